# Optimizing an MI355X kernel written in HIP

```python
import math
import jax, jax.numpy as jnp
from jax import lax
import numpy as np

D_MODEL = 1024
BATCH = 4
SEQ = 8192
DEPTH = 1

HEAD_DIM = D_MODEL // 16
N_ATTN_HEADS = 12
N_GMLP_GROUPS = 4
GMLP_DIM = HEAD_DIM
ATTN_WIDTH = N_ATTN_HEADS * HEAD_DIM
GMLP_WIDTH = N_GMLP_GROUPS * GMLP_DIM
MIX_WIDTH = ATTN_WIDTH + GMLP_WIDTH
IN_WIDTH = 3 * ATTN_WIDTH + 2 * GMLP_WIDTH
CHUNK = 128
BLOCK = 128
DILATED_PATTERNS = ((128, 1), (512, 4), (2048, 16))
D_FF = 4 * D_MODEL
EPS = 1e-6

kernel_name = "hymba_gmlp_longnet_alibi_block"


def alibi_slopes(n):
    def pow2_slopes(m):
        start = 2.0 ** (-8.0 / m)
        return [start ** (i + 1) for i in range(m)]
    if math.log2(n).is_integer():
        s = pow2_slopes(n)
    else:
        c = 2 ** int(math.floor(math.log2(n)))
        s = pow2_slopes(c) + pow2_slopes(2 * c)[0::2][: n - c]
    return np.asarray(s, dtype=np.float32)


def rms_norm(x, g):
    xf = x.astype(jnp.float32)
    y = xf * lax.rsqrt(jnp.mean(xf * xf, axis=-1, keepdims=True) + EPS)
    return (y * g.astype(jnp.float32)).astype(x.dtype)


def layer_norm(x, g, b):
    xf = x.astype(jnp.float32)
    mu = jnp.mean(xf, axis=-1, keepdims=True)
    var = jnp.mean(jnp.square(xf - mu), axis=-1, keepdims=True)
    y = (xf - mu) * lax.rsqrt(var + EPS)
    return (y * g.astype(jnp.float32) + b.astype(jnp.float32)).astype(x.dtype)


def chunked_spatial_gating(u, z, ln_g, ln_b, w_s, b_s):
    B, S, G, C = u.shape
    u = jax.nn.gelu(u)
    z = layer_norm(jax.nn.gelu(z), ln_g, ln_b)
    zc = z.reshape(B, S // CHUNK, CHUNK, G, C)
    causal = jnp.tril(jnp.ones((CHUNK, CHUNK), dtype=w_s.dtype))
    ws = w_s * causal[None]
    mixed = jnp.einsum('gts,bnsgc->bntgc', ws, zc) + b_s.T[None, None, :, :, None]
    return u * mixed.reshape(B, S, G, C)


def dilated_window_attention(q, k, v, slopes, window, dilation):
    B, S, H, Dh = q.shape
    span = BLOCK * dilation
    S_pad = -(-S // span) * span
    pad = S_pad - S
    L = S_pad // dilation
    nb = L // BLOCK

    def to_sub(t):
        t = jnp.pad(t.astype(jnp.float32), ((0, 0), (0, pad), (0, 0), (0, 0)))
        t = t.reshape(B, L, dilation, H, Dh).transpose(0, 2, 3, 1, 4)
        return t.reshape(B, dilation, H, nb, BLOCK, Dh)

    qs, ks, vs = to_sub(q), to_sub(k), to_sub(v)
    blk_pad = ((0, 0), (0, 0), (0, 0), (1, 0), (0, 0), (0, 0))
    kb = jnp.concatenate([jnp.pad(ks, blk_pad)[:, :, :, :-1], ks], axis=4)
    vb = jnp.concatenate([jnp.pad(vs, blk_pad)[:, :, :, :-1], vs], axis=4)

    scores = jnp.einsum('brhnqd,brhnkd->brhnqk', qs, kb)
    qi = jnp.arange(BLOCK)[:, None]
    kj = jnp.arange(2 * BLOCK)[None, :]
    steps = qi + BLOCK - kj
    band = (steps >= 0) & (steps <= window // dilation)
    blk = jnp.arange(nb)[:, None, None]
    valid = band[None] & ~((blk == 0) & (kj[None] < BLOCK))
    alibi = -slopes[:, None, None] * (steps * dilation).astype(jnp.float32)[None]
    scores = scores + alibi[None, None, :, None]
    scores = jnp.where(valid[None, None, None], scores, -jnp.inf)

    m = jnp.max(scores, axis=-1, keepdims=True)
    p = jnp.exp(scores - m)
    l = jnp.sum(p, axis=-1, keepdims=True)
    o = jnp.einsum('brhnqk,brhnkd->brhnqd', p, vb) / l
    lse = (m + jnp.log(l))[..., 0]

    o = o.reshape(B, dilation, H, L, Dh).transpose(0, 3, 1, 2, 4).reshape(B, S_pad, H, Dh)[:, :S]
    lse = lse.reshape(B, dilation, H, L).transpose(0, 3, 1, 2).reshape(B, S_pad, H)[:, :S]
    return o, lse


def mixture_of_dilations(q, k, v, slopes):
    outs, lses = [], []
    for window, dilation in DILATED_PATTERNS:
        o, lse = dilated_window_attention(q, k, v, slopes, window, dilation)
        outs.append(o)
        lses.append(lse)
    w = jax.nn.softmax(jnp.stack(lses, axis=0), axis=0)
    return jnp.sum(w[..., None] * jnp.stack(outs, axis=0), axis=0)


def setup_inputs(seed: int = 0) -> dict:
    key = jax.random.key(seed)
    ks = jax.random.split(key, 16)
    f32 = jnp.float32
    nrm = lambda k, shape, scale: jax.random.normal(k, shape, f32) * scale
    G, C = N_GMLP_GROUPS, GMLP_DIM
    return {
        "x": nrm(ks[0], (BATCH, SEQ, D_MODEL), 1.0),
        "norm1_g": 1.0 + nrm(ks[1], (DEPTH, D_MODEL), 0.02),
        "w_in": nrm(ks[2], (DEPTH, D_MODEL, IN_WIDTH), D_MODEL ** -0.5),
        "sgu_ln_g": 1.0 + nrm(ks[3], (DEPTH, G, C), 0.02),
        "sgu_ln_b": nrm(ks[4], (DEPTH, G, C), 0.02),
        "sgu_w": nrm(ks[5], (DEPTH, G, CHUNK, CHUNK), CHUNK ** -0.5),
        "sgu_b": 1.0 + nrm(ks[6], (DEPTH, G, CHUNK), 0.02),
        "attn_out_g": 1.0 + nrm(ks[7], (DEPTH, ATTN_WIDTH), 0.02),
        "gmlp_out_g": 1.0 + nrm(ks[8], (DEPTH, GMLP_WIDTH), 0.02),
        "w_out": nrm(ks[9], (DEPTH, MIX_WIDTH, D_MODEL), MIX_WIDTH ** -0.5),
        "norm2_g": 1.0 + nrm(ks[10], (DEPTH, D_MODEL), 0.02),
        "w_ff1": nrm(ks[11], (DEPTH, D_MODEL, D_FF), D_MODEL ** -0.5),
        "w_ff2": nrm(ks[12], (DEPTH, D_FF, D_MODEL), D_FF ** -0.5),
        "final_norm_g": 1.0 + nrm(ks[13], (D_MODEL,), 0.02),
    }


def reference(x, norm1_g, w_in, sgu_ln_g, sgu_ln_b, sgu_w, sgu_b, attn_out_g, gmlp_out_g,
              w_out, norm2_g, w_ff1, w_ff2, final_norm_g):
    B, S, _ = x.shape
    slopes = jnp.asarray(alibi_slopes(N_ATTN_HEADS), dtype=jnp.float32)
    scale = HEAD_DIM ** -0.5
    A, Gw = ATTN_WIDTH, GMLP_WIDTH
    h = x
    for l in range(DEPTH):
        hn = rms_norm(h, norm1_g[l])
        proj = hn @ w_in[l]
        q = (proj[..., :A] * scale).reshape(B, S, N_ATTN_HEADS, HEAD_DIM)
        k = proj[..., A:2 * A].reshape(B, S, N_ATTN_HEADS, HEAD_DIM)
        v = proj[..., 2 * A:3 * A].reshape(B, S, N_ATTN_HEADS, HEAD_DIM)
        u = proj[..., 3 * A:3 * A + Gw].reshape(B, S, N_GMLP_GROUPS, GMLP_DIM)
        z = proj[..., 3 * A + Gw:].reshape(B, S, N_GMLP_GROUPS, GMLP_DIM)

        attn = mixture_of_dilations(q, k, v, slopes).astype(h.dtype).reshape(B, S, A)
        gmlp = chunked_spatial_gating(u, z, sgu_ln_g[l], sgu_ln_b[l], sgu_w[l], sgu_b[l]).reshape(B, S, Gw)

        mixed = jnp.concatenate([rms_norm(attn, attn_out_g[l]), rms_norm(gmlp, gmlp_out_g[l])], axis=-1)
        h = h + mixed @ w_out[l]

        hn = rms_norm(h, norm2_g[l])
        h = h + jnp.square(jax.nn.relu(hn @ w_ff1[l])) @ w_ff2[l]
    return rms_norm(h, final_norm_g)
```

```cpp
#include <hip/hip_runtime.h>
#include <hip/hip_cooperative_groups.h>
#include <cstdio>
#include <cstdint>
namespace cg = cooperative_groups;
#define MK_NAIVE_ATTN 1
#define MK_N_LAUNCHES 1
namespace pg8 {
#define PG8_LAS __attribute__((address_space(3)))
typedef unsigned short bf16_t;
typedef short bf16x8 __attribute__((ext_vector_type(8)));
typedef float f32x4 __attribute__((ext_vector_type(4)));
typedef unsigned u32x4 __attribute__((ext_vector_type(4)));
constexpr int BM = 256, BK = 64, HALF = 128, HTB = HALF * BK * 2  , STAGE_BYTES = 8 * HTB, NXCD = 8, WGM = 8;

__host__ __device__ __forceinline__ int lds_byte(int r, int c) { const int st = (r >> 4) * 2 + (c >> 5), rr = r & 15, cc = c & 31, ob = rr * 64 + cc * 2; return st * 1024 + (ob ^ (((ob >> 9) & 1) << 5)); }
__host__ __device__ __forceinline__ void stage_rc(int b, int& R, int& C) { const int st = b / 1024, sb = b % 1024, swz = sb ^ (((sb >> 9) & 1) << 5); R = (st >> 1) * 16 + swz / 64; C = (st & 1) * 32 + (swz % 64) / 2; }
__host__ __device__ __forceinline__ int perm32(int rho) { const int n = rho >> 4, i = rho & 15; return 8 * (i >> 2) + 4 * n + (i & 3); }

struct Unit { int pm, pn; };
struct Gemm { const bf16_t* A; const bf16_t* Bt; int M, N, K; };

struct StaticOrder {
    int nM, nN, nwg, G, c;
    __host__ __device__ void init(int M, int N, int G_, int c_) { nM = M / BM; nN = N / BM; nwg = nM * nN; G = G_; c = c_; }
    __host__ __device__ bool next(int i, Unit& u) const {
        const long L = (long)i * G + c; if (L >= nwg) return false;
        int wgid = (int)L; { const int q = nwg / NXCD, r = nwg % NXCD, xcd = wgid % NXCD, off = wgid / NXCD; wgid = (xcd < r ? xcd * (q + 1) : r * (q + 1) + (xcd - r) * q) + off; }
        const int nig = WGM * nN, gid = wgid / nig, fm = gid * WGM, gsz = (nM - fm) < WGM ? (nM - fm) : WGM;
        u.pm = fm + ((wgid % nig) % gsz); u.pn = (wgid % nig) / gsz; return true;
    }
    __device__ __forceinline__ void a_ready(const Unit&) const {}
    __device__ __forceinline__ void done(const Unit&) const {}
};

__device__ __forceinline__ unsigned cvt_pk_bf16(float lo, float hi) { unsigned r; asm volatile("v_cvt_pk_bf16_f32 %0, %1, %2" : "=v"(r) : "v"(lo), "v"(hi)); return r; }
typedef unsigned u32x2 __attribute__((ext_vector_type(2)));
struct EpiBf16 {
    static constexpr bool PERM = true, AFTER_DRAIN = false;
    bf16_t* O; int ldc;
    __device__ __forceinline__ void operator()(const f32x4 (&acc)[2][2][4][2], const Unit& u, int wr, int wc, int fr, int fq) const {
        const int row0 = u.pm * BM + wr * 64 + fr; const int col0 = u.pn * BM + wc * 32 + 8 * fq;
#pragma unroll
        for (int ai = 0; ai < 2; ++ai)
#pragma unroll
            for (int m = 0; m < 4; ++m) { bf16_t* rowp = O + (size_t)(row0 + ai * HALF + m * 16) * ldc + col0;
#pragma unroll
                for (int bj = 0; bj < 2; ++bj) { const f32x4 v0 = acc[ai][bj][m][0], v1 = acc[ai][bj][m][1];
                    u32x4 w; w.x = cvt_pk_bf16(v0[0], v0[1]); w.y = cvt_pk_bf16(v0[2], v0[3]); w.z = cvt_pk_bf16(v1[0], v1[1]); w.w = cvt_pk_bf16(v1[2], v1[3]);
                    *(u32x4*)(rowp + bj * HALF) = w; } }
    }
};
struct EpiSqRelu {
    static constexpr bool PERM = true, AFTER_DRAIN = false;
    bf16_t* O; int ldc; const float* ss;
    __device__ __forceinline__ void operator()(const f32x4 (&acc)[2][2][4][2], const Unit& u, int wr, int wc, int fr, int fq) const {
        const int row0 = u.pm * BM + wr * 64 + fr; const int col0 = u.pn * BM + wc * 32 + 8 * fq;
#pragma unroll
        for (int ai = 0; ai < 2; ++ai)
#pragma unroll
            for (int m = 0; m < 4; ++m) { const int r = row0 + ai * HALF + m * 16; bf16_t* rowp = O + (size_t)r * ldc + col0;
                const f32x4* sp = (const f32x4*)(ss + (size_t)r * 16); const f32x4 s0 = sp[0], s1 = sp[1], s2 = sp[2], s3 = sp[3];
                const float tot = ((s0[0] + s0[1]) + (s0[2] + s0[3])) + ((s1[0] + s1[1]) + (s1[2] + s1[3])) + ((s2[0] + s2[1]) + (s2[2] + s2[3])) + ((s3[0] + s3[1]) + (s3[2] + s3[3]));
                const float rstd = 1.0f / sqrtf(tot * (1.0f / 1024.0f) + 1e-6f);
#pragma unroll
                for (int bj = 0; bj < 2; ++bj) { f32x4 v0 = acc[ai][bj][m][0] * rstd, v1 = acc[ai][bj][m][1] * rstd;
#pragma unroll
                    for (int e = 0; e < 4; ++e) { const float a = fmaxf(v0[e], 0.f), b = fmaxf(v1[e], 0.f); v0[e] = a * a; v1[e] = b * b; }
                    u32x4 w; w.x = cvt_pk_bf16(v0[0], v0[1]); w.y = cvt_pk_bf16(v0[2], v0[3]); w.z = cvt_pk_bf16(v1[0], v1[1]); w.w = cvt_pk_bf16(v1[2], v1[3]);
                    *(u32x4*)(rowp + bj * HALF) = w; } }
    }
};
template <bool WB> struct EpiRes {
    static constexpr bool PERM = false, AFTER_DRAIN = false;
    const float* base; float* out; bf16_t* ob; float* ss; int ldc;
    __device__ __forceinline__ void operator()(const f32x4 (&acc)[2][2][4][2], const Unit& u, int wr, int wc, int fr, int fq) const {
        const int col0 = u.pn * BM + wc * 32 + 4 * fq;
#pragma unroll
        for (int ai = 0; ai < 2; ++ai)
#pragma unroll
            for (int m = 0; m < 4; ++m) { const int r = u.pm * BM + ai * HALF + wr * 64 + m * 16 + fr; const size_t off = (size_t)r * ldc + col0; float s = 0.f;
#pragma unroll
                for (int bj = 0; bj < 2; ++bj)
#pragma unroll
                    for (int n = 0; n < 2; ++n) { const f32x4 v = *(const f32x4*)(base + off + bj * HALF + n * 16) + acc[ai][bj][m][n];
                        *(f32x4*)(out + off + bj * HALF + n * 16) = v; s += (v[0] * v[0] + v[1] * v[1]) + (v[2] * v[2] + v[3] * v[3]);
                        if (WB) { u32x2 w; w.x = cvt_pk_bf16(v[0], v[1]); w.y = cvt_pk_bf16(v[2], v[3]); *(u32x2*)(ob + off + bj * HALF + n * 16) = w; } }
                s += __shfl_xor(s, 16); s += __shfl_xor(s, 32);
                if (fq == 0) ss[(size_t)r * 16 + u.pn * 4 + wc] = s; }
    }
};
template <class Epi, class Sched, bool ALIGN_EPI = false, bool SP2 = false>
__device__ __forceinline__ void gemm_phase(PG8_LAS unsigned char* lds, const Gemm g, const Sched& S, const Epi& E) {
    const int tid = threadIdx.x, wid = __builtin_amdgcn_readfirstlane(tid >> 6), lane = tid & 63, wr = wid >> 2, wc = wid & 3, fr = lane & 15, fq = lane >> 4;
    const int K = g.K, nt = K / BK;
    unsigned voffA[2], voffB[2];
#pragma unroll
    for (int i = 0; i < 2; ++i) { int R, C; stage_rc(tid * 16 + i * 8192, R, C); const int Rb = Epi::PERM ? ((R & ~31) + perm32(R & 31)) : R;
        voffA[i] = (unsigned)(R * K + C) * 2u; voffB[i] = (unsigned)(Rb * K + C) * 2u; }
    const size_t kstep = (size_t)(BK * 2);
    const size_t hstep = (size_t)HALF * K * 2;
    const size_t tstep = 2 * hstep;
    const unsigned ldsw = (unsigned)wid * 1024u;
    const int aoff = lds_byte(wr * 64 + fr, fq * 8), boff = lds_byte(wc * 32 + fr, fq * 8);
#define PG8_SA(b, h) (((b) * 2 + (h)) * HTB)
#define PG8_SB(b, h) ((4 + (b) * 2 + (h)) * HTB)
#define PG8_STAGE(bufoff, gbase, voff) do { _Pragma("unroll") for (int _i = 0; _i < 2; ++_i) \
        __builtin_amdgcn_global_load_lds((const unsigned*)((const char*)(gbase) + (voff)[_i]), (PG8_LAS unsigned*)(lds + (bufoff) + ldsw + _i * 8192), 16, 0, 0); } while (0)
#define PG8_LDA(dst, b, h) do { _Pragma("unroll") for (int m = 0; m < 4; ++m) _Pragma("unroll") for (int k = 0; k < 2; ++k) dst[m][k] = *(const PG8_LAS bf16x8*)(lds + PG8_SA(b, h) + aoff + m * 2048 + k * 1024); } while (0)
#define PG8_LDB(dst, b, h) do { _Pragma("unroll") for (int n = 0; n < 2; ++n) _Pragma("unroll") for (int k = 0; k < 2; ++k) dst[n][k] = *(const PG8_LAS bf16x8*)(lds + PG8_SB(b, h) + boff + n * 2048 + k * 1024); } while (0)
#define PG8_MMA(ai, bj, At, Bt) do { __builtin_amdgcn_s_setprio(1); _Pragma("unroll") for (int m = 0; m < 4; ++m) _Pragma("unroll") for (int n = 0; n < 2; ++n) _Pragma("unroll") for (int k = 0; k < 2; ++k) \
        acc[ai][bj][m][n] = __builtin_amdgcn_mfma_f32_16x16x32_bf16(Bt[n][k], At[m][k], acc[ai][bj][m][n], 0, 0, 0); __builtin_amdgcn_s_setprio(0); } while (0)
#define PG8_WAIT_V(n) asm volatile("s_waitcnt vmcnt(" #n ")" ::: "memory")
#define PG8_WAIT_L(n) asm volatile("s_waitcnt lgkmcnt(" #n ")" ::: "memory")
#define PG8_BAR __builtin_amdgcn_s_barrier()
#define PG8_SCHED __builtin_amdgcn_sched_barrier(0)
    Unit cur, nxt; int ui = 0;
    if (!S.next(0, cur)) return;
    f32x4 acc[2][2][4][2];
#pragma unroll
    for (int a = 0; a < 2; ++a)
#pragma unroll
        for (int b = 0; b < 2; ++b)
#pragma unroll
            for (int m = 0; m < 4; ++m)
#pragma unroll
                for (int n = 0; n < 2; ++n) acc[a][b][m][n] = (f32x4){0.f, 0.f, 0.f, 0.f};
    bf16x8 At[4][2], B0[2][2], B1[2][2];
    const char* cA = (const char*)g.A + (size_t)cur.pm * tstep; const char* cB = (const char*)g.Bt + (size_t)cur.pn * tstep;
    S.a_ready(cur);
    if constexpr (SP2) {
        PG8_STAGE(PG8_SB(0, 0), cB, voffB); PG8_STAGE(PG8_SB(0, 1), cB + hstep, voffB); PG8_STAGE(PG8_SA(0, 0), cA, voffA); PG8_STAGE(PG8_SA(0, 1), cA + hstep, voffA);
        if (wr == 1) PG8_BAR;
        PG8_WAIT_V(2); PG8_BAR;
        PG8_STAGE(PG8_SB(1, 0), cB + kstep, voffB); PG8_STAGE(PG8_SA(1, 0), cA + kstep, voffA); PG8_STAGE(PG8_SB(1, 1), cB + hstep + kstep, voffB);
        PG8_WAIT_V(6); PG8_BAR;
    } else {
        PG8_STAGE(PG8_SB(0, 0), cB, voffB); PG8_STAGE(PG8_SA(0, 0), cA, voffA); PG8_STAGE(PG8_SB(0, 1), cB + hstep, voffB); PG8_STAGE(PG8_SA(0, 1), cA + hstep, voffA);
        if (wr == 1) PG8_BAR;
        PG8_WAIT_V(4); PG8_BAR;
        PG8_STAGE(PG8_SB(1, 0), cB + kstep, voffB); PG8_STAGE(PG8_SA(1, 0), cA + kstep, voffA); PG8_STAGE(PG8_SB(1, 1), cB + hstep + kstep, voffB);
        PG8_WAIT_V(6); PG8_BAR;
    }
    for (;;) {
        const bool has_next = S.next(ui + 1, nxt);
        const char* nA = has_next ? (const char*)g.A + (size_t)nxt.pm * tstep : cA; const char* nB = has_next ? (const char*)g.Bt + (size_t)nxt.pn * tstep : cB;
        for (int t = 0; t < nt; t += 2) {
            const bool last = (t == nt - 2);
            const char* a1 = cA + (size_t)(t + 1) * kstep;
            const char* a2 = last ? nA : cA + (size_t)(t + 2) * kstep; const char* b2 = last ? nB : cB + (size_t)(t + 2) * kstep;
            const char* a3 = a2 + kstep; const char* b3 = b2 + kstep;
            if (last && has_next) S.a_ready(nxt);
            if constexpr (SP2) {
            PG8_LDB(B0, 0, 0); PG8_LDB(B1, 0, 1); PG8_SCHED; PG8_LDA(At, 0, 0); PG8_STAGE(PG8_SA(1, 1), a1 + hstep, voffA);
            PG8_WAIT_V(8); PG8_WAIT_L(0); PG8_BAR; PG8_MMA(0, 0, At, B0); PG8_MMA(0, 1, At, B1); PG8_BAR; PG8_SCHED;
            PG8_LDA(At, 0, 1); PG8_STAGE(PG8_SB(0, 0), b2, voffB); PG8_STAGE(PG8_SB(0, 1), b2 + hstep, voffB); PG8_STAGE(PG8_SA(0, 0), a2, voffA);
            PG8_WAIT_V(8); PG8_WAIT_L(0); PG8_BAR; PG8_MMA(1, 0, At, B0); PG8_MMA(1, 1, At, B1); PG8_BAR; PG8_SCHED;
            PG8_LDB(B0, 1, 0); PG8_LDB(B1, 1, 1); PG8_SCHED; PG8_LDA(At, 1, 0); PG8_STAGE(PG8_SA(0, 1), a2 + hstep, voffA);
            PG8_WAIT_V(8); PG8_WAIT_L(0); PG8_BAR; PG8_MMA(0, 0, At, B0); PG8_MMA(0, 1, At, B1); PG8_BAR; PG8_SCHED;
            PG8_LDA(At, 1, 1); PG8_STAGE(PG8_SB(1, 0), b3, voffB); PG8_STAGE(PG8_SB(1, 1), b3 + hstep, voffB); PG8_STAGE(PG8_SA(1, 0), a3, voffA);
            PG8_WAIT_V(8); PG8_WAIT_L(0); PG8_BAR; PG8_MMA(1, 0, At, B0); PG8_MMA(1, 1, At, B1); PG8_BAR; PG8_SCHED;
            } else {
            PG8_LDB(B0, 0, 0); PG8_SCHED; PG8_LDA(At, 0, 0); PG8_STAGE(PG8_SA(1, 1), a1 + hstep, voffA);
            PG8_WAIT_L(8); PG8_BAR; PG8_WAIT_L(0); PG8_MMA(0, 0, At, B0); PG8_BAR; PG8_SCHED;
            PG8_LDB(B1, 0, 1); PG8_STAGE(PG8_SB(0, 0), b2, voffB);
            PG8_BAR; PG8_WAIT_L(0); PG8_MMA(0, 1, At, B1); PG8_BAR;
            PG8_LDA(At, 0, 1); PG8_STAGE(PG8_SA(0, 0), a2, voffA);
            PG8_BAR; PG8_WAIT_L(0); PG8_MMA(1, 0, At, B0); PG8_BAR; PG8_SCHED;
            PG8_STAGE(PG8_SB(0, 1), b2 + hstep, voffB);
            PG8_WAIT_V(6); PG8_BAR; PG8_MMA(1, 1, At, B1); PG8_BAR;
            PG8_LDB(B0, 1, 0); PG8_SCHED; PG8_LDA(At, 1, 0); PG8_STAGE(PG8_SA(0, 1), a2 + hstep, voffA);
            PG8_WAIT_L(8); PG8_BAR; PG8_WAIT_L(0); PG8_MMA(0, 0, At, B0); PG8_BAR; PG8_SCHED;
            PG8_LDB(B1, 1, 1); PG8_STAGE(PG8_SB(1, 0), b3, voffB);
            PG8_BAR; PG8_WAIT_L(0); PG8_MMA(0, 1, At, B1); PG8_BAR;
            PG8_LDA(At, 1, 1); PG8_STAGE(PG8_SA(1, 0), a3, voffA);
            PG8_BAR; PG8_WAIT_L(0); PG8_MMA(1, 0, At, B0); PG8_BAR; PG8_SCHED;
            PG8_STAGE(PG8_SB(1, 1), b3 + hstep, voffB);
            PG8_WAIT_V(6); PG8_BAR; PG8_MMA(1, 1, At, B1); PG8_BAR;
            }
        }
        if constexpr (ALIGN_EPI) { if (wr == 0) PG8_BAR; }
        if constexpr (!Epi::AFTER_DRAIN) { E(acc, cur, wr, wc, fr, fq); S.done(cur); }
        if (!has_next) break;
#pragma unroll
        for (int a = 0; a < 2; ++a)
#pragma unroll
            for (int b = 0; b < 2; ++b)
#pragma unroll
                for (int m = 0; m < 4; ++m)
#pragma unroll
                    for (int n = 0; n < 2; ++n) acc[a][b][m][n] = (f32x4){0.f, 0.f, 0.f, 0.f};
        cur = nxt; cA = nA; cB = nB; ++ui;
        if constexpr (ALIGN_EPI) { if (wr == 1) PG8_BAR; }
    }
    PG8_WAIT_V(0);
    if constexpr (!ALIGN_EPI) { if (wr == 0) PG8_BAR; }
    PG8_BAR;
    if constexpr (Epi::AFTER_DRAIN) { E.fused(acc, cur, wr, wc, fr, fq, lds, wid, lane); S.done(cur); }
#undef PG8_SA
#undef PG8_SB
#undef PG8_STAGE
#undef PG8_LDA
#undef PG8_LDB
#undef PG8_MMA
#undef PG8_WAIT_V
#undef PG8_WAIT_L
#undef PG8_BAR
#undef PG8_SCHED
}
}
#define GAS __attribute__((address_space(1)))
#define LAS __attribute__((address_space(3)))
typedef unsigned short bf16;
typedef unsigned v4u __attribute__((ext_vector_type(4)));
typedef unsigned v2u __attribute__((ext_vector_type(2)));
typedef float f32x4 __attribute__((ext_vector_type(4)));
typedef float f32x16 __attribute__((ext_vector_type(16)));
typedef short bf16x8 __attribute__((ext_vector_type(8)));
#define LDS_WAIT() asm volatile("s_waitcnt lgkmcnt(0)" ::: "memory")

#ifndef MK_N_LAUNCHES
#define MK_N_LAUNCHES 1
#endif
#ifndef MK_NAIVE_ATTN
#define MK_NAIVE_ATTN 0
#endif
constexpr int NWAVES = 8, NPH = 8;
constexpr int BATCH = 4, SEQ = 8192, D = 1024, NH = 12, HD = 64, AW = 768, GWD = 256, NG = 4, INW = 2816, FF = 4096, M = BATCH * SEQ, CHUNK = 128;
constexpr float EPS = 1e-6f;
constexpr size_t MiB = 1u << 20;
constexpr size_t WS_WIN = 2 * MiB, WS_WOUT = 8 * MiB, WS_W1 = 10 * MiB, WS_W2 = 18 * MiB, WS_SS1 = 26 * MiB, WS_SS2 = 28 * MiB, WS_LSE = 30 * MiB, WS_GM = 36 * MiB,
                 WS_XN = 64 * MiB, WS_PROJ = 128 * MiB, WS_OP = 304 * MiB, WS_H1B = 128 * MiB, WS_HID = 192 * MiB, WS_END = 448 * MiB;
static_assert(WS_WIN + (size_t)INW * D * 2 <= WS_WOUT && WS_LSE + (size_t)3 * M * NH * 4 <= WS_GM && WS_GM + (size_t)M * GWD * 2 <= WS_XN && WS_PROJ + (size_t)M * INW * 2 <= WS_OP && WS_OP + (size_t)3 * M * AW * 2 <= WS_END && WS_HID + (size_t)M * FF * 2 <= WS_END, "ws map");
constexpr int LDS_BYTES = 147456;

__device__ __forceinline__ float bflo(unsigned u) { return __uint_as_float(u << 16); }
__device__ __forceinline__ float bfhi(unsigned u) { return __uint_as_float(u & 0xffff0000u); }
__device__ __forceinline__ unsigned pk2(float lo, float hi) { return pg8::cvt_pk_bf16(lo, hi); }
__device__ __forceinline__ float wave_sum(float v) {
#pragma unroll
    for (int o = 1; o < 64; o <<= 1) v += __shfl_xor(v, o);
    return v;
}
__device__ __forceinline__ float gelu_t(float x) { const float y = 0.7978845608028654f * (x + 0.044715f * x * x * x); return x / (1.0f + __expf(-2.0f * y)); }

__device__ __forceinline__ void p0_transpose_item(const float* W, int K, int N, bf16* WT, const float* gk, int qcols, LAS float* scr, int item, int lane) {
    const int nblk = N / 32, kb = item / nblk, nb = item % nblk, k0 = 64 * kb, n0 = 32 * nb;
#pragma unroll 8
    for (int i = 0; i < 32; ++i) { const int kk = 2 * i + (lane >> 5); const float g = gk ? gk[k0 + kk] : 1.0f; scr[kk * 33 + (lane & 31)] = W[(size_t)(k0 + kk) * N + n0 + (lane & 31)] * g; }
    LDS_WAIT();
    const int c = lane & 7;
#pragma unroll
    for (int j = 0; j < 4; ++j) { const int n = (lane >> 3) + 8 * j; const LAS float* s = scr + (8 * c) * 33 + n; const float sc = (n0 + n < qcols) ? 0.125f : 1.0f;
        v4u o; o.x = pk2(s[0 * 33] * sc, s[1 * 33] * sc); o.y = pk2(s[2 * 33] * sc, s[3 * 33] * sc); o.z = pk2(s[4 * 33] * sc, s[5 * 33] * sc); o.w = pk2(s[6 * 33] * sc, s[7 * 33] * sc);
        *(v4u*)(WT + (size_t)(n0 + n) * K + k0 + 8 * c) = o; }
    LDS_WAIT();
}
__device__ __forceinline__ void rms_row_to_bf16(const float* xrow, bf16* orow, int lane) {
    const f32x4* xr = (const f32x4*)xrow + lane;
    f32x4 v[4]; float s = 0.f;
#pragma unroll
    for (int j = 0; j < 4; ++j) { v[j] = xr[64 * j]; s += (v[j].x * v[j].x + v[j].y * v[j].y) + (v[j].z * v[j].z + v[j].w * v[j].w); }
    const float rstd = 1.0f / sqrtf(wave_sum(s) * (1.0f / D) + EPS);
    v2u* o8 = (v2u*)orow + lane;
#pragma unroll
    for (int j = 0; j < 4; ++j) { v2u w; w.x = pk2(v[j].x * rstd, v[j].y * rstd); w.y = pk2(v[j].z * rstd, v[j].w * rstd); o8[64 * j] = w; }
}

__device__ __forceinline__ void gmlp_unit(LAS unsigned char* lds, const bf16* PROJ, const float* ln_g, const float* ln_b, const float* sgu_w, const float* sgu_b, bf16* GM, int unit, int tid) {
    const int g = unit & 3, n = (unit >> 2) & 63, b = unit >> 8;
    const size_t row0 = (size_t)b * SEQ + (size_t)n * CHUNK;
    LAS float* zn = (LAS float*)lds;
    LAS float* wl = (LAS float*)(lds + 128 * 68 * 4);
    const float* wg = sgu_w + (size_t)g * CHUNK * CHUNK;
    for (int i = tid; i < CHUNK * CHUNK; i += NWAVES * 64) wl[(i >> 7) * 129 + (i & 127)] = wg[i];
    {
        const int t = tid >> 2, q = tid & 3;
        const bf16* zp = PROJ + (row0 + t) * INW + 2560 + g * 64 + 16 * q;
        const v4u r0 = *(const v4u*)zp, r1 = *(const v4u*)(zp + 8);
        float z[16];
        z[0] = bflo(r0.x); z[1] = bfhi(r0.x); z[2] = bflo(r0.y); z[3] = bfhi(r0.y); z[4] = bflo(r0.z); z[5] = bfhi(r0.z); z[6] = bflo(r0.w); z[7] = bfhi(r0.w);
        z[8] = bflo(r1.x); z[9] = bfhi(r1.x); z[10] = bflo(r1.y); z[11] = bfhi(r1.y); z[12] = bflo(r1.z); z[13] = bfhi(r1.z); z[14] = bflo(r1.w); z[15] = bfhi(r1.w);
        float s = 0.f;
#pragma unroll
        for (int e = 0; e < 16; ++e) { z[e] = gelu_t(z[e]); s += z[e]; }
        s += __shfl_xor(s, 1); s += __shfl_xor(s, 2);
        const float mean = s * (1.0f / 64.0f); float v = 0.f;
#pragma unroll
        for (int e = 0; e < 16; ++e) { z[e] -= mean; v += z[e] * z[e]; }
        v += __shfl_xor(v, 1); v += __shfl_xor(v, 2);
        const float rstd = 1.0f / sqrtf(v * (1.0f / 64.0f) + EPS);
        const float* lg = ln_g + g * 64 + 16 * q; const float* lb = ln_b + g * 64 + 16 * q;
#pragma unroll
        for (int e4 = 0; e4 < 4; ++e4) { f32x4 o;
#pragma unroll
            for (int e = 0; e < 4; ++e) o[e] = z[4 * e4 + e] * rstd * lg[4 * e4 + e] + lb[4 * e4 + e];
            *(LAS f32x4*)(zn + t * 68 + 16 * q + 4 * e4) = o; }
    }
    __syncthreads();
    const int wv = __builtin_amdgcn_readfirstlane(tid >> 6), lane = tid & 63, tr = lane >> 3, cq = lane & 7;
#pragma unroll 1
    for (int half = 0; half < 2; ++half) {
        const int blk = half ? 15 - wv : wv, t = 8 * blk + tr, smax = 8 * blk + 7;
        float acc[8];
#pragma unroll
        for (int e = 0; e < 8; ++e) acc[e] = 0.f;
#pragma unroll 4
        for (int s = 0; s <= smax; ++s) {
            float w = wl[t * 129 + s]; w = (s <= t) ? w : 0.f;
            const f32x4 z0 = *(const LAS f32x4*)(zn + s * 68 + 8 * cq), z1 = *(const LAS f32x4*)(zn + s * 68 + 8 * cq + 4);
#pragma unroll
            for (int e = 0; e < 4; ++e) { acc[e] += w * z0[e]; acc[4 + e] += w * z1[e]; }
        }
        const v4u ur = *(const v4u*)(PROJ + (row0 + t) * INW + 2304 + g * 64 + 8 * cq);
        const float bs = sgu_b[g * CHUNK + t];
        float u[8]; u[0] = bflo(ur.x); u[1] = bfhi(ur.x); u[2] = bflo(ur.y); u[3] = bfhi(ur.y); u[4] = bflo(ur.z); u[5] = bfhi(ur.z); u[6] = bflo(ur.w); u[7] = bfhi(ur.w);
#pragma unroll
        for (int e = 0; e < 8; ++e) u[e] = gelu_t(u[e]) * (acc[e] + bs);
        v4u o; o.x = pk2(u[0], u[1]); o.y = pk2(u[2], u[3]); o.z = pk2(u[4], u[5]); o.w = pk2(u[6], u[7]);
        *(v4u*)(GM + (row0 + t) * GWD + g * 64 + 8 * cq) = o;
    }
    __syncthreads();
}

__device__ __forceinline__ float alibi_slope(int h) { return (h < 8) ? exp2f(-(float)(h + 1)) : exp2f(-0.5f - (float)(h - 8)); }

#if MK_NAIVE_ATTN
__device__ __forceinline__ void attn_naive(const bf16* PROJ, bf16* OP, float* LSE, int gtid, int nthreads) {
#pragma unroll 1
    for (int it = gtid; it < M * NH * 3; it += nthreads) {
        const int h = it % NH, row = (it / NH) % M, p = it / (NH * M), dil = 1 << (2 * p), t = row % SEQ;
        const float slope = alibi_slope(h);
        const bf16* qp = PROJ + (size_t)row * INW + h * 64;
        float q[64], o[64];
#pragma unroll
        for (int c = 0; c < 8; ++c) { const v4u r = *(const v4u*)(qp + 8 * c); q[8*c] = bflo(r.x); q[8*c+1] = bfhi(r.x); q[8*c+2] = bflo(r.y); q[8*c+3] = bfhi(r.y); q[8*c+4] = bflo(r.z); q[8*c+5] = bfhi(r.z); q[8*c+6] = bflo(r.w); q[8*c+7] = bfhi(r.w); }
#pragma unroll
        for (int e = 0; e < 64; ++e) o[e] = 0.f;
        float m = -1e30f, l = 0.f;
#pragma unroll 1
        for (int j = 0; j <= 128; ++j) {
            const int tk = t - dil * j; if (tk < 0) break;
            const bf16* kp = qp + 768 - (size_t)(dil * j) * INW; const bf16* vp = kp + 768;
            float dot = 0.f;
#pragma unroll
            for (int c = 0; c < 8; ++c) { const v4u r = *(const v4u*)(kp + 8 * c);
                dot += q[8*c] * bflo(r.x) + q[8*c+1] * bfhi(r.x) + q[8*c+2] * bflo(r.y) + q[8*c+3] * bfhi(r.y) + q[8*c+4] * bflo(r.z) + q[8*c+5] * bfhi(r.z) + q[8*c+6] * bflo(r.w) + q[8*c+7] * bfhi(r.w); }
            const float s = dot - slope * (float)(dil * j);
            const float mn = fmaxf(m, s), sc = __expf(m - mn), pe = __expf(s - mn);
            l = l * sc + pe; m = mn;
#pragma unroll
            for (int c = 0; c < 8; ++c) { const v4u r = *(const v4u*)(vp + 8 * c);
                o[8*c] = o[8*c] * sc + pe * bflo(r.x); o[8*c+1] = o[8*c+1] * sc + pe * bfhi(r.x); o[8*c+2] = o[8*c+2] * sc + pe * bflo(r.y); o[8*c+3] = o[8*c+3] * sc + pe * bfhi(r.y);
                o[8*c+4] = o[8*c+4] * sc + pe * bflo(r.z); o[8*c+5] = o[8*c+5] * sc + pe * bfhi(r.z); o[8*c+6] = o[8*c+6] * sc + pe * bflo(r.w); o[8*c+7] = o[8*c+7] * sc + pe * bfhi(r.w); }
        }
        const float il = 1.0f / l;
        bf16* op = OP + ((size_t)p * M + row) * AW + h * 64;
#pragma unroll
        for (int c = 0; c < 8; ++c) { v4u w; w.x = pk2(o[8*c] * il, o[8*c+1] * il); w.y = pk2(o[8*c+2] * il, o[8*c+3] * il); w.z = pk2(o[8*c+4] * il, o[8*c+5] * il); w.w = pk2(o[8*c+6] * il, o[8*c+7] * il); *(v4u*)(op + 8 * c) = w; }
        LSE[((size_t)p * M + row) * NH + h] = m + __logf(l);
    }
}
#endif

__device__ __forceinline__ void mixnorm_row(const bf16* OP, const float* LSE, const bf16* GM, bf16* MIXED, int row, int lane) {
    float a[3][4]; float ssa = 0.f;
#pragma unroll
    for (int j = 0; j < 3; ++j) {
        const int c = 256 * j + 4 * lane, head = c >> 6;
        float ls[3];
#pragma unroll
        for (int p = 0; p < 3; ++p) ls[p] = LSE[((size_t)p * M + row) * NH + head];
        const float mx = fmaxf(ls[0], fmaxf(ls[1], ls[2]));
        float w[3]; float wsum = 0.f;
#pragma unroll
        for (int p = 0; p < 3; ++p) { w[p] = __expf(ls[p] - mx); wsum += w[p]; }
        const float iw = 1.0f / wsum;
#pragma unroll
        for (int e = 0; e < 4; ++e) a[j][e] = 0.f;
#pragma unroll
        for (int p = 0; p < 3; ++p) { const v2u r = *(const v2u*)(OP + ((size_t)p * M + row) * AW + c); const float wp = w[p] * iw;
            a[j][0] += wp * bflo(r.x); a[j][1] += wp * bfhi(r.x); a[j][2] += wp * bflo(r.y); a[j][3] += wp * bfhi(r.y); }
#pragma unroll
        for (int e = 0; e < 4; ++e) ssa += a[j][e] * a[j][e];
    }
    const v2u gr = *(const v2u*)(GM + (size_t)row * GWD + 4 * lane);
    float gv[4]; gv[0] = bflo(gr.x); gv[1] = bfhi(gr.x); gv[2] = bflo(gr.y); gv[3] = bfhi(gr.y);
    float ssg = (gv[0] * gv[0] + gv[1] * gv[1]) + (gv[2] * gv[2] + gv[3] * gv[3]);
    const float ra = 1.0f / sqrtf(wave_sum(ssa) * (1.0f / AW) + EPS), rg = 1.0f / sqrtf(wave_sum(ssg) * (1.0f / GWD) + EPS);
    bf16* mp = MIXED + (size_t)row * D;
#pragma unroll
    for (int j = 0; j < 3; ++j) { v2u w; w.x = pk2(a[j][0] * ra, a[j][1] * ra); w.y = pk2(a[j][2] * ra, a[j][3] * ra); *(v2u*)(mp + 256 * j + 4 * lane) = w; }
    { v2u w; w.x = pk2(gv[0] * rg, gv[1] * rg); w.y = pk2(gv[2] * rg, gv[3] * rg); *(v2u*)(mp + AW + 4 * lane) = w; }
}
struct Args { const float* in[14]; float* out; unsigned char* ws; int ph_lo, ph_hi; };
__global__ void __launch_bounds__(NWAVES * 64, 2) hymba_fwd(Args args) {
    extern __shared__ __attribute__((aligned(16))) unsigned char lds_raw[];
    LAS unsigned char* lds = (LAS unsigned char*)lds_raw;
    cg::grid_group grid = cg::this_grid();
    const int tid = threadIdx.x, lane = tid & 63, wave = __builtin_amdgcn_readfirstlane(tid >> 6);
    const int G = gridDim.x, bx = blockIdx.x;
    const int vcu = (G % 8 == 0) ? (bx % 8) * (G / 8) + bx / 8 : bx;
    const int gw = vcu * NWAVES + wave, NGW = G * NWAVES;
    unsigned char* ws = args.ws;
    const float* x = args.in[0]; const float* norm1_g = args.in[1]; const float* w_in = args.in[2]; const float* sgu_ln_g = args.in[3]; const float* sgu_ln_b = args.in[4];
    const float* sgu_w = args.in[5]; const float* sgu_b = args.in[6]; const float* attn_out_g = args.in[7]; const float* gmlp_out_g = args.in[8]; const float* w_out = args.in[9];
    const float* norm2_g = args.in[10]; const float* w_ff1 = args.in[11]; const float* w_ff2 = args.in[12]; const float* final_g = args.in[13];
    float* out = args.out;
    bf16* WIN = (bf16*)(ws + WS_WIN); bf16* WOUT = (bf16*)(ws + WS_WOUT); bf16* W1 = (bf16*)(ws + WS_W1); bf16* W2 = (bf16*)(ws + WS_W2);
    float* SS1 = (float*)(ws + WS_SS1); float* SS2 = (float*)(ws + WS_SS2); float* LSE = (float*)(ws + WS_LSE);
    bf16* GM = (bf16*)(ws + WS_GM); bf16* XN = (bf16*)(ws + WS_XN); bf16* PROJ = (bf16*)(ws + WS_PROJ); bf16* OP = (bf16*)(ws + WS_OP);
    bf16* H1B = (bf16*)(ws + WS_H1B); bf16* HID = (bf16*)(ws + WS_HID);
    const int lo = args.ph_lo, hi = args.ph_hi;
#define IN(k) (lo <= (k) && (k) < hi)
#define SEAM(k) do { if (IN(k) && IN((k) + 1)) grid.sync(); } while (0)

    if (IN(0)) {
        LAS float* scr = (LAS float*)(lds + wave * 16384);
        constexpr int I_IN = (D / 64) * (INW / 32), I_O = (D / 64) * (D / 32), I_1 = (D / 64) * (FF / 32), I_2 = (FF / 64) * (D / 32);
        constexpr int NITEMS = I_IN + I_O + I_1 + I_2;
#pragma unroll 1
        for (int it = gw; it < NITEMS; it += NGW) {
            int r = it;
            if (r < I_IN) { p0_transpose_item(w_in, D, INW, WIN, norm1_g, AW, scr, r, lane); continue; } r -= I_IN;
            if (r < I_O) { p0_transpose_item(w_out, D, D, WOUT, (r / (D / 32)) < (AW / 64) ? attn_out_g : gmlp_out_g - AW, 0, scr, r, lane); continue; } r -= I_O;
            if (r < I_1) { p0_transpose_item(w_ff1, D, FF, W1, norm2_g, 0, scr, r, lane); continue; } r -= I_1;
            p0_transpose_item(w_ff2, FF, D, W2, nullptr, 0, scr, r, lane);
        }
#pragma unroll 1
        for (int m = gw; m < M; m += NGW) rms_row_to_bf16(x + (size_t)m * D, XN + (size_t)m * D, lane);
    }
    SEAM(0);
    if (IN(1)) {
        pg8::Gemm g{XN, WIN, M, INW, D}; pg8::StaticOrder S; S.init(M, INW, G, bx);
        pg8::EpiBf16 E{PROJ, INW};
        pg8::gemm_phase<pg8::EpiBf16, pg8::StaticOrder, true, true>(lds, g, S, E);
    }
    SEAM(1);
    if (IN(2)) {
#pragma unroll 1
        for (int u = vcu; u < BATCH * (SEQ / CHUNK) * NG; u += G) gmlp_unit(lds, PROJ, sgu_ln_g, sgu_ln_b, sgu_w, sgu_b, GM, u, tid);
#if MK_NAIVE_ATTN
        attn_naive(PROJ, OP, LSE, bx * (NWAVES * 64) + tid, G * NWAVES * 64);
#else
        attn_phase(lds, PROJ, OP, LSE, gw, NGW, wave, lane);
#endif
    }
    SEAM(2);
    if (IN(3)) {
#pragma unroll 1
        for (int m = gw; m < M; m += NGW) mixnorm_row(OP, LSE, GM, XN, m, lane);
    }
    SEAM(3);
    if (IN(4)) {
        pg8::Gemm g{XN, WOUT, M, D, D}; pg8::StaticOrder S; S.init(M, D, G, bx);
        pg8::EpiRes<true> E{x, out, H1B, SS1, D};
        pg8::gemm_phase<pg8::EpiRes<true>, pg8::StaticOrder, true, true>(lds, g, S, E);
    }
    SEAM(4);
    if (IN(5)) {
        pg8::Gemm g{H1B, W1, M, FF, D}; pg8::StaticOrder S; S.init(M, FF, G, bx);
        pg8::EpiSqRelu E{HID, FF, SS1};
        pg8::gemm_phase<pg8::EpiSqRelu, pg8::StaticOrder, true, true>(lds, g, S, E);
    }
    SEAM(5);
    if (IN(6)) {
        pg8::Gemm g{HID, W2, M, D, FF}; pg8::StaticOrder S; S.init(M, D, G, bx);
        pg8::EpiRes<false> E{out, out, nullptr, SS2, D};
        pg8::gemm_phase<pg8::EpiRes<false>, pg8::StaticOrder, true, true>(lds, g, S, E);
    }
    SEAM(6);
    if (IN(7)) {
#pragma unroll 1
        for (int m = gw; m < M; m += NGW) {
            f32x4* orow = (f32x4*)(out + (size_t)m * D) + lane;
            float s = SS2[(size_t)m * 16 + (lane & 15)];
            s += __shfl_xor(s, 1); s += __shfl_xor(s, 2); s += __shfl_xor(s, 4); s += __shfl_xor(s, 8);
            const float rstd = 1.0f / sqrtf(s * (1.0f / D) + EPS);
#pragma unroll
            for (int j = 0; j < 4; ++j) { const f32x4 v = orow[64 * j]; const f32x4 gq = *((const f32x4*)final_g + lane + 64 * j); orow[64 * j] = v * rstd * gq; }
        }
    }
#undef IN
#undef SEAM
}

extern "C" void kernel_launch(void* const* d_in, const int* in_sizes, int n_in, void* d_out, int out_size, void* d_ws, size_t ws_size, hipStream_t stream) {
    static int grid = 0;
    if (grid == 0) {
        if (n_in != 14 || in_sizes[0] != M * D || out_size != M * D || ws_size < WS_END) { fprintf(stderr, "kernel_launch: unexpected shapes (n_in %d, in0 %d, out %d, ws %zu); nothing launched\n", n_in, n_in > 0 ? in_sizes[0] : -1, out_size, ws_size); grid = -1; return; }
        int dev = 0, cus = 0, per_cu = 0;
        if (hipGetDevice(&dev) != hipSuccess || hipDeviceGetAttribute(&cus, hipDeviceAttributeMultiprocessorCount, dev) != hipSuccess) { grid = -1; return; }
        if (hipFuncSetAttribute((const void*)hymba_fwd, hipFuncAttributeMaxDynamicSharedMemorySize, LDS_BYTES) != hipSuccess) { fprintf(stderr, "kernel_launch: hipFuncSetAttribute failed\n"); grid = -1; return; }
        if (hipOccupancyMaxActiveBlocksPerMultiprocessor(&per_cu, (const void*)hymba_fwd, NWAVES * 64, LDS_BYTES) != hipSuccess || per_cu < 1) { fprintf(stderr, "kernel_launch: occupancy query says %d blocks per CU\n", per_cu); per_cu = 1; }
        (void)hipGetLastError();
        grid = cus;
    }
    if (grid < 0) return;
    Args a{};
    for (int i = 0; i < 14; ++i) a.in[i] = (const float*)d_in[i];
    a.out = (float*)d_out; a.ws = (unsigned char*)d_ws;
#if MK_N_LAUNCHES == 1
    a.ph_lo = 0; a.ph_hi = NPH;
    void* kargs[] = {&a};
    hipError_t e = hipLaunchCooperativeKernel((const void*)hymba_fwd, dim3(grid), dim3(NWAVES * 64), kargs, LDS_BYTES, stream);
    if (e != hipSuccess) fprintf(stderr, "kernel_launch: cooperative launch failed: %s (grid %d)\n", hipGetErrorString(e), grid);
#else
    for (int ph = 0; ph < NPH; ++ph) {
        a.ph_lo = ph; a.ph_hi = ph + 1;
        hipLaunchKernelGGL(hymba_fwd, dim3(grid), dim3(NWAVES * 64), LDS_BYTES, stream, a);
    }
#endif
}
```

```cpp
#include <hip/hip_runtime.h>
#include <hip/hip_cooperative_groups.h>
#include <cstdio>
#include <cstdint>
namespace cg = cooperative_groups;
#define MK_NAIVE_ATTN 0
#define MK_N_LAUNCHES 1
namespace pg8 {
#define PG8_LAS __attribute__((address_space(3)))
typedef unsigned short bf16_t;
typedef short bf16x8 __attribute__((ext_vector_type(8)));
typedef float f32x4 __attribute__((ext_vector_type(4)));
typedef unsigned u32x4 __attribute__((ext_vector_type(4)));
constexpr int BM = 256, BK = 64, HALF = 128, HTB = HALF * BK * 2  , STAGE_BYTES = 8 * HTB, NXCD = 8, WGM = 8;

__host__ __device__ __forceinline__ int lds_byte(int r, int c) { const int st = (r >> 4) * 2 + (c >> 5), rr = r & 15, cc = c & 31, ob = rr * 64 + cc * 2; return st * 1024 + (ob ^ (((ob >> 9) & 1) << 5)); }
__host__ __device__ __forceinline__ void stage_rc(int b, int& R, int& C) { const int st = b / 1024, sb = b % 1024, swz = sb ^ (((sb >> 9) & 1) << 5); R = (st >> 1) * 16 + swz / 64; C = (st & 1) * 32 + (swz % 64) / 2; }
__host__ __device__ __forceinline__ int perm32(int rho) { const int n = rho >> 4, i = rho & 15; return 8 * (i >> 2) + 4 * n + (i & 3); }

struct Unit { int pm, pn; };
struct Gemm { const bf16_t* A; const bf16_t* Bt; int M, N, K; };

struct StaticOrder {
    int nM, nN, nwg, G, c;
    __host__ __device__ void init(int M, int N, int G_, int c_) { nM = M / BM; nN = N / BM; nwg = nM * nN; G = G_; c = c_; }
    __host__ __device__ bool next(int i, Unit& u) const {
        const long L = (long)i * G + c; if (L >= nwg) return false;
        int wgid = (int)L; { const int q = nwg / NXCD, r = nwg % NXCD, xcd = wgid % NXCD, off = wgid / NXCD; wgid = (xcd < r ? xcd * (q + 1) : r * (q + 1) + (xcd - r) * q) + off; }
        const int nig = WGM * nN, gid = wgid / nig, fm = gid * WGM, gsz = (nM - fm) < WGM ? (nM - fm) : WGM;
        u.pm = fm + ((wgid % nig) % gsz); u.pn = (wgid % nig) / gsz; return true;
    }
    __device__ __forceinline__ void a_ready(const Unit&) const {}
    __device__ __forceinline__ void done(const Unit&) const {}
};

__device__ __forceinline__ unsigned cvt_pk_bf16(float lo, float hi) { unsigned r; asm volatile("v_cvt_pk_bf16_f32 %0, %1, %2" : "=v"(r) : "v"(lo), "v"(hi)); return r; }
typedef unsigned u32x2 __attribute__((ext_vector_type(2)));
struct EpiBf16 {
    static constexpr bool PERM = true, AFTER_DRAIN = false;
    bf16_t* O; int ldc;
    __device__ __forceinline__ void operator()(const f32x4 (&acc)[2][2][4][2], const Unit& u, int wr, int wc, int fr, int fq) const {
        const int row0 = u.pm * BM + wr * 64 + fr; const int col0 = u.pn * BM + wc * 32 + 8 * fq;
#pragma unroll
        for (int ai = 0; ai < 2; ++ai)
#pragma unroll
            for (int m = 0; m < 4; ++m) { bf16_t* rowp = O + (size_t)(row0 + ai * HALF + m * 16) * ldc + col0;
#pragma unroll
                for (int bj = 0; bj < 2; ++bj) { const f32x4 v0 = acc[ai][bj][m][0], v1 = acc[ai][bj][m][1];
                    u32x4 w; w.x = cvt_pk_bf16(v0[0], v0[1]); w.y = cvt_pk_bf16(v0[2], v0[3]); w.z = cvt_pk_bf16(v1[0], v1[1]); w.w = cvt_pk_bf16(v1[2], v1[3]);
                    *(u32x4*)(rowp + bj * HALF) = w; } }
    }
};
struct EpiSqRelu {
    static constexpr bool PERM = true, AFTER_DRAIN = false;
    bf16_t* O; int ldc; const float* ss;
    __device__ __forceinline__ void operator()(const f32x4 (&acc)[2][2][4][2], const Unit& u, int wr, int wc, int fr, int fq) const {
        const int row0 = u.pm * BM + wr * 64 + fr; const int col0 = u.pn * BM + wc * 32 + 8 * fq;
#pragma unroll
        for (int ai = 0; ai < 2; ++ai)
#pragma unroll
            for (int m = 0; m < 4; ++m) { const int r = row0 + ai * HALF + m * 16; bf16_t* rowp = O + (size_t)r * ldc + col0;
                const f32x4* sp = (const f32x4*)(ss + (size_t)r * 16); const f32x4 s0 = sp[0], s1 = sp[1], s2 = sp[2], s3 = sp[3];
                const float tot = ((s0[0] + s0[1]) + (s0[2] + s0[3])) + ((s1[0] + s1[1]) + (s1[2] + s1[3])) + ((s2[0] + s2[1]) + (s2[2] + s2[3])) + ((s3[0] + s3[1]) + (s3[2] + s3[3]));
                const float rstd = 1.0f / sqrtf(tot * (1.0f / 1024.0f) + 1e-6f);
#pragma unroll
                for (int bj = 0; bj < 2; ++bj) { f32x4 v0 = acc[ai][bj][m][0] * rstd, v1 = acc[ai][bj][m][1] * rstd;
#pragma unroll
                    for (int e = 0; e < 4; ++e) { const float a = fmaxf(v0[e], 0.f), b = fmaxf(v1[e], 0.f); v0[e] = a * a; v1[e] = b * b; }
                    u32x4 w; w.x = cvt_pk_bf16(v0[0], v0[1]); w.y = cvt_pk_bf16(v0[2], v0[3]); w.z = cvt_pk_bf16(v1[0], v1[1]); w.w = cvt_pk_bf16(v1[2], v1[3]);
                    *(u32x4*)(rowp + bj * HALF) = w; } }
    }
};
template <bool WB> struct EpiRes {
    static constexpr bool PERM = false, AFTER_DRAIN = false;
    const float* base; float* out; bf16_t* ob; float* ss; int ldc;
    __device__ __forceinline__ void operator()(const f32x4 (&acc)[2][2][4][2], const Unit& u, int wr, int wc, int fr, int fq) const {
        const int col0 = u.pn * BM + wc * 32 + 4 * fq;
#pragma unroll
        for (int ai = 0; ai < 2; ++ai)
#pragma unroll
            for (int m = 0; m < 4; ++m) { const int r = u.pm * BM + ai * HALF + wr * 64 + m * 16 + fr; const size_t off = (size_t)r * ldc + col0; float s = 0.f;
#pragma unroll
                for (int bj = 0; bj < 2; ++bj)
#pragma unroll
                    for (int n = 0; n < 2; ++n) { const f32x4 v = *(const f32x4*)(base + off + bj * HALF + n * 16) + acc[ai][bj][m][n];
                        *(f32x4*)(out + off + bj * HALF + n * 16) = v; s += (v[0] * v[0] + v[1] * v[1]) + (v[2] * v[2] + v[3] * v[3]);
                        if (WB) { u32x2 w; w.x = cvt_pk_bf16(v[0], v[1]); w.y = cvt_pk_bf16(v[2], v[3]); *(u32x2*)(ob + off + bj * HALF + n * 16) = w; } }
                s += __shfl_xor(s, 16); s += __shfl_xor(s, 32);
                if (fq == 0) ss[(size_t)r * 16 + u.pn * 4 + wc] = s; }
    }
};
template <class Epi, class Sched, bool ALIGN_EPI = false, bool SP2 = false>
__device__ __forceinline__ void gemm_phase(PG8_LAS unsigned char* lds, const Gemm g, const Sched& S, const Epi& E) {
    const int tid = threadIdx.x, wid = __builtin_amdgcn_readfirstlane(tid >> 6), lane = tid & 63, wr = wid >> 2, wc = wid & 3, fr = lane & 15, fq = lane >> 4;
    const int K = g.K, nt = K / BK;
    unsigned voffA[2], voffB[2];
#pragma unroll
    for (int i = 0; i < 2; ++i) { int R, C; stage_rc(tid * 16 + i * 8192, R, C); const int Rb = Epi::PERM ? ((R & ~31) + perm32(R & 31)) : R;
        voffA[i] = (unsigned)(R * K + C) * 2u; voffB[i] = (unsigned)(Rb * K + C) * 2u; }
    const size_t kstep = (size_t)(BK * 2);
    const size_t hstep = (size_t)HALF * K * 2;
    const size_t tstep = 2 * hstep;
    const unsigned ldsw = (unsigned)wid * 1024u;
    const int aoff = lds_byte(wr * 64 + fr, fq * 8), boff = lds_byte(wc * 32 + fr, fq * 8);
#define PG8_SA(b, h) (((b) * 2 + (h)) * HTB)
#define PG8_SB(b, h) ((4 + (b) * 2 + (h)) * HTB)
#define PG8_STAGE(bufoff, gbase, voff) do { _Pragma("unroll") for (int _i = 0; _i < 2; ++_i) \
        __builtin_amdgcn_global_load_lds((const unsigned*)((const char*)(gbase) + (voff)[_i]), (PG8_LAS unsigned*)(lds + (bufoff) + ldsw + _i * 8192), 16, 0, 0); } while (0)
#define PG8_LDA(dst, b, h) do { _Pragma("unroll") for (int m = 0; m < 4; ++m) _Pragma("unroll") for (int k = 0; k < 2; ++k) dst[m][k] = *(const PG8_LAS bf16x8*)(lds + PG8_SA(b, h) + aoff + m * 2048 + k * 1024); } while (0)
#define PG8_LDB(dst, b, h) do { _Pragma("unroll") for (int n = 0; n < 2; ++n) _Pragma("unroll") for (int k = 0; k < 2; ++k) dst[n][k] = *(const PG8_LAS bf16x8*)(lds + PG8_SB(b, h) + boff + n * 2048 + k * 1024); } while (0)
#define PG8_MMA(ai, bj, At, Bt) do { __builtin_amdgcn_s_setprio(1); _Pragma("unroll") for (int m = 0; m < 4; ++m) _Pragma("unroll") for (int n = 0; n < 2; ++n) _Pragma("unroll") for (int k = 0; k < 2; ++k) \
        acc[ai][bj][m][n] = __builtin_amdgcn_mfma_f32_16x16x32_bf16(Bt[n][k], At[m][k], acc[ai][bj][m][n], 0, 0, 0); __builtin_amdgcn_s_setprio(0); } while (0)
#define PG8_WAIT_V(n) asm volatile("s_waitcnt vmcnt(" #n ")" ::: "memory")
#define PG8_WAIT_L(n) asm volatile("s_waitcnt lgkmcnt(" #n ")" ::: "memory")
#define PG8_BAR __builtin_amdgcn_s_barrier()
#define PG8_SCHED __builtin_amdgcn_sched_barrier(0)
    Unit cur, nxt; int ui = 0;
    if (!S.next(0, cur)) return;
    f32x4 acc[2][2][4][2];
#pragma unroll
    for (int a = 0; a < 2; ++a)
#pragma unroll
        for (int b = 0; b < 2; ++b)
#pragma unroll
            for (int m = 0; m < 4; ++m)
#pragma unroll
                for (int n = 0; n < 2; ++n) acc[a][b][m][n] = (f32x4){0.f, 0.f, 0.f, 0.f};
    bf16x8 At[4][2], B0[2][2], B1[2][2];
    const char* cA = (const char*)g.A + (size_t)cur.pm * tstep; const char* cB = (const char*)g.Bt + (size_t)cur.pn * tstep;
    S.a_ready(cur);
    if constexpr (SP2) {
        PG8_STAGE(PG8_SB(0, 0), cB, voffB); PG8_STAGE(PG8_SB(0, 1), cB + hstep, voffB); PG8_STAGE(PG8_SA(0, 0), cA, voffA); PG8_STAGE(PG8_SA(0, 1), cA + hstep, voffA);
        if (wr == 1) PG8_BAR;
        PG8_WAIT_V(2); PG8_BAR;
        PG8_STAGE(PG8_SB(1, 0), cB + kstep, voffB); PG8_STAGE(PG8_SA(1, 0), cA + kstep, voffA); PG8_STAGE(PG8_SB(1, 1), cB + hstep + kstep, voffB);
        PG8_WAIT_V(6); PG8_BAR;
    } else {
        PG8_STAGE(PG8_SB(0, 0), cB, voffB); PG8_STAGE(PG8_SA(0, 0), cA, voffA); PG8_STAGE(PG8_SB(0, 1), cB + hstep, voffB); PG8_STAGE(PG8_SA(0, 1), cA + hstep, voffA);
        if (wr == 1) PG8_BAR;
        PG8_WAIT_V(4); PG8_BAR;
        PG8_STAGE(PG8_SB(1, 0), cB + kstep, voffB); PG8_STAGE(PG8_SA(1, 0), cA + kstep, voffA); PG8_STAGE(PG8_SB(1, 1), cB + hstep + kstep, voffB);
        PG8_WAIT_V(6); PG8_BAR;
    }
    for (;;) {
        const bool has_next = S.next(ui + 1, nxt);
        const char* nA = has_next ? (const char*)g.A + (size_t)nxt.pm * tstep : cA; const char* nB = has_next ? (const char*)g.Bt + (size_t)nxt.pn * tstep : cB;
        for (int t = 0; t < nt; t += 2) {
            const bool last = (t == nt - 2);
            const char* a1 = cA + (size_t)(t + 1) * kstep;
            const char* a2 = last ? nA : cA + (size_t)(t + 2) * kstep; const char* b2 = last ? nB : cB + (size_t)(t + 2) * kstep;
            const char* a3 = a2 + kstep; const char* b3 = b2 + kstep;
            if (last && has_next) S.a_ready(nxt);
            if constexpr (SP2) {
            PG8_LDB(B0, 0, 0); PG8_LDB(B1, 0, 1); PG8_SCHED; PG8_LDA(At, 0, 0); PG8_STAGE(PG8_SA(1, 1), a1 + hstep, voffA);
            PG8_WAIT_V(8); PG8_WAIT_L(0); PG8_BAR; PG8_MMA(0, 0, At, B0); PG8_MMA(0, 1, At, B1); PG8_BAR; PG8_SCHED;
            PG8_LDA(At, 0, 1); PG8_STAGE(PG8_SB(0, 0), b2, voffB); PG8_STAGE(PG8_SB(0, 1), b2 + hstep, voffB); PG8_STAGE(PG8_SA(0, 0), a2, voffA);
            PG8_WAIT_V(8); PG8_WAIT_L(0); PG8_BAR; PG8_MMA(1, 0, At, B0); PG8_MMA(1, 1, At, B1); PG8_BAR; PG8_SCHED;
            PG8_LDB(B0, 1, 0); PG8_LDB(B1, 1, 1); PG8_SCHED; PG8_LDA(At, 1, 0); PG8_STAGE(PG8_SA(0, 1), a2 + hstep, voffA);
            PG8_WAIT_V(8); PG8_WAIT_L(0); PG8_BAR; PG8_MMA(0, 0, At, B0); PG8_MMA(0, 1, At, B1); PG8_BAR; PG8_SCHED;
            PG8_LDA(At, 1, 1); PG8_STAGE(PG8_SB(1, 0), b3, voffB); PG8_STAGE(PG8_SB(1, 1), b3 + hstep, voffB); PG8_STAGE(PG8_SA(1, 0), a3, voffA);
            PG8_WAIT_V(8); PG8_WAIT_L(0); PG8_BAR; PG8_MMA(1, 0, At, B0); PG8_MMA(1, 1, At, B1); PG8_BAR; PG8_SCHED;
            } else {
            PG8_LDB(B0, 0, 0); PG8_SCHED; PG8_LDA(At, 0, 0); PG8_STAGE(PG8_SA(1, 1), a1 + hstep, voffA);
            PG8_WAIT_L(8); PG8_BAR; PG8_WAIT_L(0); PG8_MMA(0, 0, At, B0); PG8_BAR; PG8_SCHED;
            PG8_LDB(B1, 0, 1); PG8_STAGE(PG8_SB(0, 0), b2, voffB);
            PG8_BAR; PG8_WAIT_L(0); PG8_MMA(0, 1, At, B1); PG8_BAR;
            PG8_LDA(At, 0, 1); PG8_STAGE(PG8_SA(0, 0), a2, voffA);
            PG8_BAR; PG8_WAIT_L(0); PG8_MMA(1, 0, At, B0); PG8_BAR; PG8_SCHED;
            PG8_STAGE(PG8_SB(0, 1), b2 + hstep, voffB);
            PG8_WAIT_V(6); PG8_BAR; PG8_MMA(1, 1, At, B1); PG8_BAR;
            PG8_LDB(B0, 1, 0); PG8_SCHED; PG8_LDA(At, 1, 0); PG8_STAGE(PG8_SA(0, 1), a2 + hstep, voffA);
            PG8_WAIT_L(8); PG8_BAR; PG8_WAIT_L(0); PG8_MMA(0, 0, At, B0); PG8_BAR; PG8_SCHED;
            PG8_LDB(B1, 1, 1); PG8_STAGE(PG8_SB(1, 0), b3, voffB);
            PG8_BAR; PG8_WAIT_L(0); PG8_MMA(0, 1, At, B1); PG8_BAR;
            PG8_LDA(At, 1, 1); PG8_STAGE(PG8_SA(1, 0), a3, voffA);
            PG8_BAR; PG8_WAIT_L(0); PG8_MMA(1, 0, At, B0); PG8_BAR; PG8_SCHED;
            PG8_STAGE(PG8_SB(1, 1), b3 + hstep, voffB);
            PG8_WAIT_V(6); PG8_BAR; PG8_MMA(1, 1, At, B1); PG8_BAR;
            }
        }
        if constexpr (ALIGN_EPI) { if (wr == 0) PG8_BAR; }
        if constexpr (!Epi::AFTER_DRAIN) { E(acc, cur, wr, wc, fr, fq); S.done(cur); }
        if (!has_next) break;
#pragma unroll
        for (int a = 0; a < 2; ++a)
#pragma unroll
            for (int b = 0; b < 2; ++b)
#pragma unroll
                for (int m = 0; m < 4; ++m)
#pragma unroll
                    for (int n = 0; n < 2; ++n) acc[a][b][m][n] = (f32x4){0.f, 0.f, 0.f, 0.f};
        cur = nxt; cA = nA; cB = nB; ++ui;
        if constexpr (ALIGN_EPI) { if (wr == 1) PG8_BAR; }
    }
    PG8_WAIT_V(0);
    if constexpr (!ALIGN_EPI) { if (wr == 0) PG8_BAR; }
    PG8_BAR;
    if constexpr (Epi::AFTER_DRAIN) { E.fused(acc, cur, wr, wc, fr, fq, lds, wid, lane); S.done(cur); }
#undef PG8_SA
#undef PG8_SB
#undef PG8_STAGE
#undef PG8_LDA
#undef PG8_LDB
#undef PG8_MMA
#undef PG8_WAIT_V
#undef PG8_WAIT_L
#undef PG8_BAR
#undef PG8_SCHED
}
}
#define GAS __attribute__((address_space(1)))
#define LAS __attribute__((address_space(3)))
typedef unsigned short bf16;
typedef unsigned v4u __attribute__((ext_vector_type(4)));
typedef unsigned v2u __attribute__((ext_vector_type(2)));
typedef float f32x4 __attribute__((ext_vector_type(4)));
typedef float f32x16 __attribute__((ext_vector_type(16)));
typedef short bf16x8 __attribute__((ext_vector_type(8)));
#define LDS_WAIT() asm volatile("s_waitcnt lgkmcnt(0)" ::: "memory")

#ifndef MK_N_LAUNCHES
#define MK_N_LAUNCHES 1
#endif
#ifndef MK_NAIVE_ATTN
#define MK_NAIVE_ATTN 0
#endif
constexpr int NWAVES = 8, NPH = 8;
constexpr int BATCH = 4, SEQ = 8192, D = 1024, NH = 12, HD = 64, AW = 768, GWD = 256, NG = 4, INW = 2816, FF = 4096, M = BATCH * SEQ, CHUNK = 128;
constexpr float EPS = 1e-6f;
constexpr size_t MiB = 1u << 20;
constexpr size_t WS_WIN = 2 * MiB, WS_WOUT = 8 * MiB, WS_W1 = 10 * MiB, WS_W2 = 18 * MiB, WS_SS1 = 26 * MiB, WS_SS2 = 28 * MiB, WS_LSE = 30 * MiB, WS_GM = 36 * MiB,
                 WS_XN = 64 * MiB, WS_PROJ = 128 * MiB, WS_OP = 304 * MiB, WS_H1B = 128 * MiB, WS_HID = 192 * MiB, WS_END = 448 * MiB;
static_assert(WS_WIN + (size_t)INW * D * 2 <= WS_WOUT && WS_LSE + (size_t)3 * M * NH * 4 <= WS_GM && WS_GM + (size_t)M * GWD * 2 <= WS_XN && WS_PROJ + (size_t)M * INW * 2 <= WS_OP && WS_OP + (size_t)3 * M * AW * 2 <= WS_END && WS_HID + (size_t)M * FF * 2 <= WS_END, "ws map");
constexpr int LDS_BYTES = 147456;

__device__ __forceinline__ float bflo(unsigned u) { return __uint_as_float(u << 16); }
__device__ __forceinline__ float bfhi(unsigned u) { return __uint_as_float(u & 0xffff0000u); }
__device__ __forceinline__ unsigned pk2(float lo, float hi) { return pg8::cvt_pk_bf16(lo, hi); }
__device__ __forceinline__ float wave_sum(float v) {
#pragma unroll
    for (int o = 1; o < 64; o <<= 1) v += __shfl_xor(v, o);
    return v;
}
__device__ __forceinline__ float gelu_t(float x) { const float y = 0.7978845608028654f * (x + 0.044715f * x * x * x); return x / (1.0f + __expf(-2.0f * y)); }

__device__ __forceinline__ void p0_transpose_item(const float* W, int K, int N, bf16* WT, const float* gk, int qcols, LAS float* scr, int item, int lane) {
    const int nblk = N / 32, kb = item / nblk, nb = item % nblk, k0 = 64 * kb, n0 = 32 * nb;
#pragma unroll 8
    for (int i = 0; i < 32; ++i) { const int kk = 2 * i + (lane >> 5); const float g = gk ? gk[k0 + kk] : 1.0f; scr[kk * 33 + (lane & 31)] = W[(size_t)(k0 + kk) * N + n0 + (lane & 31)] * g; }
    LDS_WAIT();
    const int c = lane & 7;
#pragma unroll
    for (int j = 0; j < 4; ++j) { const int n = (lane >> 3) + 8 * j; const LAS float* s = scr + (8 * c) * 33 + n; const float sc = (n0 + n < qcols) ? 0.125f : 1.0f;
        v4u o; o.x = pk2(s[0 * 33] * sc, s[1 * 33] * sc); o.y = pk2(s[2 * 33] * sc, s[3 * 33] * sc); o.z = pk2(s[4 * 33] * sc, s[5 * 33] * sc); o.w = pk2(s[6 * 33] * sc, s[7 * 33] * sc);
        *(v4u*)(WT + (size_t)(n0 + n) * K + k0 + 8 * c) = o; }
    LDS_WAIT();
}
__device__ __forceinline__ void rms_row_to_bf16(const float* xrow, bf16* orow, int lane) {
    const f32x4* xr = (const f32x4*)xrow + lane;
    f32x4 v[4]; float s = 0.f;
#pragma unroll
    for (int j = 0; j < 4; ++j) { v[j] = xr[64 * j]; s += (v[j].x * v[j].x + v[j].y * v[j].y) + (v[j].z * v[j].z + v[j].w * v[j].w); }
    const float rstd = 1.0f / sqrtf(wave_sum(s) * (1.0f / D) + EPS);
    v2u* o8 = (v2u*)orow + lane;
#pragma unroll
    for (int j = 0; j < 4; ++j) { v2u w; w.x = pk2(v[j].x * rstd, v[j].y * rstd); w.y = pk2(v[j].z * rstd, v[j].w * rstd); o8[64 * j] = w; }
}

__device__ __forceinline__ void gmlp_unit(LAS unsigned char* lds, const bf16* PROJ, const float* ln_g, const float* ln_b, const float* sgu_w, const float* sgu_b, bf16* GM, int unit, int tid) {
    const int g = unit & 3, n = (unit >> 2) & 63, b = unit >> 8;
    const size_t row0 = (size_t)b * SEQ + (size_t)n * CHUNK;
    LAS float* zn = (LAS float*)lds;
    LAS float* wl = (LAS float*)(lds + 128 * 68 * 4);
    const float* wg = sgu_w + (size_t)g * CHUNK * CHUNK;
    for (int i = tid; i < CHUNK * CHUNK; i += NWAVES * 64) wl[(i >> 7) * 129 + (i & 127)] = wg[i];
    {
        const int t = tid >> 2, q = tid & 3;
        const bf16* zp = PROJ + (row0 + t) * INW + 2560 + g * 64 + 16 * q;
        const v4u r0 = *(const v4u*)zp, r1 = *(const v4u*)(zp + 8);
        float z[16];
        z[0] = bflo(r0.x); z[1] = bfhi(r0.x); z[2] = bflo(r0.y); z[3] = bfhi(r0.y); z[4] = bflo(r0.z); z[5] = bfhi(r0.z); z[6] = bflo(r0.w); z[7] = bfhi(r0.w);
        z[8] = bflo(r1.x); z[9] = bfhi(r1.x); z[10] = bflo(r1.y); z[11] = bfhi(r1.y); z[12] = bflo(r1.z); z[13] = bfhi(r1.z); z[14] = bflo(r1.w); z[15] = bfhi(r1.w);
        float s = 0.f;
#pragma unroll
        for (int e = 0; e < 16; ++e) { z[e] = gelu_t(z[e]); s += z[e]; }
        s += __shfl_xor(s, 1); s += __shfl_xor(s, 2);
        const float mean = s * (1.0f / 64.0f); float v = 0.f;
#pragma unroll
        for (int e = 0; e < 16; ++e) { z[e] -= mean; v += z[e] * z[e]; }
        v += __shfl_xor(v, 1); v += __shfl_xor(v, 2);
        const float rstd = 1.0f / sqrtf(v * (1.0f / 64.0f) + EPS);
        const float* lg = ln_g + g * 64 + 16 * q; const float* lb = ln_b + g * 64 + 16 * q;
#pragma unroll
        for (int e4 = 0; e4 < 4; ++e4) { f32x4 o;
#pragma unroll
            for (int e = 0; e < 4; ++e) o[e] = z[4 * e4 + e] * rstd * lg[4 * e4 + e] + lb[4 * e4 + e];
            *(LAS f32x4*)(zn + t * 68 + 16 * q + 4 * e4) = o; }
    }
    __syncthreads();
    const int wv = __builtin_amdgcn_readfirstlane(tid >> 6), lane = tid & 63, tr = lane >> 3, cq = lane & 7;
#pragma unroll 1
    for (int half = 0; half < 2; ++half) {
        const int blk = half ? 15 - wv : wv, t = 8 * blk + tr, smax = 8 * blk + 7;
        float acc[8];
#pragma unroll
        for (int e = 0; e < 8; ++e) acc[e] = 0.f;
#pragma unroll 4
        for (int s = 0; s <= smax; ++s) {
            float w = wl[t * 129 + s]; w = (s <= t) ? w : 0.f;
            const f32x4 z0 = *(const LAS f32x4*)(zn + s * 68 + 8 * cq), z1 = *(const LAS f32x4*)(zn + s * 68 + 8 * cq + 4);
#pragma unroll
            for (int e = 0; e < 4; ++e) { acc[e] += w * z0[e]; acc[4 + e] += w * z1[e]; }
        }
        const v4u ur = *(const v4u*)(PROJ + (row0 + t) * INW + 2304 + g * 64 + 8 * cq);
        const float bs = sgu_b[g * CHUNK + t];
        float u[8]; u[0] = bflo(ur.x); u[1] = bfhi(ur.x); u[2] = bflo(ur.y); u[3] = bfhi(ur.y); u[4] = bflo(ur.z); u[5] = bfhi(ur.z); u[6] = bflo(ur.w); u[7] = bfhi(ur.w);
#pragma unroll
        for (int e = 0; e < 8; ++e) u[e] = gelu_t(u[e]) * (acc[e] + bs);
        v4u o; o.x = pk2(u[0], u[1]); o.y = pk2(u[2], u[3]); o.z = pk2(u[4], u[5]); o.w = pk2(u[6], u[7]);
        *(v4u*)(GM + (row0 + t) * GWD + g * 64 + 8 * cq) = o;
    }
    __syncthreads();
}

__device__ __forceinline__ float alibi_slope(int h) { return (h < 8) ? exp2f(-(float)(h + 1)) : exp2f(-0.5f - (float)(h - 8)); }

#if MK_NAIVE_ATTN
__device__ __forceinline__ void attn_naive(const bf16* PROJ, bf16* OP, float* LSE, int gtid, int nthreads) {
#pragma unroll 1
    for (int it = gtid; it < M * NH * 3; it += nthreads) {
        const int h = it % NH, row = (it / NH) % M, p = it / (NH * M), dil = 1 << (2 * p), t = row % SEQ;
        const float slope = alibi_slope(h);
        const bf16* qp = PROJ + (size_t)row * INW + h * 64;
        float q[64], o[64];
#pragma unroll
        for (int c = 0; c < 8; ++c) { const v4u r = *(const v4u*)(qp + 8 * c); q[8*c] = bflo(r.x); q[8*c+1] = bfhi(r.x); q[8*c+2] = bflo(r.y); q[8*c+3] = bfhi(r.y); q[8*c+4] = bflo(r.z); q[8*c+5] = bfhi(r.z); q[8*c+6] = bflo(r.w); q[8*c+7] = bfhi(r.w); }
#pragma unroll
        for (int e = 0; e < 64; ++e) o[e] = 0.f;
        float m = -1e30f, l = 0.f;
#pragma unroll 1
        for (int j = 0; j <= 128; ++j) {
            const int tk = t - dil * j; if (tk < 0) break;
            const bf16* kp = qp + 768 - (size_t)(dil * j) * INW; const bf16* vp = kp + 768;
            float dot = 0.f;
#pragma unroll
            for (int c = 0; c < 8; ++c) { const v4u r = *(const v4u*)(kp + 8 * c);
                dot += q[8*c] * bflo(r.x) + q[8*c+1] * bfhi(r.x) + q[8*c+2] * bflo(r.y) + q[8*c+3] * bfhi(r.y) + q[8*c+4] * bflo(r.z) + q[8*c+5] * bfhi(r.z) + q[8*c+6] * bflo(r.w) + q[8*c+7] * bfhi(r.w); }
            const float s = dot - slope * (float)(dil * j);
            const float mn = fmaxf(m, s), sc = __expf(m - mn), pe = __expf(s - mn);
            l = l * sc + pe; m = mn;
#pragma unroll
            for (int c = 0; c < 8; ++c) { const v4u r = *(const v4u*)(vp + 8 * c);
                o[8*c] = o[8*c] * sc + pe * bflo(r.x); o[8*c+1] = o[8*c+1] * sc + pe * bfhi(r.x); o[8*c+2] = o[8*c+2] * sc + pe * bflo(r.y); o[8*c+3] = o[8*c+3] * sc + pe * bfhi(r.y);
                o[8*c+4] = o[8*c+4] * sc + pe * bflo(r.z); o[8*c+5] = o[8*c+5] * sc + pe * bfhi(r.z); o[8*c+6] = o[8*c+6] * sc + pe * bflo(r.w); o[8*c+7] = o[8*c+7] * sc + pe * bfhi(r.w); }
        }
        const float il = 1.0f / l;
        bf16* op = OP + ((size_t)p * M + row) * AW + h * 64;
#pragma unroll
        for (int c = 0; c < 8; ++c) { v4u w; w.x = pk2(o[8*c] * il, o[8*c+1] * il); w.y = pk2(o[8*c+2] * il, o[8*c+3] * il); w.z = pk2(o[8*c+4] * il, o[8*c+5] * il); w.w = pk2(o[8*c+6] * il, o[8*c+7] * il); *(v4u*)(op + 8 * c) = w; }
        LSE[((size_t)p * M + row) * NH + h] = m + __logf(l);
    }
}
#endif

__device__ __forceinline__ void mixnorm_row(const bf16* OP, const float* LSE, const bf16* GM, bf16* MIXED, int row, int lane) {
    float a[3][4]; float ssa = 0.f;
#pragma unroll
    for (int j = 0; j < 3; ++j) {
        const int c = 256 * j + 4 * lane, head = c >> 6;
        float ls[3];
#pragma unroll
        for (int p = 0; p < 3; ++p) ls[p] = LSE[((size_t)p * M + row) * NH + head];
        const float mx = fmaxf(ls[0], fmaxf(ls[1], ls[2]));
        float w[3]; float wsum = 0.f;
#pragma unroll
        for (int p = 0; p < 3; ++p) { w[p] = __expf(ls[p] - mx); wsum += w[p]; }
        const float iw = 1.0f / wsum;
#pragma unroll
        for (int e = 0; e < 4; ++e) a[j][e] = 0.f;
#pragma unroll
        for (int p = 0; p < 3; ++p) { const v2u r = *(const v2u*)(OP + ((size_t)p * M + row) * AW + c); const float wp = w[p] * iw;
            a[j][0] += wp * bflo(r.x); a[j][1] += wp * bfhi(r.x); a[j][2] += wp * bflo(r.y); a[j][3] += wp * bfhi(r.y); }
#pragma unroll
        for (int e = 0; e < 4; ++e) ssa += a[j][e] * a[j][e];
    }
    const v2u gr = *(const v2u*)(GM + (size_t)row * GWD + 4 * lane);
    float gv[4]; gv[0] = bflo(gr.x); gv[1] = bfhi(gr.x); gv[2] = bflo(gr.y); gv[3] = bfhi(gr.y);
    float ssg = (gv[0] * gv[0] + gv[1] * gv[1]) + (gv[2] * gv[2] + gv[3] * gv[3]);
    const float ra = 1.0f / sqrtf(wave_sum(ssa) * (1.0f / AW) + EPS), rg = 1.0f / sqrtf(wave_sum(ssg) * (1.0f / GWD) + EPS);
    bf16* mp = MIXED + (size_t)row * D;
#pragma unroll
    for (int j = 0; j < 3; ++j) { v2u w; w.x = pk2(a[j][0] * ra, a[j][1] * ra); w.y = pk2(a[j][2] * ra, a[j][3] * ra); *(v2u*)(mp + 256 * j + 4 * lane) = w; }
    { v2u w; w.x = pk2(gv[0] * rg, gv[1] * rg); w.y = pk2(gv[2] * rg, gv[3] * rg); *(v2u*)(mp + AW + 4 * lane) = w; }
}
#if !MK_NAIVE_ATTN
typedef short v4i16_t __attribute__((ext_vector_type(4)));
typedef float f32x2_t __attribute__((ext_vector_type(2)));
typedef __bf16 bf16x2_t __attribute__((ext_vector_type(2)));
__device__ __forceinline__ unsigned cvtpk_s(float lo, float hi) { f32x2_t v = {lo, hi}; bf16x2_t b = __builtin_convertvector(v, bf16x2_t); return __builtin_bit_cast(unsigned, b); }
__device__ __forceinline__ v4i16_t vtr(const LAS unsigned char* p) { return __builtin_amdgcn_ds_read_tr16_b64_v4i16((LAS v4i16_t*)p); }
__device__ __forceinline__ float xhalf_max(float v) { auto rr = __builtin_amdgcn_permlane32_swap(__float_as_uint(v), __float_as_uint(v), false, false); return fmaxf(__uint_as_float(rr[0]), __uint_as_float(rr[1])); }
__device__ __forceinline__ float xhalf_sum(float v) { auto rr = __builtin_amdgcn_permlane32_swap(__float_as_uint(v), __float_as_uint(v), false, false); return __uint_as_float(rr[0]) + __uint_as_float(rr[1]); }

__device__ __forceinline__ void attn_phase(LAS unsigned char* lds, const bf16* PROJ, bf16* OP, float* LSE, int gw, int NGW, int wave, int lane) {
    constexpr float LOG2E = 1.4426950408889634f, LN2 = 0.6931471805599453f;
    LAS unsigned char* vl = lds + wave * 6144;
    const int ql = lane & 31, h2 = lane >> 5;
    LAS unsigned char* vwr = vl + (lane >> 3) * 192 + (lane & 7) * 16;
    const LAS unsigned char* vrd = vl + (4 * h2 + ((lane & 15) >> 2)) * 192 + (((lane >> 4) & 1) * 16 + (lane & 3) * 4) * 2;
    constexpr int NITEMS = 3 * BATCH * NH * 256;
#pragma unroll 1
    for (int item = gw; item < NITEMS; item += NGW) {
        const int grp = item & 255, p = (item >> 8) % 3, bh = item / 768, b = bh / NH, h = bh - b * NH;
        const int dsh = 2 * p, dil = 1 << dsh, gpr = 256 >> dsh, r = grp >> (8 - dsh), i0 = 32 * (grp & (gpr - 1));
        const float c2 = alibi_slope(h) * (float)dil * LOG2E;
        const size_t rowb = (size_t)b * SEQ + r;
        const bf16* qkv = PROJ + h * 64;
        bf16x8 qf[4];
        { const bf16* qp = qkv + (rowb + (size_t)(i0 + ql) * dil) * INW + 8 * h2;
#pragma unroll
          for (int s = 0; s < 4; ++s) qf[s] = *(const bf16x8*)(qp + 16 * s); }
        f32x16 o0, o1;
#pragma unroll
        for (int e = 0; e < 16; ++e) { o0[e] = 0.f; o1[e] = 0.f; }
        float m = -1e30f, l = 0.f;
        bf16x8 kf[4]; v4u vr[4];
#define ATT_LOAD(kt_) do { int kk_ = i0 - 128 + 32 * (kt_); kk_ = kk_ < 0 ? 0 : kk_; \
            const bf16* kp_ = qkv + AW + (rowb + (size_t)(kk_ + ql) * dil) * INW + 8 * h2; \
            _Pragma("unroll") for (int s = 0; s < 4; ++s) kf[s] = *(const bf16x8*)(kp_ + 16 * s); \
            const bf16* vp_ = qkv + 2 * AW + (rowb + (size_t)(kk_ + (lane >> 3)) * dil) * INW + (lane & 7) * 8; \
            _Pragma("unroll") for (int it = 0; it < 4; ++it) vr[it] = *(const v4u*)(vp_ + (size_t)(it * 8 * dil) * INW); } while (0)
        ATT_LOAD(0);
#pragma unroll
        for (int kt = 0; kt < 5; ++kt) {
            const int k0 = i0 - 128 + 32 * kt;
#pragma unroll
            for (int it = 0; it < 4; ++it) *(LAS v4u*)(vwr + it * 8 * 192) = vr[it];
            bf16x8 kc[4];
#pragma unroll
            for (int s = 0; s < 4; ++s) kc[s] = kf[s];
            if (kt < 4) ATT_LOAD(kt + 1);
            if (k0 >= 0) {
                f32x16 sa;
#pragma unroll
                for (int e = 0; e < 16; ++e) sa[e] = 0.f;
#pragma unroll
                for (int s = 0; s < 4; ++s) sa = __builtin_amdgcn_mfma_f32_32x32x16_bf16(kc[s], qf[s], sa, 0, 0, 0);
                const float lb = -c2 * (float)(128 - 32 * kt + ql - 4 * h2);
                float sc[16]; float mx = -INFINITY;
#pragma unroll
                for (int e = 0; e < 16; ++e) { const int kr = (e & 3) + 8 * (e >> 2);
                    float s = fmaf(sa[e], LOG2E, lb); s = fmaf(c2, (float)kr, s);
                    if (kt == 0) s = (kr + 4 * h2 >= ql) ? s : -INFINITY;
                    if (kt == 4) s = (kr + 4 * h2 <= ql) ? s : -INFINITY;
                    sc[e] = s; mx = fmaxf(mx, s); }
                mx = xhalf_max(mx);
                const float mn = fmaxf(m, mx), alpha = __builtin_amdgcn_exp2f(m - mn); m = mn;
                float ls = 0.f;
#pragma unroll
                for (int e = 0; e < 16; ++e) { sc[e] = __builtin_amdgcn_exp2f(sc[e] - mn); ls += sc[e]; }
                l = l * alpha + ls;
#pragma unroll
                for (int e = 0; e < 16; ++e) { o0[e] *= alpha; o1[e] *= alpha; }
#pragma unroll
                for (int s2 = 0; s2 < 2; ++s2) {
                    v4u pw; pw.x = cvtpk_s(sc[8 * s2], sc[8 * s2 + 1]); pw.y = cvtpk_s(sc[8 * s2 + 2], sc[8 * s2 + 3]); pw.z = cvtpk_s(sc[8 * s2 + 4], sc[8 * s2 + 5]); pw.w = cvtpk_s(sc[8 * s2 + 6], sc[8 * s2 + 7]);
                    const bf16x8 pb = __builtin_bit_cast(bf16x8, pw);
                    { const v4i16_t a = vtr(vrd + (16 * s2) * 192), c = vtr(vrd + (16 * s2 + 8) * 192);
                      const bf16x8 vf = {a[0], a[1], a[2], a[3], c[0], c[1], c[2], c[3]};
                      o0 = __builtin_amdgcn_mfma_f32_32x32x16_bf16(vf, pb, o0, 0, 0, 0); }
                    { const v4i16_t a = vtr(vrd + (16 * s2) * 192 + 64), c = vtr(vrd + (16 * s2 + 8) * 192 + 64);
                      const bf16x8 vf = {a[0], a[1], a[2], a[3], c[0], c[1], c[2], c[3]};
                      o1 = __builtin_amdgcn_mfma_f32_32x32x16_bf16(vf, pb, o1, 0, 0, 0); }
                }
            }
        }
#undef ATT_LOAD
        const float lt = xhalf_sum(l), il = 1.0f / lt;
        const size_t row = rowb + (size_t)(i0 + ql) * dil;
        bf16* op = OP + ((size_t)p * M + row) * AW + h * 64 + 4 * h2;
#pragma unroll
        for (int g4 = 0; g4 < 4; ++g4) {
            v2u w0; w0.x = cvtpk_s(o0[4 * g4] * il, o0[4 * g4 + 1] * il); w0.y = cvtpk_s(o0[4 * g4 + 2] * il, o0[4 * g4 + 3] * il); *(v2u*)(op + 8 * g4) = w0;
            v2u w1; w1.x = cvtpk_s(o1[4 * g4] * il, o1[4 * g4 + 1] * il); w1.y = cvtpk_s(o1[4 * g4 + 2] * il, o1[4 * g4 + 3] * il); *(v2u*)(op + 32 + 8 * g4) = w1;
        }
        if (h2 == 0) LSE[((size_t)p * M + row) * NH + h] = (m + __log2f(lt)) * LN2;
    }
}
#endif
struct Args { const float* in[14]; float* out; unsigned char* ws; int ph_lo, ph_hi; };
__global__ void __launch_bounds__(NWAVES * 64, 2) hymba_fwd(Args args) {
    extern __shared__ __attribute__((aligned(16))) unsigned char lds_raw[];
    LAS unsigned char* lds = (LAS unsigned char*)lds_raw;
    cg::grid_group grid = cg::this_grid();
    const int tid = threadIdx.x, lane = tid & 63, wave = __builtin_amdgcn_readfirstlane(tid >> 6);
    const int G = gridDim.x, bx = blockIdx.x;
    const int vcu = (G % 8 == 0) ? (bx % 8) * (G / 8) + bx / 8 : bx;
    const int gw = vcu * NWAVES + wave, NGW = G * NWAVES;
    unsigned char* ws = args.ws;
    const float* x = args.in[0]; const float* norm1_g = args.in[1]; const float* w_in = args.in[2]; const float* sgu_ln_g = args.in[3]; const float* sgu_ln_b = args.in[4];
    const float* sgu_w = args.in[5]; const float* sgu_b = args.in[6]; const float* attn_out_g = args.in[7]; const float* gmlp_out_g = args.in[8]; const float* w_out = args.in[9];
    const float* norm2_g = args.in[10]; const float* w_ff1 = args.in[11]; const float* w_ff2 = args.in[12]; const float* final_g = args.in[13];
    float* out = args.out;
    bf16* WIN = (bf16*)(ws + WS_WIN); bf16* WOUT = (bf16*)(ws + WS_WOUT); bf16* W1 = (bf16*)(ws + WS_W1); bf16* W2 = (bf16*)(ws + WS_W2);
    float* SS1 = (float*)(ws + WS_SS1); float* SS2 = (float*)(ws + WS_SS2); float* LSE = (float*)(ws + WS_LSE);
    bf16* GM = (bf16*)(ws + WS_GM); bf16* XN = (bf16*)(ws + WS_XN); bf16* PROJ = (bf16*)(ws + WS_PROJ); bf16* OP = (bf16*)(ws + WS_OP);
    bf16* H1B = (bf16*)(ws + WS_H1B); bf16* HID = (bf16*)(ws + WS_HID);
    const int lo = args.ph_lo, hi = args.ph_hi;
#define IN(k) (lo <= (k) && (k) < hi)
#define SEAM(k) do { if (IN(k) && IN((k) + 1)) grid.sync(); } while (0)

    if (IN(0)) {
        LAS float* scr = (LAS float*)(lds + wave * 16384);
        constexpr int I_IN = (D / 64) * (INW / 32), I_O = (D / 64) * (D / 32), I_1 = (D / 64) * (FF / 32), I_2 = (FF / 64) * (D / 32);
        constexpr int NITEMS = I_IN + I_O + I_1 + I_2;
#pragma unroll 1
        for (int it = gw; it < NITEMS; it += NGW) {
            int r = it;
            if (r < I_IN) { p0_transpose_item(w_in, D, INW, WIN, norm1_g, AW, scr, r, lane); continue; } r -= I_IN;
            if (r < I_O) { p0_transpose_item(w_out, D, D, WOUT, (r / (D / 32)) < (AW / 64) ? attn_out_g : gmlp_out_g - AW, 0, scr, r, lane); continue; } r -= I_O;
            if (r < I_1) { p0_transpose_item(w_ff1, D, FF, W1, norm2_g, 0, scr, r, lane); continue; } r -= I_1;
            p0_transpose_item(w_ff2, FF, D, W2, nullptr, 0, scr, r, lane);
        }
#pragma unroll 1
        for (int m = gw; m < M; m += NGW) rms_row_to_bf16(x + (size_t)m * D, XN + (size_t)m * D, lane);
    }
    SEAM(0);
    if (IN(1)) {
        pg8::Gemm g{XN, WIN, M, INW, D}; pg8::StaticOrder S; S.init(M, INW, G, bx);
        pg8::EpiBf16 E{PROJ, INW};
        pg8::gemm_phase<pg8::EpiBf16, pg8::StaticOrder, true, true>(lds, g, S, E);
    }
    SEAM(1);
    if (IN(2)) {
#pragma unroll 1
        for (int u = vcu; u < BATCH * (SEQ / CHUNK) * NG; u += G) gmlp_unit(lds, PROJ, sgu_ln_g, sgu_ln_b, sgu_w, sgu_b, GM, u, tid);
#if MK_NAIVE_ATTN
        attn_naive(PROJ, OP, LSE, bx * (NWAVES * 64) + tid, G * NWAVES * 64);
#else
        attn_phase(lds, PROJ, OP, LSE, gw, NGW, wave, lane);
#endif
    }
    SEAM(2);
    if (IN(3)) {
#pragma unroll 1
        for (int m = gw; m < M; m += NGW) mixnorm_row(OP, LSE, GM, XN, m, lane);
    }
    SEAM(3);
    if (IN(4)) {
        pg8::Gemm g{XN, WOUT, M, D, D}; pg8::StaticOrder S; S.init(M, D, G, bx);
        pg8::EpiRes<true> E{x, out, H1B, SS1, D};
        pg8::gemm_phase<pg8::EpiRes<true>, pg8::StaticOrder, true, true>(lds, g, S, E);
    }
    SEAM(4);
    if (IN(5)) {
        pg8::Gemm g{H1B, W1, M, FF, D}; pg8::StaticOrder S; S.init(M, FF, G, bx);
        pg8::EpiSqRelu E{HID, FF, SS1};
        pg8::gemm_phase<pg8::EpiSqRelu, pg8::StaticOrder, true, true>(lds, g, S, E);
    }
    SEAM(5);
    if (IN(6)) {
        pg8::Gemm g{HID, W2, M, D, FF}; pg8::StaticOrder S; S.init(M, D, G, bx);
        pg8::EpiRes<false> E{out, out, nullptr, SS2, D};
        pg8::gemm_phase<pg8::EpiRes<false>, pg8::StaticOrder, true, true>(lds, g, S, E);
    }
    SEAM(6);
    if (IN(7)) {
#pragma unroll 1
        for (int m = gw; m < M; m += NGW) {
            f32x4* orow = (f32x4*)(out + (size_t)m * D) + lane;
            float s = SS2[(size_t)m * 16 + (lane & 15)];
            s += __shfl_xor(s, 1); s += __shfl_xor(s, 2); s += __shfl_xor(s, 4); s += __shfl_xor(s, 8);
            const float rstd = 1.0f / sqrtf(s * (1.0f / D) + EPS);
#pragma unroll
            for (int j = 0; j < 4; ++j) { const f32x4 v = orow[64 * j]; const f32x4 gq = *((const f32x4*)final_g + lane + 64 * j); orow[64 * j] = v * rstd * gq; }
        }
    }
#undef IN
#undef SEAM
}

extern "C" void kernel_launch(void* const* d_in, const int* in_sizes, int n_in, void* d_out, int out_size, void* d_ws, size_t ws_size, hipStream_t stream) {
    static int grid = 0;
    if (grid == 0) {
        if (n_in != 14 || in_sizes[0] != M * D || out_size != M * D || ws_size < WS_END) { fprintf(stderr, "kernel_launch: unexpected shapes (n_in %d, in0 %d, out %d, ws %zu); nothing launched\n", n_in, n_in > 0 ? in_sizes[0] : -1, out_size, ws_size); grid = -1; return; }
        int dev = 0, cus = 0, per_cu = 0;
        if (hipGetDevice(&dev) != hipSuccess || hipDeviceGetAttribute(&cus, hipDeviceAttributeMultiprocessorCount, dev) != hipSuccess) { grid = -1; return; }
        if (hipFuncSetAttribute((const void*)hymba_fwd, hipFuncAttributeMaxDynamicSharedMemorySize, LDS_BYTES) != hipSuccess) { fprintf(stderr, "kernel_launch: hipFuncSetAttribute failed\n"); grid = -1; return; }
        if (hipOccupancyMaxActiveBlocksPerMultiprocessor(&per_cu, (const void*)hymba_fwd, NWAVES * 64, LDS_BYTES) != hipSuccess || per_cu < 1) { fprintf(stderr, "kernel_launch: occupancy query says %d blocks per CU\n", per_cu); per_cu = 1; }
        (void)hipGetLastError();
        grid = cus;
    }
    if (grid < 0) return;
    Args a{};
    for (int i = 0; i < 14; ++i) a.in[i] = (const float*)d_in[i];
    a.out = (float*)d_out; a.ws = (unsigned char*)d_ws;
#if MK_N_LAUNCHES == 1
    a.ph_lo = 0; a.ph_hi = NPH;
    void* kargs[] = {&a};
    hipError_t e = hipLaunchCooperativeKernel((const void*)hymba_fwd, dim3(grid), dim3(NWAVES * 64), kargs, LDS_BYTES, stream);
    if (e != hipSuccess) fprintf(stderr, "kernel_launch: cooperative launch failed: %s (grid %d)\n", hipGetErrorString(e), grid);
#else
    for (int ph = 0; ph < NPH; ++ph) {
        a.ph_lo = ph; a.ph_hi = ph + 1;
        hipLaunchKernelGGL(hymba_fwd, dim3(grid), dim3(NWAVES * 64), LDS_BYTES, stream, a);
    }
#endif
}
```

```cpp
#include <hip/hip_runtime.h>
#include <hip/hip_cooperative_groups.h>
#include <cstdio>
#include <cstdint>
namespace cg = cooperative_groups;
#define MK_NAIVE_ATTN 0
#define MK_N_LAUNCHES 1
#define MK_DBL -1
namespace pg8 {
#define PG8_LAS __attribute__((address_space(3)))
typedef unsigned short bf16_t;
typedef short bf16x8 __attribute__((ext_vector_type(8)));
typedef float f32x4 __attribute__((ext_vector_type(4)));
typedef unsigned u32x4 __attribute__((ext_vector_type(4)));
constexpr int BM = 256, BK = 64, HALF = 128, HTB = HALF * BK * 2  , STAGE_BYTES = 8 * HTB, NXCD = 8, WGM = 8;

__host__ __device__ __forceinline__ int lds_byte(int r, int c) { const int st = (r >> 4) * 2 + (c >> 5), rr = r & 15, cc = c & 31, ob = rr * 64 + cc * 2; return st * 1024 + (ob ^ (((ob >> 9) & 1) << 5)); }
__host__ __device__ __forceinline__ void stage_rc(int b, int& R, int& C) { const int st = b / 1024, sb = b % 1024, swz = sb ^ (((sb >> 9) & 1) << 5); R = (st >> 1) * 16 + swz / 64; C = (st & 1) * 32 + (swz % 64) / 2; }
__host__ __device__ __forceinline__ int perm32(int rho) { const int n = rho >> 4, i = rho & 15; return 8 * (i >> 2) + 4 * n + (i & 3); }

struct Unit { int pm, pn; };
struct Gemm { const bf16_t* A; const bf16_t* Bt; int M, N, K; };

struct StaticOrder {
    int nM, nN, nwg, G, c;
    __host__ __device__ void init(int M, int N, int G_, int c_) { nM = M / BM; nN = N / BM; nwg = nM * nN; G = G_; c = c_; }
    __host__ __device__ bool next(int i, Unit& u) const {
        const long L = (long)i * G + c; if (L >= nwg) return false;
        int wgid = (int)L; { const int q = nwg / NXCD, r = nwg % NXCD, xcd = wgid % NXCD, off = wgid / NXCD; wgid = (xcd < r ? xcd * (q + 1) : r * (q + 1) + (xcd - r) * q) + off; }
        const int nig = WGM * nN, gid = wgid / nig, fm = gid * WGM, gsz = (nM - fm) < WGM ? (nM - fm) : WGM;
        u.pm = fm + ((wgid % nig) % gsz); u.pn = (wgid % nig) / gsz; return true;
    }
    __device__ __forceinline__ void a_ready(const Unit&) const {}
    __device__ __forceinline__ void done(const Unit&) const {}
};

__device__ __forceinline__ unsigned cvt_pk_bf16(float lo, float hi) { unsigned r; asm volatile("v_cvt_pk_bf16_f32 %0, %1, %2" : "=v"(r) : "v"(lo), "v"(hi)); return r; }
typedef unsigned u32x2 __attribute__((ext_vector_type(2)));
struct EpiBf16 {
    static constexpr bool PERM = true, AFTER_DRAIN = false;
    bf16_t* O; int ldc;
    __device__ __forceinline__ void operator()(const f32x4 (&acc)[2][2][4][2], const Unit& u, int wr, int wc, int fr, int fq) const {
        const int row0 = u.pm * BM + wr * 64 + fr; const int col0 = u.pn * BM + wc * 32 + 8 * fq;
#pragma unroll
        for (int ai = 0; ai < 2; ++ai)
#pragma unroll
            for (int m = 0; m < 4; ++m) { bf16_t* rowp = O + (size_t)(row0 + ai * HALF + m * 16) * ldc + col0;
#pragma unroll
                for (int bj = 0; bj < 2; ++bj) { const f32x4 v0 = acc[ai][bj][m][0], v1 = acc[ai][bj][m][1];
                    u32x4 w; w.x = cvt_pk_bf16(v0[0], v0[1]); w.y = cvt_pk_bf16(v0[2], v0[3]); w.z = cvt_pk_bf16(v1[0], v1[1]); w.w = cvt_pk_bf16(v1[2], v1[3]);
                    *(u32x4*)(rowp + bj * HALF) = w; } }
    }
};
struct EpiSqRelu {
    static constexpr bool PERM = true, AFTER_DRAIN = false;
    bf16_t* O; int ldc; const float* ss;
    __device__ __forceinline__ void operator()(const f32x4 (&acc)[2][2][4][2], const Unit& u, int wr, int wc, int fr, int fq) const {
        const int row0 = u.pm * BM + wr * 64 + fr; const int col0 = u.pn * BM + wc * 32 + 8 * fq;
#pragma unroll
        for (int ai = 0; ai < 2; ++ai)
#pragma unroll
            for (int m = 0; m < 4; ++m) { const int r = row0 + ai * HALF + m * 16; bf16_t* rowp = O + (size_t)r * ldc + col0;
                const f32x4* sp = (const f32x4*)(ss + (size_t)r * 16); const f32x4 s0 = sp[0], s1 = sp[1], s2 = sp[2], s3 = sp[3];
                const float tot = ((s0[0] + s0[1]) + (s0[2] + s0[3])) + ((s1[0] + s1[1]) + (s1[2] + s1[3])) + ((s2[0] + s2[1]) + (s2[2] + s2[3])) + ((s3[0] + s3[1]) + (s3[2] + s3[3]));
                const float rstd = 1.0f / sqrtf(tot * (1.0f / 1024.0f) + 1e-6f);
#pragma unroll
                for (int bj = 0; bj < 2; ++bj) { f32x4 v0 = acc[ai][bj][m][0] * rstd, v1 = acc[ai][bj][m][1] * rstd;
#pragma unroll
                    for (int e = 0; e < 4; ++e) { const float a = fmaxf(v0[e], 0.f), b = fmaxf(v1[e], 0.f); v0[e] = a * a; v1[e] = b * b; }
                    u32x4 w; w.x = cvt_pk_bf16(v0[0], v0[1]); w.y = cvt_pk_bf16(v0[2], v0[3]); w.z = cvt_pk_bf16(v1[0], v1[1]); w.w = cvt_pk_bf16(v1[2], v1[3]);
                    *(u32x4*)(rowp + bj * HALF) = w; } }
    }
};
template <bool WB> struct EpiRes {
    static constexpr bool PERM = false, AFTER_DRAIN = false;
    const float* base; float* out; bf16_t* ob; float* ss; int ldc;
    __device__ __forceinline__ void operator()(const f32x4 (&acc)[2][2][4][2], const Unit& u, int wr, int wc, int fr, int fq) const {
        const int col0 = u.pn * BM + wc * 32 + 4 * fq;
#pragma unroll
        for (int ai = 0; ai < 2; ++ai)
#pragma unroll
            for (int m = 0; m < 4; ++m) { const int r = u.pm * BM + ai * HALF + wr * 64 + m * 16 + fr; const size_t off = (size_t)r * ldc + col0; float s = 0.f;
#pragma unroll
                for (int bj = 0; bj < 2; ++bj)
#pragma unroll
                    for (int n = 0; n < 2; ++n) { const f32x4 v = *(const f32x4*)(base + off + bj * HALF + n * 16) + acc[ai][bj][m][n];
                        *(f32x4*)(out + off + bj * HALF + n * 16) = v; s += (v[0] * v[0] + v[1] * v[1]) + (v[2] * v[2] + v[3] * v[3]);
                        if (WB) { u32x2 w; w.x = cvt_pk_bf16(v[0], v[1]); w.y = cvt_pk_bf16(v[2], v[3]); *(u32x2*)(ob + off + bj * HALF + n * 16) = w; } }
                s += __shfl_xor(s, 16); s += __shfl_xor(s, 32);
                if (fq == 0) ss[(size_t)r * 16 + u.pn * 4 + wc] = s; }
    }
};
template <class Epi, class Sched, bool ALIGN_EPI = false, bool SP2 = false>
__device__ __forceinline__ void gemm_phase(PG8_LAS unsigned char* lds, const Gemm g, const Sched& S, const Epi& E) {
    const int tid = threadIdx.x, wid = __builtin_amdgcn_readfirstlane(tid >> 6), lane = tid & 63, wr = wid >> 2, wc = wid & 3, fr = lane & 15, fq = lane >> 4;
    const int K = g.K, nt = K / BK;
    unsigned voffA[2], voffB[2];
#pragma unroll
    for (int i = 0; i < 2; ++i) { int R, C; stage_rc(tid * 16 + i * 8192, R, C); const int Rb = Epi::PERM ? ((R & ~31) + perm32(R & 31)) : R;
        voffA[i] = (unsigned)(R * K + C) * 2u; voffB[i] = (unsigned)(Rb * K + C) * 2u; }
    const size_t kstep = (size_t)(BK * 2);
    const size_t hstep = (size_t)HALF * K * 2;
    const size_t tstep = 2 * hstep;
    const unsigned ldsw = (unsigned)wid * 1024u;
    const int aoff = lds_byte(wr * 64 + fr, fq * 8), boff = lds_byte(wc * 32 + fr, fq * 8);
#define PG8_SA(b, h) (((b) * 2 + (h)) * HTB)
#define PG8_SB(b, h) ((4 + (b) * 2 + (h)) * HTB)
#define PG8_STAGE(bufoff, gbase, voff) do { _Pragma("unroll") for (int _i = 0; _i < 2; ++_i) \
        __builtin_amdgcn_global_load_lds((const unsigned*)((const char*)(gbase) + (voff)[_i]), (PG8_LAS unsigned*)(lds + (bufoff) + ldsw + _i * 8192), 16, 0, 0); } while (0)
#define PG8_LDA(dst, b, h) do { _Pragma("unroll") for (int m = 0; m < 4; ++m) _Pragma("unroll") for (int k = 0; k < 2; ++k) dst[m][k] = *(const PG8_LAS bf16x8*)(lds + PG8_SA(b, h) + aoff + m * 2048 + k * 1024); } while (0)
#define PG8_LDB(dst, b, h) do { _Pragma("unroll") for (int n = 0; n < 2; ++n) _Pragma("unroll") for (int k = 0; k < 2; ++k) dst[n][k] = *(const PG8_LAS bf16x8*)(lds + PG8_SB(b, h) + boff + n * 2048 + k * 1024); } while (0)
#define PG8_MMA(ai, bj, At, Bt) do { __builtin_amdgcn_s_setprio(1); _Pragma("unroll") for (int m = 0; m < 4; ++m) _Pragma("unroll") for (int n = 0; n < 2; ++n) _Pragma("unroll") for (int k = 0; k < 2; ++k) \
        acc[ai][bj][m][n] = __builtin_amdgcn_mfma_f32_16x16x32_bf16(Bt[n][k], At[m][k], acc[ai][bj][m][n], 0, 0, 0); __builtin_amdgcn_s_setprio(0); } while (0)
#define PG8_WAIT_V(n) asm volatile("s_waitcnt vmcnt(" #n ")" ::: "memory")
#define PG8_WAIT_L(n) asm volatile("s_waitcnt lgkmcnt(" #n ")" ::: "memory")
#define PG8_BAR __builtin_amdgcn_s_barrier()
#define PG8_SCHED __builtin_amdgcn_sched_barrier(0)
    Unit cur, nxt; int ui = 0;
    if (!S.next(0, cur)) return;
    f32x4 acc[2][2][4][2];
#pragma unroll
    for (int a = 0; a < 2; ++a)
#pragma unroll
        for (int b = 0; b < 2; ++b)
#pragma unroll
            for (int m = 0; m < 4; ++m)
#pragma unroll
                for (int n = 0; n < 2; ++n) acc[a][b][m][n] = (f32x4){0.f, 0.f, 0.f, 0.f};
    bf16x8 At[4][2], B0[2][2], B1[2][2];
    const char* cA = (const char*)g.A + (size_t)cur.pm * tstep; const char* cB = (const char*)g.Bt + (size_t)cur.pn * tstep;
    S.a_ready(cur);
    if constexpr (SP2) {
        PG8_STAGE(PG8_SB(0, 0), cB, voffB); PG8_STAGE(PG8_SB(0, 1), cB + hstep, voffB); PG8_STAGE(PG8_SA(0, 0), cA, voffA); PG8_STAGE(PG8_SA(0, 1), cA + hstep, voffA);
        if (wr == 1) PG8_BAR;
        PG8_WAIT_V(2); PG8_BAR;
        PG8_STAGE(PG8_SB(1, 0), cB + kstep, voffB); PG8_STAGE(PG8_SA(1, 0), cA + kstep, voffA); PG8_STAGE(PG8_SB(1, 1), cB + hstep + kstep, voffB);
        PG8_WAIT_V(6); PG8_BAR;
    } else {
        PG8_STAGE(PG8_SB(0, 0), cB, voffB); PG8_STAGE(PG8_SA(0, 0), cA, voffA); PG8_STAGE(PG8_SB(0, 1), cB + hstep, voffB); PG8_STAGE(PG8_SA(0, 1), cA + hstep, voffA);
        if (wr == 1) PG8_BAR;
        PG8_WAIT_V(4); PG8_BAR;
        PG8_STAGE(PG8_SB(1, 0), cB + kstep, voffB); PG8_STAGE(PG8_SA(1, 0), cA + kstep, voffA); PG8_STAGE(PG8_SB(1, 1), cB + hstep + kstep, voffB);
        PG8_WAIT_V(6); PG8_BAR;
    }
    for (;;) {
        const bool has_next = S.next(ui + 1, nxt);
        const char* nA = has_next ? (const char*)g.A + (size_t)nxt.pm * tstep : cA; const char* nB = has_next ? (const char*)g.Bt + (size_t)nxt.pn * tstep : cB;
        for (int t = 0; t < nt; t += 2) {
            const bool last = (t == nt - 2);
            const char* a1 = cA + (size_t)(t + 1) * kstep;
            const char* a2 = last ? nA : cA + (size_t)(t + 2) * kstep; const char* b2 = last ? nB : cB + (size_t)(t + 2) * kstep;
            const char* a3 = a2 + kstep; const char* b3 = b2 + kstep;
            if (last && has_next) S.a_ready(nxt);
            if constexpr (SP2) {
            PG8_LDB(B0, 0, 0); PG8_LDB(B1, 0, 1); PG8_SCHED; PG8_LDA(At, 0, 0); PG8_STAGE(PG8_SA(1, 1), a1 + hstep, voffA);
            PG8_WAIT_V(8); PG8_WAIT_L(0); PG8_BAR; PG8_MMA(0, 0, At, B0); PG8_MMA(0, 1, At, B1); PG8_BAR; PG8_SCHED;
            PG8_LDA(At, 0, 1); PG8_STAGE(PG8_SB(0, 0), b2, voffB); PG8_STAGE(PG8_SB(0, 1), b2 + hstep, voffB); PG8_STAGE(PG8_SA(0, 0), a2, voffA);
            PG8_WAIT_V(8); PG8_WAIT_L(0); PG8_BAR; PG8_MMA(1, 0, At, B0); PG8_MMA(1, 1, At, B1); PG8_BAR; PG8_SCHED;
            PG8_LDB(B0, 1, 0); PG8_LDB(B1, 1, 1); PG8_SCHED; PG8_LDA(At, 1, 0); PG8_STAGE(PG8_SA(0, 1), a2 + hstep, voffA);
            PG8_WAIT_V(8); PG8_WAIT_L(0); PG8_BAR; PG8_MMA(0, 0, At, B0); PG8_MMA(0, 1, At, B1); PG8_BAR; PG8_SCHED;
            PG8_LDA(At, 1, 1); PG8_STAGE(PG8_SB(1, 0), b3, voffB); PG8_STAGE(PG8_SB(1, 1), b3 + hstep, voffB); PG8_STAGE(PG8_SA(1, 0), a3, voffA);
            PG8_WAIT_V(8); PG8_WAIT_L(0); PG8_BAR; PG8_MMA(1, 0, At, B0); PG8_MMA(1, 1, At, B1); PG8_BAR; PG8_SCHED;
            } else {
            PG8_LDB(B0, 0, 0); PG8_SCHED; PG8_LDA(At, 0, 0); PG8_STAGE(PG8_SA(1, 1), a1 + hstep, voffA);
            PG8_WAIT_L(8); PG8_BAR; PG8_WAIT_L(0); PG8_MMA(0, 0, At, B0); PG8_BAR; PG8_SCHED;
            PG8_LDB(B1, 0, 1); PG8_STAGE(PG8_SB(0, 0), b2, voffB);
            PG8_BAR; PG8_WAIT_L(0); PG8_MMA(0, 1, At, B1); PG8_BAR;
            PG8_LDA(At, 0, 1); PG8_STAGE(PG8_SA(0, 0), a2, voffA);
            PG8_BAR; PG8_WAIT_L(0); PG8_MMA(1, 0, At, B0); PG8_BAR; PG8_SCHED;
            PG8_STAGE(PG8_SB(0, 1), b2 + hstep, voffB);
            PG8_WAIT_V(6); PG8_BAR; PG8_MMA(1, 1, At, B1); PG8_BAR;
            PG8_LDB(B0, 1, 0); PG8_SCHED; PG8_LDA(At, 1, 0); PG8_STAGE(PG8_SA(0, 1), a2 + hstep, voffA);
            PG8_WAIT_L(8); PG8_BAR; PG8_WAIT_L(0); PG8_MMA(0, 0, At, B0); PG8_BAR; PG8_SCHED;
            PG8_LDB(B1, 1, 1); PG8_STAGE(PG8_SB(1, 0), b3, voffB);
            PG8_BAR; PG8_WAIT_L(0); PG8_MMA(0, 1, At, B1); PG8_BAR;
            PG8_LDA(At, 1, 1); PG8_STAGE(PG8_SA(1, 0), a3, voffA);
            PG8_BAR; PG8_WAIT_L(0); PG8_MMA(1, 0, At, B0); PG8_BAR; PG8_SCHED;
            PG8_STAGE(PG8_SB(1, 1), b3 + hstep, voffB);
            PG8_WAIT_V(6); PG8_BAR; PG8_MMA(1, 1, At, B1); PG8_BAR;
            }
        }
        if constexpr (ALIGN_EPI) { if (wr == 0) PG8_BAR; }
        if constexpr (!Epi::AFTER_DRAIN) { E(acc, cur, wr, wc, fr, fq); S.done(cur); }
        if (!has_next) break;
#pragma unroll
        for (int a = 0; a < 2; ++a)
#pragma unroll
            for (int b = 0; b < 2; ++b)
#pragma unroll
                for (int m = 0; m < 4; ++m)
#pragma unroll
                    for (int n = 0; n < 2; ++n) acc[a][b][m][n] = (f32x4){0.f, 0.f, 0.f, 0.f};
        cur = nxt; cA = nA; cB = nB; ++ui;
        if constexpr (ALIGN_EPI) { if (wr == 1) PG8_BAR; }
    }
    PG8_WAIT_V(0);
    if constexpr (!ALIGN_EPI) { if (wr == 0) PG8_BAR; }
    PG8_BAR;
    if constexpr (Epi::AFTER_DRAIN) { E.fused(acc, cur, wr, wc, fr, fq, lds, wid, lane); S.done(cur); }
#undef PG8_SA
#undef PG8_SB
#undef PG8_STAGE
#undef PG8_LDA
#undef PG8_LDB
#undef PG8_MMA
#undef PG8_WAIT_V
#undef PG8_WAIT_L
#undef PG8_BAR
#undef PG8_SCHED
}
}
#define GAS __attribute__((address_space(1)))
#define LAS __attribute__((address_space(3)))
typedef unsigned short bf16;
typedef unsigned v4u __attribute__((ext_vector_type(4)));
typedef unsigned v2u __attribute__((ext_vector_type(2)));
typedef float f32x4 __attribute__((ext_vector_type(4)));
typedef float f32x16 __attribute__((ext_vector_type(16)));
typedef short bf16x8 __attribute__((ext_vector_type(8)));
#define LDS_WAIT() asm volatile("s_waitcnt lgkmcnt(0)" ::: "memory")

#ifndef MK_N_LAUNCHES
#define MK_N_LAUNCHES 1
#endif
#ifndef MK_NAIVE_ATTN
#define MK_NAIVE_ATTN 0
#endif
constexpr int NWAVES = 8, NPH = 8;
constexpr int BATCH = 4, SEQ = 8192, D = 1024, NH = 12, HD = 64, AW = 768, GWD = 256, NG = 4, INW = 2816, FF = 4096, M = BATCH * SEQ, CHUNK = 128;
constexpr float EPS = 1e-6f;
constexpr size_t MiB = 1u << 20;
constexpr size_t WS_WIN = 2 * MiB, WS_WOUT = 8 * MiB, WS_W1 = 10 * MiB, WS_W2 = 18 * MiB, WS_SS1 = 26 * MiB, WS_SS2 = 28 * MiB, WS_LSE = 30 * MiB, WS_GM = 36 * MiB,
                 WS_XN = 64 * MiB, WS_PROJ = 128 * MiB, WS_OP = 304 * MiB, WS_H1B = 128 * MiB, WS_HID = 192 * MiB, WS_END = 448 * MiB;
static_assert(WS_WIN + (size_t)INW * D * 2 <= WS_WOUT && WS_LSE + (size_t)3 * M * NH * 4 <= WS_GM && WS_GM + (size_t)M * GWD * 2 <= WS_XN && WS_PROJ + (size_t)M * INW * 2 <= WS_OP && WS_OP + (size_t)3 * M * AW * 2 <= WS_END && WS_HID + (size_t)M * FF * 2 <= WS_END, "ws map");
constexpr int LDS_BYTES = 147456;

__device__ __forceinline__ float bflo(unsigned u) { return __uint_as_float(u << 16); }
__device__ __forceinline__ float bfhi(unsigned u) { return __uint_as_float(u & 0xffff0000u); }
__device__ __forceinline__ unsigned pk2(float lo, float hi) { return pg8::cvt_pk_bf16(lo, hi); }
__device__ __forceinline__ float wave_sum(float v) {
#pragma unroll
    for (int o = 1; o < 64; o <<= 1) v += __shfl_xor(v, o);
    return v;
}
__device__ __forceinline__ float gelu_t(float x) { const float y = 0.7978845608028654f * (x + 0.044715f * x * x * x); return x / (1.0f + __expf(-2.0f * y)); }

__device__ __forceinline__ void p0_transpose_item(const float* W, int K, int N, bf16* WT, const float* gk, int qcols, LAS float* scr, int item, int lane) {
    const int nblk = N / 32, kb = item / nblk, nb = item % nblk, k0 = 64 * kb, n0 = 32 * nb;
#pragma unroll 8
    for (int i = 0; i < 32; ++i) { const int kk = 2 * i + (lane >> 5); const float g = gk ? gk[k0 + kk] : 1.0f; scr[kk * 33 + (lane & 31)] = W[(size_t)(k0 + kk) * N + n0 + (lane & 31)] * g; }
    LDS_WAIT();
    const int c = lane & 7;
#pragma unroll
    for (int j = 0; j < 4; ++j) { const int n = (lane >> 3) + 8 * j; const LAS float* s = scr + (8 * c) * 33 + n; const float sc = (n0 + n < qcols) ? 0.125f : 1.0f;
        v4u o; o.x = pk2(s[0 * 33] * sc, s[1 * 33] * sc); o.y = pk2(s[2 * 33] * sc, s[3 * 33] * sc); o.z = pk2(s[4 * 33] * sc, s[5 * 33] * sc); o.w = pk2(s[6 * 33] * sc, s[7 * 33] * sc);
        *(v4u*)(WT + (size_t)(n0 + n) * K + k0 + 8 * c) = o; }
    LDS_WAIT();
}
__device__ __forceinline__ void rms_row_to_bf16(const float* xrow, bf16* orow, int lane) {
    const f32x4* xr = (const f32x4*)xrow + lane;
    f32x4 v[4]; float s = 0.f;
#pragma unroll
    for (int j = 0; j < 4; ++j) { v[j] = xr[64 * j]; s += (v[j].x * v[j].x + v[j].y * v[j].y) + (v[j].z * v[j].z + v[j].w * v[j].w); }
    const float rstd = 1.0f / sqrtf(wave_sum(s) * (1.0f / D) + EPS);
    v2u* o8 = (v2u*)orow + lane;
#pragma unroll
    for (int j = 0; j < 4; ++j) { v2u w; w.x = pk2(v[j].x * rstd, v[j].y * rstd); w.y = pk2(v[j].z * rstd, v[j].w * rstd); o8[64 * j] = w; }
}

__device__ __forceinline__ void gmlp_unit(LAS unsigned char* lds, const bf16* PROJ, const float* ln_g, const float* ln_b, const float* sgu_w, const float* sgu_b, bf16* GM, int unit, int tid) {
    const int g = unit & 3, n = (unit >> 2) & 63, b = unit >> 8;
    const size_t row0 = (size_t)b * SEQ + (size_t)n * CHUNK;
    LAS float* zn = (LAS float*)lds;
    LAS float* wl = (LAS float*)(lds + 128 * 68 * 4);
    const float* wg = sgu_w + (size_t)g * CHUNK * CHUNK;
    for (int i = tid; i < CHUNK * CHUNK; i += NWAVES * 64) wl[(i >> 7) * 129 + (i & 127)] = wg[i];
    {
        const int t = tid >> 2, q = tid & 3;
        const bf16* zp = PROJ + (row0 + t) * INW + 2560 + g * 64 + 16 * q;
        const v4u r0 = *(const v4u*)zp, r1 = *(const v4u*)(zp + 8);
        float z[16];
        z[0] = bflo(r0.x); z[1] = bfhi(r0.x); z[2] = bflo(r0.y); z[3] = bfhi(r0.y); z[4] = bflo(r0.z); z[5] = bfhi(r0.z); z[6] = bflo(r0.w); z[7] = bfhi(r0.w);
        z[8] = bflo(r1.x); z[9] = bfhi(r1.x); z[10] = bflo(r1.y); z[11] = bfhi(r1.y); z[12] = bflo(r1.z); z[13] = bfhi(r1.z); z[14] = bflo(r1.w); z[15] = bfhi(r1.w);
        float s = 0.f;
#pragma unroll
        for (int e = 0; e < 16; ++e) { z[e] = gelu_t(z[e]); s += z[e]; }
        s += __shfl_xor(s, 1); s += __shfl_xor(s, 2);
        const float mean = s * (1.0f / 64.0f); float v = 0.f;
#pragma unroll
        for (int e = 0; e < 16; ++e) { z[e] -= mean; v += z[e] * z[e]; }
        v += __shfl_xor(v, 1); v += __shfl_xor(v, 2);
        const float rstd = 1.0f / sqrtf(v * (1.0f / 64.0f) + EPS);
        const float* lg = ln_g + g * 64 + 16 * q; const float* lb = ln_b + g * 64 + 16 * q;
#pragma unroll
        for (int e4 = 0; e4 < 4; ++e4) { f32x4 o;
#pragma unroll
            for (int e = 0; e < 4; ++e) o[e] = z[4 * e4 + e] * rstd * lg[4 * e4 + e] + lb[4 * e4 + e];
            *(LAS f32x4*)(zn + t * 68 + 16 * q + 4 * e4) = o; }
    }
    __syncthreads();
    const int wv = __builtin_amdgcn_readfirstlane(tid >> 6), lane = tid & 63, tr = lane >> 3, cq = lane & 7;
#pragma unroll 1
    for (int half = 0; half < 2; ++half) {
        const int blk = half ? 15 - wv : wv, t = 8 * blk + tr, smax = 8 * blk + 7;
        float acc[8];
#pragma unroll
        for (int e = 0; e < 8; ++e) acc[e] = 0.f;
#pragma unroll 4
        for (int s = 0; s <= smax; ++s) {
            float w = wl[t * 129 + s]; w = (s <= t) ? w : 0.f;
            const f32x4 z0 = *(const LAS f32x4*)(zn + s * 68 + 8 * cq), z1 = *(const LAS f32x4*)(zn + s * 68 + 8 * cq + 4);
#pragma unroll
            for (int e = 0; e < 4; ++e) { acc[e] += w * z0[e]; acc[4 + e] += w * z1[e]; }
        }
        const v4u ur = *(const v4u*)(PROJ + (row0 + t) * INW + 2304 + g * 64 + 8 * cq);
        const float bs = sgu_b[g * CHUNK + t];
        float u[8]; u[0] = bflo(ur.x); u[1] = bfhi(ur.x); u[2] = bflo(ur.y); u[3] = bfhi(ur.y); u[4] = bflo(ur.z); u[5] = bfhi(ur.z); u[6] = bflo(ur.w); u[7] = bfhi(ur.w);
#pragma unroll
        for (int e = 0; e < 8; ++e) u[e] = gelu_t(u[e]) * (acc[e] + bs);
        v4u o; o.x = pk2(u[0], u[1]); o.y = pk2(u[2], u[3]); o.z = pk2(u[4], u[5]); o.w = pk2(u[6], u[7]);
        *(v4u*)(GM + (row0 + t) * GWD + g * 64 + 8 * cq) = o;
    }
    __syncthreads();
}

__device__ __forceinline__ float alibi_slope(int h) { return (h < 8) ? exp2f(-(float)(h + 1)) : exp2f(-0.5f - (float)(h - 8)); }

#if MK_NAIVE_ATTN
__device__ __forceinline__ void attn_naive(const bf16* PROJ, bf16* OP, float* LSE, int gtid, int nthreads) {
#pragma unroll 1
    for (int it = gtid; it < M * NH * 3; it += nthreads) {
        const int h = it % NH, row = (it / NH) % M, p = it / (NH * M), dil = 1 << (2 * p), t = row % SEQ;
        const float slope = alibi_slope(h);
        const bf16* qp = PROJ + (size_t)row * INW + h * 64;
        float q[64], o[64];
#pragma unroll
        for (int c = 0; c < 8; ++c) { const v4u r = *(const v4u*)(qp + 8 * c); q[8*c] = bflo(r.x); q[8*c+1] = bfhi(r.x); q[8*c+2] = bflo(r.y); q[8*c+3] = bfhi(r.y); q[8*c+4] = bflo(r.z); q[8*c+5] = bfhi(r.z); q[8*c+6] = bflo(r.w); q[8*c+7] = bfhi(r.w); }
#pragma unroll
        for (int e = 0; e < 64; ++e) o[e] = 0.f;
        float m = -1e30f, l = 0.f;
#pragma unroll 1
        for (int j = 0; j <= 128; ++j) {
            const int tk = t - dil * j; if (tk < 0) break;
            const bf16* kp = qp + 768 - (size_t)(dil * j) * INW; const bf16* vp = kp + 768;
            float dot = 0.f;
#pragma unroll
            for (int c = 0; c < 8; ++c) { const v4u r = *(const v4u*)(kp + 8 * c);
                dot += q[8*c] * bflo(r.x) + q[8*c+1] * bfhi(r.x) + q[8*c+2] * bflo(r.y) + q[8*c+3] * bfhi(r.y) + q[8*c+4] * bflo(r.z) + q[8*c+5] * bfhi(r.z) + q[8*c+6] * bflo(r.w) + q[8*c+7] * bfhi(r.w); }
            const float s = dot - slope * (float)(dil * j);
            const float mn = fmaxf(m, s), sc = __expf(m - mn), pe = __expf(s - mn);
            l = l * sc + pe; m = mn;
#pragma unroll
            for (int c = 0; c < 8; ++c) { const v4u r = *(const v4u*)(vp + 8 * c);
                o[8*c] = o[8*c] * sc + pe * bflo(r.x); o[8*c+1] = o[8*c+1] * sc + pe * bfhi(r.x); o[8*c+2] = o[8*c+2] * sc + pe * bflo(r.y); o[8*c+3] = o[8*c+3] * sc + pe * bfhi(r.y);
                o[8*c+4] = o[8*c+4] * sc + pe * bflo(r.z); o[8*c+5] = o[8*c+5] * sc + pe * bfhi(r.z); o[8*c+6] = o[8*c+6] * sc + pe * bflo(r.w); o[8*c+7] = o[8*c+7] * sc + pe * bfhi(r.w); }
        }
        const float il = 1.0f / l;
        bf16* op = OP + ((size_t)p * M + row) * AW + h * 64;
#pragma unroll
        for (int c = 0; c < 8; ++c) { v4u w; w.x = pk2(o[8*c] * il, o[8*c+1] * il); w.y = pk2(o[8*c+2] * il, o[8*c+3] * il); w.z = pk2(o[8*c+4] * il, o[8*c+5] * il); w.w = pk2(o[8*c+6] * il, o[8*c+7] * il); *(v4u*)(op + 8 * c) = w; }
        LSE[((size_t)p * M + row) * NH + h] = m + __logf(l);
    }
}
#endif

__device__ __forceinline__ void mixnorm_row(const bf16* OP, const float* LSE, const bf16* GM, bf16* MIXED, int row, int lane) {
    float a[3][4]; float ssa = 0.f;
#pragma unroll
    for (int j = 0; j < 3; ++j) {
        const int c = 256 * j + 4 * lane, head = c >> 6;
        float ls[3];
#pragma unroll
        for (int p = 0; p < 3; ++p) ls[p] = LSE[((size_t)p * M + row) * NH + head];
        const float mx = fmaxf(ls[0], fmaxf(ls[1], ls[2]));
        float w[3]; float wsum = 0.f;
#pragma unroll
        for (int p = 0; p < 3; ++p) { w[p] = __expf(ls[p] - mx); wsum += w[p]; }
        const float iw = 1.0f / wsum;
#pragma unroll
        for (int e = 0; e < 4; ++e) a[j][e] = 0.f;
#pragma unroll
        for (int p = 0; p < 3; ++p) { const v2u r = *(const v2u*)(OP + ((size_t)p * M + row) * AW + c); const float wp = w[p] * iw;
            a[j][0] += wp * bflo(r.x); a[j][1] += wp * bfhi(r.x); a[j][2] += wp * bflo(r.y); a[j][3] += wp * bfhi(r.y); }
#pragma unroll
        for (int e = 0; e < 4; ++e) ssa += a[j][e] * a[j][e];
    }
    const v2u gr = *(const v2u*)(GM + (size_t)row * GWD + 4 * lane);
    float gv[4]; gv[0] = bflo(gr.x); gv[1] = bfhi(gr.x); gv[2] = bflo(gr.y); gv[3] = bfhi(gr.y);
    float ssg = (gv[0] * gv[0] + gv[1] * gv[1]) + (gv[2] * gv[2] + gv[3] * gv[3]);
    const float ra = 1.0f / sqrtf(wave_sum(ssa) * (1.0f / AW) + EPS), rg = 1.0f / sqrtf(wave_sum(ssg) * (1.0f / GWD) + EPS);
    bf16* mp = MIXED + (size_t)row * D;
#pragma unroll
    for (int j = 0; j < 3; ++j) { v2u w; w.x = pk2(a[j][0] * ra, a[j][1] * ra); w.y = pk2(a[j][2] * ra, a[j][3] * ra); *(v2u*)(mp + 256 * j + 4 * lane) = w; }
    { v2u w; w.x = pk2(gv[0] * rg, gv[1] * rg); w.y = pk2(gv[2] * rg, gv[3] * rg); *(v2u*)(mp + AW + 4 * lane) = w; }
}
#if !MK_NAIVE_ATTN
typedef short v4i16_t __attribute__((ext_vector_type(4)));
typedef float f32x2_t __attribute__((ext_vector_type(2)));
typedef __bf16 bf16x2_t __attribute__((ext_vector_type(2)));
__device__ __forceinline__ unsigned cvtpk_s(float lo, float hi) { f32x2_t v = {lo, hi}; bf16x2_t b = __builtin_convertvector(v, bf16x2_t); return __builtin_bit_cast(unsigned, b); }
__device__ __forceinline__ v4i16_t vtr(const LAS unsigned char* p) { return __builtin_amdgcn_ds_read_tr16_b64_v4i16((LAS v4i16_t*)p); }
__device__ __forceinline__ float xhalf_max(float v) { auto rr = __builtin_amdgcn_permlane32_swap(__float_as_uint(v), __float_as_uint(v), false, false); return fmaxf(__uint_as_float(rr[0]), __uint_as_float(rr[1])); }
__device__ __forceinline__ float xhalf_sum(float v) { auto rr = __builtin_amdgcn_permlane32_swap(__float_as_uint(v), __float_as_uint(v), false, false); return __uint_as_float(rr[0]) + __uint_as_float(rr[1]); }
constexpr int ATT_KS = 144, ATT_VS = 192, ATT_KROWS = 384, ATT_VOFF = ATT_KROWS * ATT_KS, ATT_OOFF = ATT_VOFF + ATT_KROWS * ATT_VS, ATT_OS = 72;
static_assert(ATT_OOFF + NWAVES * 32 * ATT_OS <= LDS_BYTES, "attention LDS map");
constexpr int ATT_NU = BATCH * NH * 96;

struct AttUnit { int p, h, dil, i0w; size_t rowb; };
__device__ __forceinline__ AttUnit att_decode(int u) {
    AttUnit a; const int bh = u / 96, rem = u - bh * 96, b = bh / NH; a.h = bh - b * NH; a.p = rem >> 5; const int sub = rem & 31, dsh = 2 * a.p; a.dil = 1 << dsh;
    const int nblk = 32 >> dsh, r = sub / nblk, blk = sub - r * nblk; a.i0w = 256 * blk; a.rowb = (size_t)b * SEQ + r; return a;
}

__device__ __forceinline__ void attn_phase(LAS unsigned char* lds, const bf16* PROJ, bf16* OP, float* LSE, int vcu, int G, int wave, int lane, int tid) {
    constexpr float LOG2E = 1.4426950408889634f, LN2 = 0.6931471805599453f;
    const int ql = lane & 31, h2 = lane >> 5;
    LAS unsigned char* KL = lds; LAS unsigned char* VL = lds + ATT_VOFF; LAS unsigned char* OL = lds + ATT_OOFF + wave * (32 * ATT_OS);
    const LAS unsigned char* krd = KL + (32 * wave + ql) * ATT_KS + 16 * h2;
    const LAS unsigned char* vrd = VL + (32 * wave + 4 * h2 + ((lane & 15) >> 2)) * ATT_VS + (((lane >> 4) & 1) * 16 + (lane & 3) * 4) * 2;
    v4u kreg[6], vreg[6]; bf16x8 qn[4];
#define ATT_LOAD(u_) do { const AttUnit a_ = att_decode(u_); const bf16* base_ = PROJ + a_.h * 64; \
        _Pragma("unroll") for (int j = 0; j < 6; ++j) { const int c_ = tid + 512 * j; int di_ = a_.i0w - 128 + (c_ >> 3); di_ = di_ < 0 ? 0 : di_; \
            const bf16* kp_ = base_ + AW + (a_.rowb + (size_t)di_ * a_.dil) * INW + (c_ & 7) * 8; kreg[j] = *(const v4u*)kp_; vreg[j] = *(const v4u*)(kp_ + AW); } \
        const bf16* qp_ = base_ + (a_.rowb + (size_t)(a_.i0w + 32 * wave + ql) * a_.dil) * INW + 8 * h2; \
        _Pragma("unroll") for (int s = 0; s < 4; ++s) qn[s] = *(const bf16x8*)(qp_ + 16 * s); } while (0)
    int u = vcu;
    if (u < ATT_NU) ATT_LOAD(u);
#pragma unroll 1
    for (; u < ATT_NU; u += G) {
        asm volatile("" ::: "memory"); __builtin_amdgcn_s_barrier(); asm volatile("" ::: "memory");
#pragma unroll
        for (int j = 0; j < 6; ++j) { const int c = tid + 512 * j; *(LAS v4u*)(KL + (c >> 3) * ATT_KS + (c & 7) * 16) = kreg[j]; *(LAS v4u*)(VL + (c >> 3) * ATT_VS + (c & 7) * 16) = vreg[j]; }
        bf16x8 qf[4];
#pragma unroll
        for (int s = 0; s < 4; ++s) qf[s] = qn[s];
        asm volatile("s_waitcnt lgkmcnt(0)" ::: "memory"); __builtin_amdgcn_s_barrier(); asm volatile("" ::: "memory");
        const AttUnit au = att_decode(u);
        if (u + G < ATT_NU) ATT_LOAD(u + G);
        const int i0 = au.i0w + 32 * wave, dil = au.dil;
        const float c2 = alibi_slope(au.h) * (float)dil * LOG2E;
        f32x16 o0, o1;
#pragma unroll
        for (int e = 0; e < 16; ++e) { o0[e] = 0.f; o1[e] = 0.f; }
        float m = -1e30f, l = 0.f;
#pragma unroll
        for (int kt = 0; kt < 5; ++kt) {
            const int k0 = i0 - 128 + 32 * kt;
            if (k0 >= 0) {
                f32x16 sa;
#pragma unroll
                for (int e = 0; e < 16; ++e) sa[e] = 0.f;
#pragma unroll
                for (int s = 0; s < 4; ++s) { const bf16x8 kc = *(const LAS bf16x8*)(krd + (32 * kt) * ATT_KS + 32 * s); sa = __builtin_amdgcn_mfma_f32_32x32x16_bf16(kc, qf[s], sa, 0, 0, 0); }
                const float lb = -c2 * (float)(128 - 32 * kt + ql - 4 * h2);
                float sc[16]; float mx = -INFINITY;
#pragma unroll
                for (int e = 0; e < 16; ++e) { const int kr = (e & 3) + 8 * (e >> 2);
                    float s = fmaf(sa[e], LOG2E, lb); s = fmaf(c2, (float)kr, s);
                    if (kt == 0) s = (kr + 4 * h2 >= ql) ? s : -INFINITY;
                    if (kt == 4) s = (kr + 4 * h2 <= ql) ? s : -INFINITY;
                    sc[e] = s; mx = fmaxf(mx, s); }
                mx = xhalf_max(mx);
                const float mn = fmaxf(m, mx), alpha = __builtin_amdgcn_exp2f(m - mn); m = mn;
                float ls = 0.f;
#pragma unroll
                for (int e = 0; e < 16; ++e) { sc[e] = __builtin_amdgcn_exp2f(sc[e] - mn); ls += sc[e]; }
                l = l * alpha + ls;
#pragma unroll
                for (int e = 0; e < 16; ++e) { o0[e] *= alpha; o1[e] *= alpha; }
#pragma unroll
                for (int s2 = 0; s2 < 2; ++s2) {
                    v4u pw; pw.x = cvtpk_s(sc[8 * s2], sc[8 * s2 + 1]); pw.y = cvtpk_s(sc[8 * s2 + 2], sc[8 * s2 + 3]); pw.z = cvtpk_s(sc[8 * s2 + 4], sc[8 * s2 + 5]); pw.w = cvtpk_s(sc[8 * s2 + 6], sc[8 * s2 + 7]);
                    const bf16x8 pb = __builtin_bit_cast(bf16x8, pw);
                    const LAS unsigned char* vb = vrd + (32 * kt + 16 * s2) * ATT_VS;
                    { const v4i16_t a = vtr(vb), c = vtr(vb + 8 * ATT_VS);
                      const bf16x8 vf = {a[0], a[1], a[2], a[3], c[0], c[1], c[2], c[3]};
                      o0 = __builtin_amdgcn_mfma_f32_32x32x16_bf16(vf, pb, o0, 0, 0, 0); }
                    { const v4i16_t a = vtr(vb + 64), c = vtr(vb + 8 * ATT_VS + 64);
                      const bf16x8 vf = {a[0], a[1], a[2], a[3], c[0], c[1], c[2], c[3]};
                      o1 = __builtin_amdgcn_mfma_f32_32x32x16_bf16(vf, pb, o1, 0, 0, 0); }
                }
            }
        }
        const float lt = xhalf_sum(l), il = 1.0f / lt;
        if (h2 == 0) LSE[((size_t)au.p * M + au.rowb + (size_t)(i0 + ql) * dil) * NH + au.h] = (m + __log2f(lt)) * LN2;
        bf16* og = OP + ((size_t)au.p * M + au.rowb + (size_t)(i0 + (lane >> 1)) * dil) * AW + au.h * 64 + 16 * (lane & 1);
        LAS unsigned char* ow = OL + ql * ATT_OS + 8 * h2;
        const LAS unsigned char* orr = OL + (lane >> 1) * ATT_OS + 32 * (lane & 1);
#pragma unroll
        for (int dt = 0; dt < 2; ++dt) {
#pragma unroll
            for (int g4 = 0; g4 < 4; ++g4) { v2u w;
                if (dt == 0) { w.x = cvtpk_s(o0[4 * g4] * il, o0[4 * g4 + 1] * il); w.y = cvtpk_s(o0[4 * g4 + 2] * il, o0[4 * g4 + 3] * il); }
                else { w.x = cvtpk_s(o1[4 * g4] * il, o1[4 * g4 + 1] * il); w.y = cvtpk_s(o1[4 * g4 + 2] * il, o1[4 * g4 + 3] * il); }
                *(LAS v2u*)(ow + 16 * g4) = w; }
            const v2u r0 = *(const LAS v2u*)(orr), r1 = *(const LAS v2u*)(orr + 8), r2 = *(const LAS v2u*)(orr + 16), r3 = *(const LAS v2u*)(orr + 24);
            v4u s0; s0.x = r0.x; s0.y = r0.y; s0.z = r1.x; s0.w = r1.y; v4u s1; s1.x = r2.x; s1.y = r2.y; s1.z = r3.x; s1.w = r3.y;
            *(v4u*)(og + 32 * dt) = s0; *(v4u*)(og + 32 * dt + 8) = s1;
        }
    }
#undef ATT_LOAD
    asm volatile("" ::: "memory"); __builtin_amdgcn_s_barrier(); asm volatile("" ::: "memory");
}
#endif
struct Args { const float* in[14]; float* out; unsigned char* ws; int ph_lo, ph_hi; };
__global__ void __launch_bounds__(NWAVES * 64, 2) hymba_fwd(Args args) {
    extern __shared__ __attribute__((aligned(16))) unsigned char lds_raw[];
    LAS unsigned char* lds = (LAS unsigned char*)lds_raw;
    cg::grid_group grid = cg::this_grid();
    const int tid = threadIdx.x, lane = tid & 63, wave = __builtin_amdgcn_readfirstlane(tid >> 6);
    const int G = gridDim.x, bx = blockIdx.x;
    const int vcu = (G % 8 == 0) ? (bx % 8) * (G / 8) + bx / 8 : bx;
    const int gw = vcu * NWAVES + wave, NGW = G * NWAVES;
    unsigned char* ws = args.ws;
    const float* x = args.in[0]; const float* norm1_g = args.in[1]; const float* w_in = args.in[2]; const float* sgu_ln_g = args.in[3]; const float* sgu_ln_b = args.in[4];
    const float* sgu_w = args.in[5]; const float* sgu_b = args.in[6]; const float* attn_out_g = args.in[7]; const float* gmlp_out_g = args.in[8]; const float* w_out = args.in[9];
    const float* norm2_g = args.in[10]; const float* w_ff1 = args.in[11]; const float* w_ff2 = args.in[12]; const float* final_g = args.in[13];
    float* out = args.out;
    bf16* WIN = (bf16*)(ws + WS_WIN); bf16* WOUT = (bf16*)(ws + WS_WOUT); bf16* W1 = (bf16*)(ws + WS_W1); bf16* W2 = (bf16*)(ws + WS_W2);
    float* SS1 = (float*)(ws + WS_SS1); float* SS2 = (float*)(ws + WS_SS2); float* LSE = (float*)(ws + WS_LSE);
    bf16* GM = (bf16*)(ws + WS_GM); bf16* XN = (bf16*)(ws + WS_XN); bf16* PROJ = (bf16*)(ws + WS_PROJ); bf16* OP = (bf16*)(ws + WS_OP);
    bf16* H1B = (bf16*)(ws + WS_H1B); bf16* HID = (bf16*)(ws + WS_HID);
    const int lo = args.ph_lo, hi = args.ph_hi;
#define IN(k) (lo <= (k) && (k) < hi)
#define SEAM(k) do { if (IN(k) && IN((k) + 1)) grid.sync(); } while (0)
#define REPS(k) for (int rep_ = 0; rep_ < ((MK_DBL == (k)) ? 2 : 1); ++rep_)
#define REPSYNC() do { if (rep_) grid.sync(); } while (0)

    if (IN(0)) REPS(0) { REPSYNC();
        LAS float* scr = (LAS float*)(lds + wave * 16384);
        constexpr int I_IN = (D / 64) * (INW / 32), I_O = (D / 64) * (D / 32), I_1 = (D / 64) * (FF / 32), I_2 = (FF / 64) * (D / 32);
        constexpr int NITEMS = I_IN + I_O + I_1 + I_2;
#pragma unroll 1
        for (int it = gw; it < NITEMS; it += NGW) {
            int r = it;
            if (r < I_IN) { p0_transpose_item(w_in, D, INW, WIN, norm1_g, AW, scr, r, lane); continue; } r -= I_IN;
            if (r < I_O) { p0_transpose_item(w_out, D, D, WOUT, (r / (D / 32)) < (AW / 64) ? attn_out_g : gmlp_out_g - AW, 0, scr, r, lane); continue; } r -= I_O;
            if (r < I_1) { p0_transpose_item(w_ff1, D, FF, W1, norm2_g, 0, scr, r, lane); continue; } r -= I_1;
            p0_transpose_item(w_ff2, FF, D, W2, nullptr, 0, scr, r, lane);
        }
#pragma unroll 1
        for (int m = gw; m < M; m += NGW) rms_row_to_bf16(x + (size_t)m * D, XN + (size_t)m * D, lane);
    }
    SEAM(0);
    if (IN(1)) REPS(1) { REPSYNC();
        pg8::Gemm g{XN, WIN, M, INW, D}; pg8::StaticOrder S; S.init(M, INW, G, bx);
        pg8::EpiBf16 E{PROJ, INW};
        pg8::gemm_phase<pg8::EpiBf16, pg8::StaticOrder, true, true>(lds, g, S, E);
    }
    SEAM(1);
    if (IN(2)) REPS(2) { REPSYNC();
#pragma unroll 1
        for (int u = vcu; u < BATCH * (SEQ / CHUNK) * NG; u += G) gmlp_unit(lds, PROJ, sgu_ln_g, sgu_ln_b, sgu_w, sgu_b, GM, u, tid);
#if MK_NAIVE_ATTN
        attn_naive(PROJ, OP, LSE, bx * (NWAVES * 64) + tid, G * NWAVES * 64);
#else
        attn_phase(lds, PROJ, OP, LSE, vcu, G, wave, lane, tid);
#endif
    }
    SEAM(2);
    if (IN(3)) REPS(3) { REPSYNC();
#pragma unroll 1
        for (int m = gw; m < M; m += NGW) mixnorm_row(OP, LSE, GM, XN, m, lane);
    }
    SEAM(3);
    if (IN(4)) REPS(4) { REPSYNC();
        pg8::Gemm g{XN, WOUT, M, D, D}; pg8::StaticOrder S; S.init(M, D, G, bx);
        pg8::EpiRes<true> E{x, out, H1B, SS1, D};
        pg8::gemm_phase<pg8::EpiRes<true>, pg8::StaticOrder, true, true>(lds, g, S, E);
    }
    SEAM(4);
    if (IN(5)) REPS(5) { REPSYNC();
        pg8::Gemm g{H1B, W1, M, FF, D}; pg8::StaticOrder S; S.init(M, FF, G, bx);
        pg8::EpiSqRelu E{HID, FF, SS1};
        pg8::gemm_phase<pg8::EpiSqRelu, pg8::StaticOrder, true, true>(lds, g, S, E);
    }
    SEAM(5);
    if (IN(6)) REPS(6) { REPSYNC();
        pg8::Gemm g{HID, W2, M, D, FF}; pg8::StaticOrder S; S.init(M, D, G, bx);
        pg8::EpiRes<false> E{out, out, nullptr, SS2, D};
        pg8::gemm_phase<pg8::EpiRes<false>, pg8::StaticOrder, true, true>(lds, g, S, E);
    }
    SEAM(6);
    if (IN(7)) REPS(7) { REPSYNC();
#pragma unroll 1
        for (int m = gw; m < M; m += NGW) {
            f32x4* orow = (f32x4*)(out + (size_t)m * D) + lane;
            float s = SS2[(size_t)m * 16 + (lane & 15)];
            s += __shfl_xor(s, 1); s += __shfl_xor(s, 2); s += __shfl_xor(s, 4); s += __shfl_xor(s, 8);
            const float rstd = 1.0f / sqrtf(s * (1.0f / D) + EPS);
#pragma unroll
            for (int j = 0; j < 4; ++j) { const f32x4 v = orow[64 * j]; const f32x4 gq = *((const f32x4*)final_g + lane + 64 * j); orow[64 * j] = v * rstd * gq; }
        }
    }
#undef IN
#undef SEAM
}

extern "C" void kernel_launch(void* const* d_in, const int* in_sizes, int n_in, void* d_out, int out_size, void* d_ws, size_t ws_size, hipStream_t stream) {
    static int grid = 0;
    if (grid == 0) {
        if (n_in != 14 || in_sizes[0] != M * D || out_size != M * D || ws_size < WS_END) { fprintf(stderr, "kernel_launch: unexpected shapes (n_in %d, in0 %d, out %d, ws %zu); nothing launched\n", n_in, n_in > 0 ? in_sizes[0] : -1, out_size, ws_size); grid = -1; return; }
        int dev = 0, cus = 0, per_cu = 0;
        if (hipGetDevice(&dev) != hipSuccess || hipDeviceGetAttribute(&cus, hipDeviceAttributeMultiprocessorCount, dev) != hipSuccess) { grid = -1; return; }
        if (hipFuncSetAttribute((const void*)hymba_fwd, hipFuncAttributeMaxDynamicSharedMemorySize, LDS_BYTES) != hipSuccess) { fprintf(stderr, "kernel_launch: hipFuncSetAttribute failed\n"); grid = -1; return; }
        if (hipOccupancyMaxActiveBlocksPerMultiprocessor(&per_cu, (const void*)hymba_fwd, NWAVES * 64, LDS_BYTES) != hipSuccess || per_cu < 1) { fprintf(stderr, "kernel_launch: occupancy query says %d blocks per CU\n", per_cu); per_cu = 1; }
        (void)hipGetLastError();
        grid = cus;
    }
    if (grid < 0) return;
    Args a{};
    for (int i = 0; i < 14; ++i) a.in[i] = (const float*)d_in[i];
    a.out = (float*)d_out; a.ws = (unsigned char*)d_ws;
#if MK_N_LAUNCHES == 1
    a.ph_lo = 0; a.ph_hi = NPH;
    void* kargs[] = {&a};
    hipError_t e = hipLaunchCooperativeKernel((const void*)hymba_fwd, dim3(grid), dim3(NWAVES * 64), kargs, LDS_BYTES, stream);
    if (e != hipSuccess) fprintf(stderr, "kernel_launch: cooperative launch failed: %s (grid %d)\n", hipGetErrorString(e), grid);
#else
    for (int ph = 0; ph < NPH; ++ph) {
        a.ph_lo = ph; a.ph_hi = ph + 1;
        hipLaunchKernelGGL(hymba_fwd, dim3(grid), dim3(NWAVES * 64), LDS_BYTES, stream, a);
    }
#endif
}
```

```cpp
#include <hip/hip_runtime.h>
#include <hip/hip_cooperative_groups.h>
#include <cstdio>
#include <cstdint>
namespace cg = cooperative_groups;
#define MK_NAIVE_ATTN 0
#define MK_N_LAUNCHES 1
#define MK_DBL -1
namespace pg8 {
#define PG8_LAS __attribute__((address_space(3)))
typedef unsigned short bf16_t;
typedef short bf16x8 __attribute__((ext_vector_type(8)));
typedef float f32x4 __attribute__((ext_vector_type(4)));
typedef unsigned u32x4 __attribute__((ext_vector_type(4)));
constexpr int BM = 256, BK = 64, HALF = 128, HTB = HALF * BK * 2  , STAGE_BYTES = 8 * HTB, NXCD = 8, WGM = 8;

__host__ __device__ __forceinline__ int lds_byte(int r, int c) { const int st = (r >> 4) * 2 + (c >> 5), rr = r & 15, cc = c & 31, ob = rr * 64 + cc * 2; return st * 1024 + (ob ^ (((ob >> 9) & 1) << 5)); }
__host__ __device__ __forceinline__ void stage_rc(int b, int& R, int& C) { const int st = b / 1024, sb = b % 1024, swz = sb ^ (((sb >> 9) & 1) << 5); R = (st >> 1) * 16 + swz / 64; C = (st & 1) * 32 + (swz % 64) / 2; }
__host__ __device__ __forceinline__ int perm32(int rho) { const int n = rho >> 4, i = rho & 15; return 8 * (i >> 2) + 4 * n + (i & 3); }

struct Unit { int pm, pn; };
struct Gemm { const bf16_t* A; const bf16_t* Bt; int M, N, K; };

struct StaticOrder {
    int nM, nN, nwg, G, c;
    __host__ __device__ void init(int M, int N, int G_, int c_) { nM = M / BM; nN = N / BM; nwg = nM * nN; G = G_; c = c_; }
    __host__ __device__ bool next(int i, Unit& u) const {
        const long L = (long)i * G + c; if (L >= nwg) return false;
        int wgid = (int)L; { const int q = nwg / NXCD, r = nwg % NXCD, xcd = wgid % NXCD, off = wgid / NXCD; wgid = (xcd < r ? xcd * (q + 1) : r * (q + 1) + (xcd - r) * q) + off; }
        const int nig = WGM * nN, gid = wgid / nig, fm = gid * WGM, gsz = (nM - fm) < WGM ? (nM - fm) : WGM;
        u.pm = fm + ((wgid % nig) % gsz); u.pn = (wgid % nig) / gsz; return true;
    }
    __device__ __forceinline__ void a_ready(const Unit&) const {}
    __device__ __forceinline__ void done(const Unit&) const {}
};

__device__ __forceinline__ unsigned cvt_pk_bf16(float lo, float hi) { unsigned r; asm volatile("v_cvt_pk_bf16_f32 %0, %1, %2" : "=v"(r) : "v"(lo), "v"(hi)); return r; }
typedef unsigned u32x2 __attribute__((ext_vector_type(2)));
struct EpiBf16 {
    static constexpr bool PERM = true, AFTER_DRAIN = false;
    bf16_t* O; int ldc;
    __device__ __forceinline__ void operator()(const f32x4 (&acc)[2][2][4][2], const Unit& u, int wr, int wc, int fr, int fq) const {
        const int row0 = u.pm * BM + wr * 64 + fr; const int col0 = u.pn * BM + wc * 32 + 8 * fq;
#pragma unroll
        for (int ai = 0; ai < 2; ++ai)
#pragma unroll
            for (int m = 0; m < 4; ++m) { bf16_t* rowp = O + (size_t)(row0 + ai * HALF + m * 16) * ldc + col0;
#pragma unroll
                for (int bj = 0; bj < 2; ++bj) { const f32x4 v0 = acc[ai][bj][m][0], v1 = acc[ai][bj][m][1];
                    u32x4 w; w.x = cvt_pk_bf16(v0[0], v0[1]); w.y = cvt_pk_bf16(v0[2], v0[3]); w.z = cvt_pk_bf16(v1[0], v1[1]); w.w = cvt_pk_bf16(v1[2], v1[3]);
                    *(u32x4*)(rowp + bj * HALF) = w; } }
    }
};
struct EpiSqRelu {
    static constexpr bool PERM = true, AFTER_DRAIN = false;
    bf16_t* O; int ldc; const float* ss;
    __device__ __forceinline__ void operator()(const f32x4 (&acc)[2][2][4][2], const Unit& u, int wr, int wc, int fr, int fq) const {
        const int row0 = u.pm * BM + wr * 64 + fr; const int col0 = u.pn * BM + wc * 32 + 8 * fq;
#pragma unroll
        for (int ai = 0; ai < 2; ++ai)
#pragma unroll
            for (int m = 0; m < 4; ++m) { const int r = row0 + ai * HALF + m * 16; bf16_t* rowp = O + (size_t)r * ldc + col0;
                const f32x4* sp = (const f32x4*)(ss + (size_t)r * 16); const f32x4 s0 = sp[0], s1 = sp[1], s2 = sp[2], s3 = sp[3];
                const float tot = ((s0[0] + s0[1]) + (s0[2] + s0[3])) + ((s1[0] + s1[1]) + (s1[2] + s1[3])) + ((s2[0] + s2[1]) + (s2[2] + s2[3])) + ((s3[0] + s3[1]) + (s3[2] + s3[3]));
                const float rstd = 1.0f / sqrtf(tot * (1.0f / 1024.0f) + 1e-6f);
#pragma unroll
                for (int bj = 0; bj < 2; ++bj) { f32x4 v0 = acc[ai][bj][m][0] * rstd, v1 = acc[ai][bj][m][1] * rstd;
#pragma unroll
                    for (int e = 0; e < 4; ++e) { const float a = fmaxf(v0[e], 0.f), b = fmaxf(v1[e], 0.f); v0[e] = a * a; v1[e] = b * b; }
                    u32x4 w; w.x = cvt_pk_bf16(v0[0], v0[1]); w.y = cvt_pk_bf16(v0[2], v0[3]); w.z = cvt_pk_bf16(v1[0], v1[1]); w.w = cvt_pk_bf16(v1[2], v1[3]);
                    *(u32x4*)(rowp + bj * HALF) = w; } }
    }
};
struct EpiResA {
    static constexpr bool PERM = true, AFTER_DRAIN = false;
    const float* base; bf16_t* ob; float* ss; int ldc;
    __device__ __forceinline__ void operator()(const f32x4 (&acc)[2][2][4][2], const Unit& u, int wr, int wc, int fr, int fq) const {
        const int row0 = u.pm * BM + wr * 64 + fr; const int col0 = u.pn * BM + wc * 32 + 8 * fq;
#pragma unroll
        for (int ai = 0; ai < 2; ++ai)
#pragma unroll
            for (int m = 0; m < 4; ++m) { const int r = row0 + ai * HALF + m * 16; const size_t off = (size_t)r * ldc + col0; float s = 0.f;
#pragma unroll
                for (int bj = 0; bj < 2; ++bj) { const f32x4 v0 = *(const f32x4*)(base + off + bj * HALF) + acc[ai][bj][m][0], v1 = *(const f32x4*)(base + off + bj * HALF + 4) + acc[ai][bj][m][1];
                    s += ((v0[0] * v0[0] + v0[1] * v0[1]) + (v0[2] * v0[2] + v0[3] * v0[3])) + ((v1[0] * v1[0] + v1[1] * v1[1]) + (v1[2] * v1[2] + v1[3] * v1[3]));
                    u32x4 w; w.x = cvt_pk_bf16(v0[0], v0[1]); w.y = cvt_pk_bf16(v0[2], v0[3]); w.z = cvt_pk_bf16(v1[0], v1[1]); w.w = cvt_pk_bf16(v1[2], v1[3]);
                    *(u32x4*)(ob + off + bj * HALF) = w; }
                s += __shfl_xor(s, 16); s += __shfl_xor(s, 32);
                if (fq == 0) ss[(size_t)r * 16 + u.pn * 4 + wc] = s; }
    }
};
struct EpiResB {
    static constexpr bool PERM = true, AFTER_DRAIN = false;
    const bf16_t* hb; float* out; float* ss; int ldc;
    __device__ __forceinline__ void operator()(const f32x4 (&acc)[2][2][4][2], const Unit& u, int wr, int wc, int fr, int fq) const {
        const int row0 = u.pm * BM + wr * 64 + fr; const int col0 = u.pn * BM + wc * 32 + 8 * fq;
#pragma unroll
        for (int ai = 0; ai < 2; ++ai)
#pragma unroll
            for (int m = 0; m < 4; ++m) { const int r = row0 + ai * HALF + m * 16; const size_t off = (size_t)r * ldc + col0; float s = 0.f;
#pragma unroll
                for (int bj = 0; bj < 2; ++bj) { const u32x4 rb = *(const u32x4*)(hb + off + bj * HALF);
                    f32x4 v0, v1; v0[0] = __uint_as_float(rb.x << 16); v0[1] = __uint_as_float(rb.x & 0xffff0000u); v0[2] = __uint_as_float(rb.y << 16); v0[3] = __uint_as_float(rb.y & 0xffff0000u);
                    v1[0] = __uint_as_float(rb.z << 16); v1[1] = __uint_as_float(rb.z & 0xffff0000u); v1[2] = __uint_as_float(rb.w << 16); v1[3] = __uint_as_float(rb.w & 0xffff0000u);
                    v0 += acc[ai][bj][m][0]; v1 += acc[ai][bj][m][1];
                    s += ((v0[0] * v0[0] + v0[1] * v0[1]) + (v0[2] * v0[2] + v0[3] * v0[3])) + ((v1[0] * v1[0] + v1[1] * v1[1]) + (v1[2] * v1[2] + v1[3] * v1[3]));
                    *(f32x4*)(out + off + bj * HALF) = v0; *(f32x4*)(out + off + bj * HALF + 4) = v1; }
                s += __shfl_xor(s, 16); s += __shfl_xor(s, 32);
                if (fq == 0) ss[(size_t)r * 16 + u.pn * 4 + wc] = s; }
    }
};
template <class Epi, class Sched, bool ALIGN_EPI = false, bool SP2 = false>
__device__ __forceinline__ void gemm_phase(PG8_LAS unsigned char* lds, const Gemm g, const Sched& S, const Epi& E) {
    const int tid = threadIdx.x, wid = __builtin_amdgcn_readfirstlane(tid >> 6), lane = tid & 63, wr = wid >> 2, wc = wid & 3, fr = lane & 15, fq = lane >> 4;
    const int K = g.K, nt = K / BK;
    unsigned voffA[2], voffB[2];
#pragma unroll
    for (int i = 0; i < 2; ++i) { int R, C; stage_rc(tid * 16 + i * 8192, R, C); const int Rb = Epi::PERM ? ((R & ~31) + perm32(R & 31)) : R;
        voffA[i] = (unsigned)(R * K + C) * 2u; voffB[i] = (unsigned)(Rb * K + C) * 2u; }
    const size_t kstep = (size_t)(BK * 2);
    const size_t hstep = (size_t)HALF * K * 2;
    const size_t tstep = 2 * hstep;
    const unsigned ldsw = (unsigned)wid * 1024u;
    const int aoff = lds_byte(wr * 64 + fr, fq * 8), boff = lds_byte(wc * 32 + fr, fq * 8);
#define PG8_SA(b, h) (((b) * 2 + (h)) * HTB)
#define PG8_SB(b, h) ((4 + (b) * 2 + (h)) * HTB)
#define PG8_STAGE(bufoff, gbase, voff) do { _Pragma("unroll") for (int _i = 0; _i < 2; ++_i) \
        __builtin_amdgcn_global_load_lds((const unsigned*)((const char*)(gbase) + (voff)[_i]), (PG8_LAS unsigned*)(lds + (bufoff) + ldsw + _i * 8192), 16, 0, 0); } while (0)
#define PG8_LDA(dst, b, h) do { _Pragma("unroll") for (int m = 0; m < 4; ++m) _Pragma("unroll") for (int k = 0; k < 2; ++k) dst[m][k] = *(const PG8_LAS bf16x8*)(lds + PG8_SA(b, h) + aoff + m * 2048 + k * 1024); } while (0)
#define PG8_LDB(dst, b, h) do { _Pragma("unroll") for (int n = 0; n < 2; ++n) _Pragma("unroll") for (int k = 0; k < 2; ++k) dst[n][k] = *(const PG8_LAS bf16x8*)(lds + PG8_SB(b, h) + boff + n * 2048 + k * 1024); } while (0)
#define PG8_MMA(ai, bj, At, Bt) do { __builtin_amdgcn_s_setprio(1); _Pragma("unroll") for (int m = 0; m < 4; ++m) _Pragma("unroll") for (int n = 0; n < 2; ++n) _Pragma("unroll") for (int k = 0; k < 2; ++k) \
        acc[ai][bj][m][n] = __builtin_amdgcn_mfma_f32_16x16x32_bf16(Bt[n][k], At[m][k], acc[ai][bj][m][n], 0, 0, 0); __builtin_amdgcn_s_setprio(0); } while (0)
#define PG8_WAIT_V(n) asm volatile("s_waitcnt vmcnt(" #n ")" ::: "memory")
#define PG8_WAIT_L(n) asm volatile("s_waitcnt lgkmcnt(" #n ")" ::: "memory")
#define PG8_BAR __builtin_amdgcn_s_barrier()
#define PG8_SCHED __builtin_amdgcn_sched_barrier(0)
    Unit cur, nxt; int ui = 0;
    if (!S.next(0, cur)) return;
    f32x4 acc[2][2][4][2];
#pragma unroll
    for (int a = 0; a < 2; ++a)
#pragma unroll
        for (int b = 0; b < 2; ++b)
#pragma unroll
            for (int m = 0; m < 4; ++m)
#pragma unroll
                for (int n = 0; n < 2; ++n) acc[a][b][m][n] = (f32x4){0.f, 0.f, 0.f, 0.f};
    bf16x8 At[4][2], B0[2][2], B1[2][2];
    const char* cA = (const char*)g.A + (size_t)cur.pm * tstep; const char* cB = (const char*)g.Bt + (size_t)cur.pn * tstep;
    S.a_ready(cur);
    if constexpr (SP2) {
        PG8_STAGE(PG8_SB(0, 0), cB, voffB); PG8_STAGE(PG8_SB(0, 1), cB + hstep, voffB); PG8_STAGE(PG8_SA(0, 0), cA, voffA); PG8_STAGE(PG8_SA(0, 1), cA + hstep, voffA);
        if (wr == 1) PG8_BAR;
        PG8_WAIT_V(2); PG8_BAR;
        PG8_STAGE(PG8_SB(1, 0), cB + kstep, voffB); PG8_STAGE(PG8_SA(1, 0), cA + kstep, voffA); PG8_STAGE(PG8_SB(1, 1), cB + hstep + kstep, voffB);
        PG8_WAIT_V(6); PG8_BAR;
    } else {
        PG8_STAGE(PG8_SB(0, 0), cB, voffB); PG8_STAGE(PG8_SA(0, 0), cA, voffA); PG8_STAGE(PG8_SB(0, 1), cB + hstep, voffB); PG8_STAGE(PG8_SA(0, 1), cA + hstep, voffA);
        if (wr == 1) PG8_BAR;
        PG8_WAIT_V(4); PG8_BAR;
        PG8_STAGE(PG8_SB(1, 0), cB + kstep, voffB); PG8_STAGE(PG8_SA(1, 0), cA + kstep, voffA); PG8_STAGE(PG8_SB(1, 1), cB + hstep + kstep, voffB);
        PG8_WAIT_V(6); PG8_BAR;
    }
    for (;;) {
        const bool has_next = S.next(ui + 1, nxt);
        const char* nA = has_next ? (const char*)g.A + (size_t)nxt.pm * tstep : cA; const char* nB = has_next ? (const char*)g.Bt + (size_t)nxt.pn * tstep : cB;
        for (int t = 0; t < nt; t += 2) {
            const bool last = (t == nt - 2);
            const char* a1 = cA + (size_t)(t + 1) * kstep;
            const char* a2 = last ? nA : cA + (size_t)(t + 2) * kstep; const char* b2 = last ? nB : cB + (size_t)(t + 2) * kstep;
            const char* a3 = a2 + kstep; const char* b3 = b2 + kstep;
            if (last && has_next) S.a_ready(nxt);
            if constexpr (SP2) {
            PG8_LDB(B0, 0, 0); PG8_LDB(B1, 0, 1); PG8_SCHED; PG8_LDA(At, 0, 0); PG8_STAGE(PG8_SA(1, 1), a1 + hstep, voffA);
            PG8_WAIT_V(8); PG8_WAIT_L(0); PG8_BAR; PG8_MMA(0, 0, At, B0); PG8_MMA(0, 1, At, B1); PG8_BAR; PG8_SCHED;
            PG8_LDA(At, 0, 1); PG8_STAGE(PG8_SB(0, 0), b2, voffB); PG8_STAGE(PG8_SB(0, 1), b2 + hstep, voffB); PG8_STAGE(PG8_SA(0, 0), a2, voffA);
            PG8_WAIT_V(8); PG8_WAIT_L(0); PG8_BAR; PG8_MMA(1, 0, At, B0); PG8_MMA(1, 1, At, B1); PG8_BAR; PG8_SCHED;
            PG8_LDB(B0, 1, 0); PG8_LDB(B1, 1, 1); PG8_SCHED; PG8_LDA(At, 1, 0); PG8_STAGE(PG8_SA(0, 1), a2 + hstep, voffA);
            PG8_WAIT_V(8); PG8_WAIT_L(0); PG8_BAR; PG8_MMA(0, 0, At, B0); PG8_MMA(0, 1, At, B1); PG8_BAR; PG8_SCHED;
            PG8_LDA(At, 1, 1); PG8_STAGE(PG8_SB(1, 0), b3, voffB); PG8_STAGE(PG8_SB(1, 1), b3 + hstep, voffB); PG8_STAGE(PG8_SA(1, 0), a3, voffA);
            PG8_WAIT_V(8); PG8_WAIT_L(0); PG8_BAR; PG8_MMA(1, 0, At, B0); PG8_MMA(1, 1, At, B1); PG8_BAR; PG8_SCHED;
            } else {
            PG8_LDB(B0, 0, 0); PG8_SCHED; PG8_LDA(At, 0, 0); PG8_STAGE(PG8_SA(1, 1), a1 + hstep, voffA);
            PG8_WAIT_L(8); PG8_BAR; PG8_WAIT_L(0); PG8_MMA(0, 0, At, B0); PG8_BAR; PG8_SCHED;
            PG8_LDB(B1, 0, 1); PG8_STAGE(PG8_SB(0, 0), b2, voffB);
            PG8_BAR; PG8_WAIT_L(0); PG8_MMA(0, 1, At, B1); PG8_BAR;
            PG8_LDA(At, 0, 1); PG8_STAGE(PG8_SA(0, 0), a2, voffA);
            PG8_BAR; PG8_WAIT_L(0); PG8_MMA(1, 0, At, B0); PG8_BAR; PG8_SCHED;
            PG8_STAGE(PG8_SB(0, 1), b2 + hstep, voffB);
            PG8_WAIT_V(6); PG8_BAR; PG8_MMA(1, 1, At, B1); PG8_BAR;
            PG8_LDB(B0, 1, 0); PG8_SCHED; PG8_LDA(At, 1, 0); PG8_STAGE(PG8_SA(0, 1), a2 + hstep, voffA);
            PG8_WAIT_L(8); PG8_BAR; PG8_WAIT_L(0); PG8_MMA(0, 0, At, B0); PG8_BAR; PG8_SCHED;
            PG8_LDB(B1, 1, 1); PG8_STAGE(PG8_SB(1, 0), b3, voffB);
            PG8_BAR; PG8_WAIT_L(0); PG8_MMA(0, 1, At, B1); PG8_BAR;
            PG8_LDA(At, 1, 1); PG8_STAGE(PG8_SA(1, 0), a3, voffA);
            PG8_BAR; PG8_WAIT_L(0); PG8_MMA(1, 0, At, B0); PG8_BAR; PG8_SCHED;
            PG8_STAGE(PG8_SB(1, 1), b3 + hstep, voffB);
            PG8_WAIT_V(6); PG8_BAR; PG8_MMA(1, 1, At, B1); PG8_BAR;
            }
        }
        if constexpr (ALIGN_EPI) { if (wr == 0) PG8_BAR; }
        if constexpr (!Epi::AFTER_DRAIN) { E(acc, cur, wr, wc, fr, fq); S.done(cur); }
        if (!has_next) break;
#pragma unroll
        for (int a = 0; a < 2; ++a)
#pragma unroll
            for (int b = 0; b < 2; ++b)
#pragma unroll
                for (int m = 0; m < 4; ++m)
#pragma unroll
                    for (int n = 0; n < 2; ++n) acc[a][b][m][n] = (f32x4){0.f, 0.f, 0.f, 0.f};
        cur = nxt; cA = nA; cB = nB; ++ui;
        if constexpr (ALIGN_EPI) { if (wr == 1) PG8_BAR; }
    }
    PG8_WAIT_V(0);
    if constexpr (!ALIGN_EPI) { if (wr == 0) PG8_BAR; }
    PG8_BAR;
    if constexpr (Epi::AFTER_DRAIN) { E.fused(acc, cur, wr, wc, fr, fq, lds, wid, lane); S.done(cur); }
#undef PG8_SA
#undef PG8_SB
#undef PG8_STAGE
#undef PG8_LDA
#undef PG8_LDB
#undef PG8_MMA
#undef PG8_WAIT_V
#undef PG8_WAIT_L
#undef PG8_BAR
#undef PG8_SCHED
}
}
#define GAS __attribute__((address_space(1)))
#define LAS __attribute__((address_space(3)))
typedef unsigned short bf16;
typedef unsigned v4u __attribute__((ext_vector_type(4)));
typedef unsigned v2u __attribute__((ext_vector_type(2)));
typedef float f32x4 __attribute__((ext_vector_type(4)));
typedef float f32x16 __attribute__((ext_vector_type(16)));
typedef short bf16x8 __attribute__((ext_vector_type(8)));
#define LDS_WAIT() asm volatile("s_waitcnt lgkmcnt(0)" ::: "memory")

#ifndef MK_N_LAUNCHES
#define MK_N_LAUNCHES 1
#endif
#ifndef MK_NAIVE_ATTN
#define MK_NAIVE_ATTN 0
#endif
constexpr int NWAVES = 8, NPH = 8;
constexpr int BATCH = 4, SEQ = 8192, D = 1024, NH = 12, HD = 64, AW = 768, GWD = 256, NG = 4, INW = 2816, FF = 4096, M = BATCH * SEQ, CHUNK = 128;
constexpr float EPS = 1e-6f;
constexpr size_t MiB = 1u << 20;
constexpr size_t WS_WIN = 2 * MiB, WS_WOUT = 8 * MiB, WS_W1 = 10 * MiB, WS_W2 = 18 * MiB, WS_SS1 = 26 * MiB, WS_SS2 = 28 * MiB, WS_LSE = 30 * MiB, WS_GM = 36 * MiB,
                 WS_XN = 64 * MiB, WS_PROJ = 128 * MiB, WS_OP = 304 * MiB, WS_H1B = 128 * MiB, WS_HID = 192 * MiB, WS_END = 448 * MiB;
static_assert(WS_WIN + (size_t)INW * D * 2 <= WS_WOUT && WS_LSE + (size_t)3 * M * NH * 4 <= WS_GM && WS_GM + (size_t)M * GWD * 2 <= WS_XN && WS_PROJ + (size_t)M * INW * 2 <= WS_OP && WS_OP + (size_t)3 * M * AW * 2 <= WS_END && WS_HID + (size_t)M * FF * 2 <= WS_END, "ws map");
constexpr int LDS_BYTES = 147456;

__device__ __forceinline__ float bflo(unsigned u) { return __uint_as_float(u << 16); }
__device__ __forceinline__ float bfhi(unsigned u) { return __uint_as_float(u & 0xffff0000u); }
__device__ __forceinline__ unsigned pk2(float lo, float hi) { return pg8::cvt_pk_bf16(lo, hi); }
__device__ __forceinline__ float wave_sum(float v) {
#pragma unroll
    for (int o = 1; o < 64; o <<= 1) v += __shfl_xor(v, o);
    return v;
}
__device__ __forceinline__ float gelu_t(float x) { const float y = 0.7978845608028654f * (x + 0.044715f * x * x * x); return x / (1.0f + __expf(-2.0f * y)); }

__device__ __forceinline__ void p0_transpose_item(const float* W, int K, int N, bf16* WT, const float* gk, int qcols, LAS float* scr, int item, int lane) {
    const int nblk = N / 32, kb = item / nblk, nb = item % nblk, k0 = 64 * kb, n0 = 32 * nb;
#pragma unroll 8
    for (int i = 0; i < 32; ++i) { const int kk = 2 * i + (lane >> 5); const float g = gk ? gk[k0 + kk] : 1.0f; scr[kk * 33 + (lane & 31)] = W[(size_t)(k0 + kk) * N + n0 + (lane & 31)] * g; }
    LDS_WAIT();
    const int c = lane & 7;
#pragma unroll
    for (int j = 0; j < 4; ++j) { const int n = (lane >> 3) + 8 * j; const LAS float* s = scr + (8 * c) * 33 + n; const float sc = (n0 + n < qcols) ? 0.125f : 1.0f;
        v4u o; o.x = pk2(s[0 * 33] * sc, s[1 * 33] * sc); o.y = pk2(s[2 * 33] * sc, s[3 * 33] * sc); o.z = pk2(s[4 * 33] * sc, s[5 * 33] * sc); o.w = pk2(s[6 * 33] * sc, s[7 * 33] * sc);
        *(v4u*)(WT + (size_t)(n0 + n) * K + k0 + 8 * c) = o; }
    LDS_WAIT();
}
__device__ __forceinline__ void rms_row_to_bf16(const float* xrow, bf16* orow, int lane) {
    const f32x4* xr = (const f32x4*)xrow + lane;
    f32x4 v[4]; float s = 0.f;
#pragma unroll
    for (int j = 0; j < 4; ++j) { v[j] = xr[64 * j]; s += (v[j].x * v[j].x + v[j].y * v[j].y) + (v[j].z * v[j].z + v[j].w * v[j].w); }
    const float rstd = 1.0f / sqrtf(wave_sum(s) * (1.0f / D) + EPS);
    v2u* o8 = (v2u*)orow + lane;
#pragma unroll
    for (int j = 0; j < 4; ++j) { v2u w; w.x = pk2(v[j].x * rstd, v[j].y * rstd); w.y = pk2(v[j].z * rstd, v[j].w * rstd); o8[64 * j] = w; }
}

__device__ __forceinline__ void gmlp_unit(LAS unsigned char* lds, const bf16* PROJ, const float* ln_g, const float* ln_b, const float* sgu_w, const float* sgu_b, bf16* GM, int unit, int tid) {
    const int g = unit & 3, n = (unit >> 2) & 63, b = unit >> 8;
    const size_t row0 = (size_t)b * SEQ + (size_t)n * CHUNK;
    LAS float* zn = (LAS float*)lds;
    LAS float* wl = (LAS float*)(lds + 128 * 68 * 4);
    const float* wg = sgu_w + (size_t)g * CHUNK * CHUNK;
    for (int i = tid; i < CHUNK * CHUNK; i += NWAVES * 64) wl[(i >> 7) * 129 + (i & 127)] = wg[i];
    {
        const int t = tid >> 2, q = tid & 3;
        const bf16* zp = PROJ + (row0 + t) * INW + 2560 + g * 64 + 16 * q;
        const v4u r0 = *(const v4u*)zp, r1 = *(const v4u*)(zp + 8);
        float z[16];
        z[0] = bflo(r0.x); z[1] = bfhi(r0.x); z[2] = bflo(r0.y); z[3] = bfhi(r0.y); z[4] = bflo(r0.z); z[5] = bfhi(r0.z); z[6] = bflo(r0.w); z[7] = bfhi(r0.w);
        z[8] = bflo(r1.x); z[9] = bfhi(r1.x); z[10] = bflo(r1.y); z[11] = bfhi(r1.y); z[12] = bflo(r1.z); z[13] = bfhi(r1.z); z[14] = bflo(r1.w); z[15] = bfhi(r1.w);
        float s = 0.f;
#pragma unroll
        for (int e = 0; e < 16; ++e) { z[e] = gelu_t(z[e]); s += z[e]; }
        s += __shfl_xor(s, 1); s += __shfl_xor(s, 2);
        const float mean = s * (1.0f / 64.0f); float v = 0.f;
#pragma unroll
        for (int e = 0; e < 16; ++e) { z[e] -= mean; v += z[e] * z[e]; }
        v += __shfl_xor(v, 1); v += __shfl_xor(v, 2);
        const float rstd = 1.0f / sqrtf(v * (1.0f / 64.0f) + EPS);
        const float* lg = ln_g + g * 64 + 16 * q; const float* lb = ln_b + g * 64 + 16 * q;
#pragma unroll
        for (int e4 = 0; e4 < 4; ++e4) { f32x4 o;
#pragma unroll
            for (int e = 0; e < 4; ++e) o[e] = z[4 * e4 + e] * rstd * lg[4 * e4 + e] + lb[4 * e4 + e];
            *(LAS f32x4*)(zn + t * 68 + 16 * q + 4 * e4) = o; }
    }
    __syncthreads();
    const int wv = __builtin_amdgcn_readfirstlane(tid >> 6), lane = tid & 63, tr = lane >> 3, cq = lane & 7;
#pragma unroll 1
    for (int half = 0; half < 2; ++half) {
        const int blk = half ? 15 - wv : wv, t = 8 * blk + tr, smax = 8 * blk + 7;
        float acc[8];
#pragma unroll
        for (int e = 0; e < 8; ++e) acc[e] = 0.f;
#pragma unroll 4
        for (int s = 0; s <= smax; ++s) {
            float w = wl[t * 129 + s]; w = (s <= t) ? w : 0.f;
            const f32x4 z0 = *(const LAS f32x4*)(zn + s * 68 + 8 * cq), z1 = *(const LAS f32x4*)(zn + s * 68 + 8 * cq + 4);
#pragma unroll
            for (int e = 0; e < 4; ++e) { acc[e] += w * z0[e]; acc[4 + e] += w * z1[e]; }
        }
        const v4u ur = *(const v4u*)(PROJ + (row0 + t) * INW + 2304 + g * 64 + 8 * cq);
        const float bs = sgu_b[g * CHUNK + t];
        float u[8]; u[0] = bflo(ur.x); u[1] = bfhi(ur.x); u[2] = bflo(ur.y); u[3] = bfhi(ur.y); u[4] = bflo(ur.z); u[5] = bfhi(ur.z); u[6] = bflo(ur.w); u[7] = bfhi(ur.w);
#pragma unroll
        for (int e = 0; e < 8; ++e) u[e] = gelu_t(u[e]) * (acc[e] + bs);
        v4u o; o.x = pk2(u[0], u[1]); o.y = pk2(u[2], u[3]); o.z = pk2(u[4], u[5]); o.w = pk2(u[6], u[7]);
        *(v4u*)(GM + (row0 + t) * GWD + g * 64 + 8 * cq) = o;
    }
    __syncthreads();
}

__device__ __forceinline__ float alibi_slope(int h) { return (h < 8) ? exp2f(-(float)(h + 1)) : exp2f(-0.5f - (float)(h - 8)); }

#if MK_NAIVE_ATTN
__device__ __forceinline__ void attn_naive(const bf16* PROJ, bf16* OP, float* LSE, int gtid, int nthreads) {
#pragma unroll 1
    for (int it = gtid; it < M * NH * 3; it += nthreads) {
        const int h = it % NH, row = (it / NH) % M, p = it / (NH * M), dil = 1 << (2 * p), t = row % SEQ;
        const float slope = alibi_slope(h);
        const bf16* qp = PROJ + (size_t)row * INW + h * 64;
        float q[64], o[64];
#pragma unroll
        for (int c = 0; c < 8; ++c) { const v4u r = *(const v4u*)(qp + 8 * c); q[8*c] = bflo(r.x); q[8*c+1] = bfhi(r.x); q[8*c+2] = bflo(r.y); q[8*c+3] = bfhi(r.y); q[8*c+4] = bflo(r.z); q[8*c+5] = bfhi(r.z); q[8*c+6] = bflo(r.w); q[8*c+7] = bfhi(r.w); }
#pragma unroll
        for (int e = 0; e < 64; ++e) o[e] = 0.f;
        float m = -1e30f, l = 0.f;
#pragma unroll 1
        for (int j = 0; j <= 128; ++j) {
            const int tk = t - dil * j; if (tk < 0) break;
            const bf16* kp = qp + 768 - (size_t)(dil * j) * INW; const bf16* vp = kp + 768;
            float dot = 0.f;
#pragma unroll
            for (int c = 0; c < 8; ++c) { const v4u r = *(const v4u*)(kp + 8 * c);
                dot += q[8*c] * bflo(r.x) + q[8*c+1] * bfhi(r.x) + q[8*c+2] * bflo(r.y) + q[8*c+3] * bfhi(r.y) + q[8*c+4] * bflo(r.z) + q[8*c+5] * bfhi(r.z) + q[8*c+6] * bflo(r.w) + q[8*c+7] * bfhi(r.w); }
            const float s = dot - slope * (float)(dil * j);
            const float mn = fmaxf(m, s), sc = __expf(m - mn), pe = __expf(s - mn);
            l = l * sc + pe; m = mn;
#pragma unroll
            for (int c = 0; c < 8; ++c) { const v4u r = *(const v4u*)(vp + 8 * c);
                o[8*c] = o[8*c] * sc + pe * bflo(r.x); o[8*c+1] = o[8*c+1] * sc + pe * bfhi(r.x); o[8*c+2] = o[8*c+2] * sc + pe * bflo(r.y); o[8*c+3] = o[8*c+3] * sc + pe * bfhi(r.y);
                o[8*c+4] = o[8*c+4] * sc + pe * bflo(r.z); o[8*c+5] = o[8*c+5] * sc + pe * bfhi(r.z); o[8*c+6] = o[8*c+6] * sc + pe * bflo(r.w); o[8*c+7] = o[8*c+7] * sc + pe * bfhi(r.w); }
        }
        const float il = 1.0f / l;
        bf16* op = OP + ((size_t)p * M + row) * AW + h * 64;
#pragma unroll
        for (int c = 0; c < 8; ++c) { v4u w; w.x = pk2(o[8*c] * il, o[8*c+1] * il); w.y = pk2(o[8*c+2] * il, o[8*c+3] * il); w.z = pk2(o[8*c+4] * il, o[8*c+5] * il); w.w = pk2(o[8*c+6] * il, o[8*c+7] * il); *(v4u*)(op + 8 * c) = w; }
        LSE[((size_t)p * M + row) * NH + h] = m + __logf(l);
    }
}
#endif

__device__ __forceinline__ void mixnorm_row(const bf16* OP, const float* LSE, const bf16* GM, bf16* MIXED, int row, int lane) {
    float a[3][4]; float ssa = 0.f;
#pragma unroll
    for (int j = 0; j < 3; ++j) {
        const int c = 256 * j + 4 * lane, head = c >> 6;
        float ls[3];
#pragma unroll
        for (int p = 0; p < 3; ++p) ls[p] = LSE[((size_t)p * M + row) * NH + head];
        const float mx = fmaxf(ls[0], fmaxf(ls[1], ls[2]));
        float w[3]; float wsum = 0.f;
#pragma unroll
        for (int p = 0; p < 3; ++p) { w[p] = __expf(ls[p] - mx); wsum += w[p]; }
        const float iw = 1.0f / wsum;
#pragma unroll
        for (int e = 0; e < 4; ++e) a[j][e] = 0.f;
#pragma unroll
        for (int p = 0; p < 3; ++p) { const v2u r = *(const v2u*)(OP + ((size_t)p * M + row) * AW + c); const float wp = w[p] * iw;
            a[j][0] += wp * bflo(r.x); a[j][1] += wp * bfhi(r.x); a[j][2] += wp * bflo(r.y); a[j][3] += wp * bfhi(r.y); }
#pragma unroll
        for (int e = 0; e < 4; ++e) ssa += a[j][e] * a[j][e];
    }
    const v2u gr = *(const v2u*)(GM + (size_t)row * GWD + 4 * lane);
    float gv[4]; gv[0] = bflo(gr.x); gv[1] = bfhi(gr.x); gv[2] = bflo(gr.y); gv[3] = bfhi(gr.y);
    float ssg = (gv[0] * gv[0] + gv[1] * gv[1]) + (gv[2] * gv[2] + gv[3] * gv[3]);
    const float ra = 1.0f / sqrtf(wave_sum(ssa) * (1.0f / AW) + EPS), rg = 1.0f / sqrtf(wave_sum(ssg) * (1.0f / GWD) + EPS);
    bf16* mp = MIXED + (size_t)row * D;
#pragma unroll
    for (int j = 0; j < 3; ++j) { v2u w; w.x = pk2(a[j][0] * ra, a[j][1] * ra); w.y = pk2(a[j][2] * ra, a[j][3] * ra); *(v2u*)(mp + 256 * j + 4 * lane) = w; }
    { v2u w; w.x = pk2(gv[0] * rg, gv[1] * rg); w.y = pk2(gv[2] * rg, gv[3] * rg); *(v2u*)(mp + AW + 4 * lane) = w; }
}
#if !MK_NAIVE_ATTN
typedef short v4i16_t __attribute__((ext_vector_type(4)));
typedef float f32x2_t __attribute__((ext_vector_type(2)));
typedef __bf16 bf16x2_t __attribute__((ext_vector_type(2)));
__device__ __forceinline__ unsigned cvtpk_s(float lo, float hi) { f32x2_t v = {lo, hi}; bf16x2_t b = __builtin_convertvector(v, bf16x2_t); return __builtin_bit_cast(unsigned, b); }
__device__ __forceinline__ v4i16_t vtr(const LAS unsigned char* p) { return __builtin_amdgcn_ds_read_tr16_b64_v4i16((LAS v4i16_t*)p); }
__device__ __forceinline__ float xhalf_max(float v) { auto rr = __builtin_amdgcn_permlane32_swap(__float_as_uint(v), __float_as_uint(v), false, false); return fmaxf(__uint_as_float(rr[0]), __uint_as_float(rr[1])); }
__device__ __forceinline__ float xhalf_sum(float v) { auto rr = __builtin_amdgcn_permlane32_swap(__float_as_uint(v), __float_as_uint(v), false, false); return __uint_as_float(rr[0]) + __uint_as_float(rr[1]); }
constexpr int ATT_KS = 144, ATT_VS = 192, ATT_KROWS = 384, ATT_VOFF = ATT_KROWS * ATT_KS, ATT_OOFF = ATT_VOFF + ATT_KROWS * ATT_VS, ATT_OS = 72;
static_assert(ATT_OOFF + NWAVES * 32 * ATT_OS <= LDS_BYTES, "attention LDS map");
constexpr int ATT_NU = BATCH * NH * 96;

struct AttUnit { int p, h, dil, i0w; size_t rowb; };
__device__ __forceinline__ AttUnit att_decode(int u) {
    AttUnit a; const int bh = u / 96, rem = u - bh * 96, b = bh / NH; a.h = bh - b * NH; a.p = rem >> 5; const int sub = rem & 31, dsh = 2 * a.p; a.dil = 1 << dsh;
    const int nblk = 32 >> dsh, r = sub / nblk, blk = sub - r * nblk; a.i0w = 256 * blk; a.rowb = (size_t)b * SEQ + r; return a;
}

__device__ __forceinline__ void attn_phase(LAS unsigned char* lds, const bf16* PROJ, bf16* OP, float* LSE, int vcu, int G, int wave, int lane, int tid) {
    constexpr float LOG2E = 1.4426950408889634f, LN2 = 0.6931471805599453f;
    const int ql = lane & 31, h2 = lane >> 5;
    LAS unsigned char* KL = lds; LAS unsigned char* VL = lds + ATT_VOFF; LAS unsigned char* OL = lds + ATT_OOFF + wave * (32 * ATT_OS);
    const LAS unsigned char* krd = KL + (32 * wave + ql) * ATT_KS + 16 * h2;
    const LAS unsigned char* vrd = VL + (32 * wave + 4 * h2 + ((lane & 15) >> 2)) * ATT_VS + (((lane >> 4) & 1) * 16 + (lane & 3) * 4) * 2;
    v4u kreg[6], vreg[6]; bf16x8 qn[4];
#define ATT_LOAD(u_) do { const AttUnit a_ = att_decode(u_); const bf16* base_ = PROJ + a_.h * 64; \
        _Pragma("unroll") for (int j = 0; j < 6; ++j) { const int c_ = tid + 512 * j; int di_ = a_.i0w - 128 + (c_ >> 3); di_ = di_ < 0 ? 0 : di_; \
            const bf16* kp_ = base_ + AW + (a_.rowb + (size_t)di_ * a_.dil) * INW + (c_ & 7) * 8; kreg[j] = *(const v4u*)kp_; vreg[j] = *(const v4u*)(kp_ + AW); } \
        const bf16* qp_ = base_ + (a_.rowb + (size_t)(a_.i0w + 32 * wave + ql) * a_.dil) * INW + 8 * h2; \
        _Pragma("unroll") for (int s = 0; s < 4; ++s) qn[s] = *(const bf16x8*)(qp_ + 16 * s); } while (0)
    int u = vcu;
    if (u < ATT_NU) ATT_LOAD(u);
#pragma unroll 1
    for (; u < ATT_NU; u += G) {
        asm volatile("" ::: "memory"); __builtin_amdgcn_s_barrier(); asm volatile("" ::: "memory");
#pragma unroll
        for (int j = 0; j < 6; ++j) { const int c = tid + 512 * j; *(LAS v4u*)(KL + (c >> 3) * ATT_KS + (c & 7) * 16) = kreg[j]; *(LAS v4u*)(VL + (c >> 3) * ATT_VS + (c & 7) * 16) = vreg[j]; }
        bf16x8 qf[4];
#pragma unroll
        for (int s = 0; s < 4; ++s) qf[s] = qn[s];
        asm volatile("s_waitcnt lgkmcnt(0)" ::: "memory"); __builtin_amdgcn_s_barrier(); asm volatile("" ::: "memory");
        const AttUnit au = att_decode(u);
        if (u + G < ATT_NU) ATT_LOAD(u + G);
        const int i0 = au.i0w + 32 * wave, dil = au.dil;
        const float c2 = alibi_slope(au.h) * (float)dil * LOG2E;
        f32x16 o0, o1;
#pragma unroll
        for (int e = 0; e < 16; ++e) { o0[e] = 0.f; o1[e] = 0.f; }
        float m = -1e30f, l = 0.f;
#pragma unroll
        for (int kt = 0; kt < 5; ++kt) {
            const int k0 = i0 - 128 + 32 * kt;
            if (k0 >= 0) {
                f32x16 sa;
#pragma unroll
                for (int e = 0; e < 16; ++e) sa[e] = 0.f;
#pragma unroll
                for (int s = 0; s < 4; ++s) { const bf16x8 kc = *(const LAS bf16x8*)(krd + (32 * kt) * ATT_KS + 32 * s); sa = __builtin_amdgcn_mfma_f32_32x32x16_bf16(kc, qf[s], sa, 0, 0, 0); }
                const float lb = -c2 * (float)(128 - 32 * kt + ql - 4 * h2);
                float sc[16]; float mx = -INFINITY;
#pragma unroll
                for (int e = 0; e < 16; ++e) { const int kr = (e & 3) + 8 * (e >> 2);
                    float s = fmaf(sa[e], LOG2E, lb); s = fmaf(c2, (float)kr, s);
                    if (kt == 0) s = (kr + 4 * h2 >= ql) ? s : -INFINITY;
                    if (kt == 4) s = (kr + 4 * h2 <= ql) ? s : -INFINITY;
                    sc[e] = s; mx = fmaxf(mx, s); }
                mx = xhalf_max(mx);
                const float mn = fmaxf(m, mx), alpha = __builtin_amdgcn_exp2f(m - mn); m = mn;
                float ls = 0.f;
#pragma unroll
                for (int e = 0; e < 16; ++e) { sc[e] = __builtin_amdgcn_exp2f(sc[e] - mn); ls += sc[e]; }
                l = l * alpha + ls;
#pragma unroll
                for (int e = 0; e < 16; ++e) { o0[e] *= alpha; o1[e] *= alpha; }
#pragma unroll
                for (int s2 = 0; s2 < 2; ++s2) {
                    v4u pw; pw.x = cvtpk_s(sc[8 * s2], sc[8 * s2 + 1]); pw.y = cvtpk_s(sc[8 * s2 + 2], sc[8 * s2 + 3]); pw.z = cvtpk_s(sc[8 * s2 + 4], sc[8 * s2 + 5]); pw.w = cvtpk_s(sc[8 * s2 + 6], sc[8 * s2 + 7]);
                    const bf16x8 pb = __builtin_bit_cast(bf16x8, pw);
                    const LAS unsigned char* vb = vrd + (32 * kt + 16 * s2) * ATT_VS;
                    { const v4i16_t a = vtr(vb), c = vtr(vb + 8 * ATT_VS);
                      const bf16x8 vf = {a[0], a[1], a[2], a[3], c[0], c[1], c[2], c[3]};
                      o0 = __builtin_amdgcn_mfma_f32_32x32x16_bf16(vf, pb, o0, 0, 0, 0); }
                    { const v4i16_t a = vtr(vb + 64), c = vtr(vb + 8 * ATT_VS + 64);
                      const bf16x8 vf = {a[0], a[1], a[2], a[3], c[0], c[1], c[2], c[3]};
                      o1 = __builtin_amdgcn_mfma_f32_32x32x16_bf16(vf, pb, o1, 0, 0, 0); }
                }
            }
        }
        const float lt = xhalf_sum(l), il = 1.0f / lt;
        if (h2 == 0) LSE[((size_t)au.p * M + au.rowb + (size_t)(i0 + ql) * dil) * NH + au.h] = (m + __log2f(lt)) * LN2;
        bf16* og = OP + ((size_t)au.p * M + au.rowb + (size_t)(i0 + (lane >> 1)) * dil) * AW + au.h * 64 + 16 * (lane & 1);
        LAS unsigned char* ow = OL + ql * ATT_OS + 8 * h2;
        const LAS unsigned char* orr = OL + (lane >> 1) * ATT_OS + 32 * (lane & 1);
#pragma unroll
        for (int dt = 0; dt < 2; ++dt) {
#pragma unroll
            for (int g4 = 0; g4 < 4; ++g4) { v2u w;
                if (dt == 0) { w.x = cvtpk_s(o0[4 * g4] * il, o0[4 * g4 + 1] * il); w.y = cvtpk_s(o0[4 * g4 + 2] * il, o0[4 * g4 + 3] * il); }
                else { w.x = cvtpk_s(o1[4 * g4] * il, o1[4 * g4 + 1] * il); w.y = cvtpk_s(o1[4 * g4 + 2] * il, o1[4 * g4 + 3] * il); }
                *(LAS v2u*)(ow + 16 * g4) = w; }
            const v2u r0 = *(const LAS v2u*)(orr), r1 = *(const LAS v2u*)(orr + 8), r2 = *(const LAS v2u*)(orr + 16), r3 = *(const LAS v2u*)(orr + 24);
            v4u s0; s0.x = r0.x; s0.y = r0.y; s0.z = r1.x; s0.w = r1.y; v4u s1; s1.x = r2.x; s1.y = r2.y; s1.z = r3.x; s1.w = r3.y;
            *(v4u*)(og + 32 * dt) = s0; *(v4u*)(og + 32 * dt + 8) = s1;
        }
    }
#undef ATT_LOAD
    asm volatile("" ::: "memory"); __builtin_amdgcn_s_barrier(); asm volatile("" ::: "memory");
}
#endif
struct Args { const float* in[14]; float* out; unsigned char* ws; int ph_lo, ph_hi; };
__global__ void __launch_bounds__(NWAVES * 64, 2) hymba_fwd(Args args) {
    extern __shared__ __attribute__((aligned(16))) unsigned char lds_raw[];
    LAS unsigned char* lds = (LAS unsigned char*)lds_raw;
    cg::grid_group grid = cg::this_grid();
    const int tid = threadIdx.x, lane = tid & 63, wave = __builtin_amdgcn_readfirstlane(tid >> 6);
    const int G = gridDim.x, bx = blockIdx.x;
    const int vcu = (G % 8 == 0) ? (bx % 8) * (G / 8) + bx / 8 : bx;
    const int gw = vcu * NWAVES + wave, NGW = G * NWAVES;
    unsigned char* ws = args.ws;
    const float* x = args.in[0]; const float* norm1_g = args.in[1]; const float* w_in = args.in[2]; const float* sgu_ln_g = args.in[3]; const float* sgu_ln_b = args.in[4];
    const float* sgu_w = args.in[5]; const float* sgu_b = args.in[6]; const float* attn_out_g = args.in[7]; const float* gmlp_out_g = args.in[8]; const float* w_out = args.in[9];
    const float* norm2_g = args.in[10]; const float* w_ff1 = args.in[11]; const float* w_ff2 = args.in[12]; const float* final_g = args.in[13];
    float* out = args.out;
    bf16* WIN = (bf16*)(ws + WS_WIN); bf16* WOUT = (bf16*)(ws + WS_WOUT); bf16* W1 = (bf16*)(ws + WS_W1); bf16* W2 = (bf16*)(ws + WS_W2);
    float* SS1 = (float*)(ws + WS_SS1); float* SS2 = (float*)(ws + WS_SS2); float* LSE = (float*)(ws + WS_LSE);
    bf16* GM = (bf16*)(ws + WS_GM); bf16* XN = (bf16*)(ws + WS_XN); bf16* PROJ = (bf16*)(ws + WS_PROJ); bf16* OP = (bf16*)(ws + WS_OP);
    bf16* H1B = (bf16*)(ws + WS_H1B); bf16* HID = (bf16*)(ws + WS_HID);
    const int lo = args.ph_lo, hi = args.ph_hi;
#define IN(k) (lo <= (k) && (k) < hi)
#define SEAM(k) do { if (IN(k) && IN((k) + 1)) grid.sync(); } while (0)
#define REPS(k) for (int rep_ = 0; rep_ < ((MK_DBL == (k)) ? 2 : 1); ++rep_)
#define REPSYNC() do { if (rep_) grid.sync(); } while (0)

    if (IN(0)) REPS(0) { REPSYNC();
        LAS float* scr = (LAS float*)(lds + wave * 16384);
        constexpr int I_IN = (D / 64) * (INW / 32), I_O = (D / 64) * (D / 32), I_1 = (D / 64) * (FF / 32), I_2 = (FF / 64) * (D / 32);
        constexpr int NITEMS = I_IN + I_O + I_1 + I_2;
#pragma unroll 1
        for (int it = gw; it < NITEMS; it += NGW) {
            int r = it;
            if (r < I_IN) { p0_transpose_item(w_in, D, INW, WIN, norm1_g, AW, scr, r, lane); continue; } r -= I_IN;
            if (r < I_O) { p0_transpose_item(w_out, D, D, WOUT, (r / (D / 32)) < (AW / 64) ? attn_out_g : gmlp_out_g - AW, 0, scr, r, lane); continue; } r -= I_O;
            if (r < I_1) { p0_transpose_item(w_ff1, D, FF, W1, norm2_g, 0, scr, r, lane); continue; } r -= I_1;
            p0_transpose_item(w_ff2, FF, D, W2, nullptr, 0, scr, r, lane);
        }
#pragma unroll 1
        for (int m = gw; m < M; m += NGW) rms_row_to_bf16(x + (size_t)m * D, XN + (size_t)m * D, lane);
    }
    SEAM(0);
    if (IN(1)) REPS(1) { REPSYNC();
        pg8::Gemm g{XN, WIN, M, INW, D}; pg8::StaticOrder S; S.init(M, INW, G, bx);
        pg8::EpiBf16 E{PROJ, INW};
        pg8::gemm_phase<pg8::EpiBf16, pg8::StaticOrder, true, true>(lds, g, S, E);
    }
    SEAM(1);
    if (IN(2)) REPS(2) { REPSYNC();
        for (int rg_ = 0; rg_ < (MK_DBL == 20 ? 2 : 1); ++rg_)
#pragma unroll 1
        for (int u = vcu; u < BATCH * (SEQ / CHUNK) * NG; u += G) gmlp_unit(lds, PROJ, sgu_ln_g, sgu_ln_b, sgu_w, sgu_b, GM, u, tid);
#if MK_NAIVE_ATTN
        attn_naive(PROJ, OP, LSE, bx * (NWAVES * 64) + tid, G * NWAVES * 64);
#else
        for (int ra_ = 0; ra_ < (MK_DBL == 21 ? 2 : 1); ++ra_) attn_phase(lds, PROJ, OP, LSE, vcu, G, wave, lane, tid);
#endif
    }
    SEAM(2);
    if (IN(3)) REPS(3) { REPSYNC();
#pragma unroll 1
        for (int m = gw; m < M; m += NGW) mixnorm_row(OP, LSE, GM, XN, m, lane);
    }
    SEAM(3);
    if (IN(4)) REPS(4) { REPSYNC();
        pg8::Gemm g{XN, WOUT, M, D, D}; pg8::StaticOrder S; S.init(M, D, G, bx);
        pg8::EpiResA E{x, H1B, SS1, D};
        pg8::gemm_phase<pg8::EpiResA, pg8::StaticOrder, true, true>(lds, g, S, E);
    }
    SEAM(4);
    if (IN(5)) REPS(5) { REPSYNC();
        pg8::Gemm g{H1B, W1, M, FF, D}; pg8::StaticOrder S; S.init(M, FF, G, bx);
        pg8::EpiSqRelu E{HID, FF, SS1};
        pg8::gemm_phase<pg8::EpiSqRelu, pg8::StaticOrder, true, true>(lds, g, S, E);
    }
    SEAM(5);
    if (IN(6)) REPS(6) { REPSYNC();
        pg8::Gemm g{HID, W2, M, D, FF}; pg8::StaticOrder S; S.init(M, D, G, bx);
        pg8::EpiResB E{H1B, out, SS2, D};
        pg8::gemm_phase<pg8::EpiResB, pg8::StaticOrder, true, true>(lds, g, S, E);
    }
    SEAM(6);
    if (IN(7)) REPS(7) { REPSYNC();
#pragma unroll 1
        for (int m = gw; m < M; m += NGW) {
            f32x4* orow = (f32x4*)(out + (size_t)m * D) + lane;
            float s = SS2[(size_t)m * 16 + (lane & 15)];
            s += __shfl_xor(s, 1); s += __shfl_xor(s, 2); s += __shfl_xor(s, 4); s += __shfl_xor(s, 8);
            const float rstd = 1.0f / sqrtf(s * (1.0f / D) + EPS);
#pragma unroll
            for (int j = 0; j < 4; ++j) { const f32x4 v = orow[64 * j]; const f32x4 gq = *((const f32x4*)final_g + lane + 64 * j); orow[64 * j] = v * rstd * gq; }
        }
    }
#undef IN
#undef SEAM
}

extern "C" void kernel_launch(void* const* d_in, const int* in_sizes, int n_in, void* d_out, int out_size, void* d_ws, size_t ws_size, hipStream_t stream) {
    static int grid = 0;
    if (grid == 0) {
        if (n_in != 14 || in_sizes[0] != M * D || out_size != M * D || ws_size < WS_END) { fprintf(stderr, "kernel_launch: unexpected shapes (n_in %d, in0 %d, out %d, ws %zu); nothing launched\n", n_in, n_in > 0 ? in_sizes[0] : -1, out_size, ws_size); grid = -1; return; }
        int dev = 0, cus = 0, per_cu = 0;
        if (hipGetDevice(&dev) != hipSuccess || hipDeviceGetAttribute(&cus, hipDeviceAttributeMultiprocessorCount, dev) != hipSuccess) { grid = -1; return; }
        if (hipFuncSetAttribute((const void*)hymba_fwd, hipFuncAttributeMaxDynamicSharedMemorySize, LDS_BYTES) != hipSuccess) { fprintf(stderr, "kernel_launch: hipFuncSetAttribute failed\n"); grid = -1; return; }
        if (hipOccupancyMaxActiveBlocksPerMultiprocessor(&per_cu, (const void*)hymba_fwd, NWAVES * 64, LDS_BYTES) != hipSuccess || per_cu < 1) { fprintf(stderr, "kernel_launch: occupancy query says %d blocks per CU\n", per_cu); per_cu = 1; }
        (void)hipGetLastError();
        grid = cus;
    }
    if (grid < 0) return;
    Args a{};
    for (int i = 0; i < 14; ++i) a.in[i] = (const float*)d_in[i];
    a.out = (float*)d_out; a.ws = (unsigned char*)d_ws;
#if MK_N_LAUNCHES == 1
    a.ph_lo = 0; a.ph_hi = NPH;
    void* kargs[] = {&a};
    hipError_t e = hipLaunchCooperativeKernel((const void*)hymba_fwd, dim3(grid), dim3(NWAVES * 64), kargs, LDS_BYTES, stream);
    if (e != hipSuccess) fprintf(stderr, "kernel_launch: cooperative launch failed: %s (grid %d)\n", hipGetErrorString(e), grid);
#else
    for (int ph = 0; ph < NPH; ++ph) {
        a.ph_lo = ph; a.ph_hi = ph + 1;
        hipLaunchKernelGGL(hymba_fwd, dim3(grid), dim3(NWAVES * 64), LDS_BYTES, stream, a);
    }
#endif
}
```

```cpp
#include <hip/hip_runtime.h>
#include <hip/hip_cooperative_groups.h>
#include <cstdio>
#include <cstdint>
namespace cg = cooperative_groups;
#define MK_NAIVE_ATTN 0
#define MK_N_LAUNCHES 1
#define MK_DBL -1
namespace pg8 {
#define PG8_LAS __attribute__((address_space(3)))
typedef unsigned short bf16_t;
typedef short bf16x8 __attribute__((ext_vector_type(8)));
typedef float f32x4 __attribute__((ext_vector_type(4)));
typedef unsigned u32x4 __attribute__((ext_vector_type(4)));
constexpr int BM = 256, BK = 64, HALF = 128, HTB = HALF * BK * 2  , STAGE_BYTES = 8 * HTB, NXCD = 8, WGM = 8;

__host__ __device__ __forceinline__ int lds_byte(int r, int c) { const int st = (r >> 4) * 2 + (c >> 5), rr = r & 15, cc = c & 31, ob = rr * 64 + cc * 2; return st * 1024 + (ob ^ (((ob >> 9) & 1) << 5)); }
__host__ __device__ __forceinline__ void stage_rc(int b, int& R, int& C) { const int st = b / 1024, sb = b % 1024, swz = sb ^ (((sb >> 9) & 1) << 5); R = (st >> 1) * 16 + swz / 64; C = (st & 1) * 32 + (swz % 64) / 2; }
__host__ __device__ __forceinline__ int perm32(int rho) { const int n = rho >> 4, i = rho & 15; return 8 * (i >> 2) + 4 * n + (i & 3); }

struct Unit { int pm, pn; };
struct Gemm { const bf16_t* A; const bf16_t* Bt; int M, N, K; };

struct StaticOrder {
    int nM, nN, nwg, G, c;
    __host__ __device__ void init(int M, int N, int G_, int c_) { nM = M / BM; nN = N / BM; nwg = nM * nN; G = G_; c = c_; }
    __host__ __device__ bool next(int i, Unit& u) const {
        const long L = (long)i * G + c; if (L >= nwg) return false;
        int wgid = (int)L; { const int q = nwg / NXCD, r = nwg % NXCD, xcd = wgid % NXCD, off = wgid / NXCD; wgid = (xcd < r ? xcd * (q + 1) : r * (q + 1) + (xcd - r) * q) + off; }
        const int nig = WGM * nN, gid = wgid / nig, fm = gid * WGM, gsz = (nM - fm) < WGM ? (nM - fm) : WGM;
        u.pm = fm + ((wgid % nig) % gsz); u.pn = (wgid % nig) / gsz; return true;
    }
    __device__ __forceinline__ void a_ready(const Unit&) const {}
    __device__ __forceinline__ void done(const Unit&) const {}
};

__device__ __forceinline__ unsigned cvt_pk_bf16(float lo, float hi) { unsigned r; asm volatile("v_cvt_pk_bf16_f32 %0, %1, %2" : "=v"(r) : "v"(lo), "v"(hi)); return r; }
typedef unsigned u32x2 __attribute__((ext_vector_type(2)));
struct EpiBf16 {
    static constexpr bool PERM = true, AFTER_DRAIN = false;
    bf16_t* O; int ldc;
    __device__ __forceinline__ void operator()(const f32x4 (&acc)[2][2][4][2], const Unit& u, int wr, int wc, int fr, int fq) const {
        const int row0 = u.pm * BM + wr * 64 + fr; const int col0 = u.pn * BM + wc * 32 + 8 * fq;
#pragma unroll
        for (int ai = 0; ai < 2; ++ai)
#pragma unroll
            for (int m = 0; m < 4; ++m) { bf16_t* rowp = O + (size_t)(row0 + ai * HALF + m * 16) * ldc + col0;
#pragma unroll
                for (int bj = 0; bj < 2; ++bj) { const f32x4 v0 = acc[ai][bj][m][0], v1 = acc[ai][bj][m][1];
                    u32x4 w; w.x = cvt_pk_bf16(v0[0], v0[1]); w.y = cvt_pk_bf16(v0[2], v0[3]); w.z = cvt_pk_bf16(v1[0], v1[1]); w.w = cvt_pk_bf16(v1[2], v1[3]);
                    *(u32x4*)(rowp + bj * HALF) = w; } }
    }
};
struct EpiSqRelu {
    static constexpr bool PERM = true, AFTER_DRAIN = false;
    bf16_t* O; int ldc; const float* ss;
    __device__ __forceinline__ void operator()(const f32x4 (&acc)[2][2][4][2], const Unit& u, int wr, int wc, int fr, int fq) const {
        const int row0 = u.pm * BM + wr * 64 + fr; const int col0 = u.pn * BM + wc * 32 + 8 * fq;
#pragma unroll
        for (int ai = 0; ai < 2; ++ai)
#pragma unroll
            for (int m = 0; m < 4; ++m) { const int r = row0 + ai * HALF + m * 16; bf16_t* rowp = O + (size_t)r * ldc + col0;
                const f32x4* sp = (const f32x4*)(ss + (size_t)r * 16); const f32x4 s0 = sp[0], s1 = sp[1], s2 = sp[2], s3 = sp[3];
                const float tot = ((s0[0] + s0[1]) + (s0[2] + s0[3])) + ((s1[0] + s1[1]) + (s1[2] + s1[3])) + ((s2[0] + s2[1]) + (s2[2] + s2[3])) + ((s3[0] + s3[1]) + (s3[2] + s3[3]));
                const float rstd = 1.0f / sqrtf(tot * (1.0f / 1024.0f) + 1e-6f);
#pragma unroll
                for (int bj = 0; bj < 2; ++bj) { f32x4 v0 = acc[ai][bj][m][0] * rstd, v1 = acc[ai][bj][m][1] * rstd;
#pragma unroll
                    for (int e = 0; e < 4; ++e) { const float a = fmaxf(v0[e], 0.f), b = fmaxf(v1[e], 0.f); v0[e] = a * a; v1[e] = b * b; }
                    u32x4 w; w.x = cvt_pk_bf16(v0[0], v0[1]); w.y = cvt_pk_bf16(v0[2], v0[3]); w.z = cvt_pk_bf16(v1[0], v1[1]); w.w = cvt_pk_bf16(v1[2], v1[3]);
                    *(u32x4*)(rowp + bj * HALF) = w; } }
    }
};
struct EpiResA {
    static constexpr bool PERM = true, AFTER_DRAIN = false;
    const float* base; bf16_t* ob; float* ss; int ldc;
    __device__ __forceinline__ void operator()(const f32x4 (&acc)[2][2][4][2], const Unit& u, int wr, int wc, int fr, int fq) const {
        const int row0 = u.pm * BM + wr * 64 + fr; const int col0 = u.pn * BM + wc * 32 + 8 * fq;
#pragma unroll
        for (int ai = 0; ai < 2; ++ai)
#pragma unroll
            for (int m = 0; m < 4; ++m) { const int r = row0 + ai * HALF + m * 16; const size_t off = (size_t)r * ldc + col0; float s = 0.f;
#pragma unroll
                for (int bj = 0; bj < 2; ++bj) { const f32x4 v0 = *(const f32x4*)(base + off + bj * HALF) + acc[ai][bj][m][0], v1 = *(const f32x4*)(base + off + bj * HALF + 4) + acc[ai][bj][m][1];
                    s += ((v0[0] * v0[0] + v0[1] * v0[1]) + (v0[2] * v0[2] + v0[3] * v0[3])) + ((v1[0] * v1[0] + v1[1] * v1[1]) + (v1[2] * v1[2] + v1[3] * v1[3]));
                    u32x4 w; w.x = cvt_pk_bf16(v0[0], v0[1]); w.y = cvt_pk_bf16(v0[2], v0[3]); w.z = cvt_pk_bf16(v1[0], v1[1]); w.w = cvt_pk_bf16(v1[2], v1[3]);
                    *(u32x4*)(ob + off + bj * HALF) = w; }
                s += __shfl_xor(s, 16); s += __shfl_xor(s, 32);
                if (fq == 0) ss[(size_t)r * 16 + u.pn * 4 + wc] = s; }
    }
};
struct EpiResB {
    static constexpr bool PERM = true, AFTER_DRAIN = false;
    const bf16_t* hb; float* out; float* ss; int ldc;
    __device__ __forceinline__ void operator()(const f32x4 (&acc)[2][2][4][2], const Unit& u, int wr, int wc, int fr, int fq) const {
        const int row0 = u.pm * BM + wr * 64 + fr; const int col0 = u.pn * BM + wc * 32 + 8 * fq;
#pragma unroll
        for (int ai = 0; ai < 2; ++ai)
#pragma unroll
            for (int m = 0; m < 4; ++m) { const int r = row0 + ai * HALF + m * 16; const size_t off = (size_t)r * ldc + col0; float s = 0.f;
#pragma unroll
                for (int bj = 0; bj < 2; ++bj) { const u32x4 rb = *(const u32x4*)(hb + off + bj * HALF);
                    f32x4 v0, v1; v0[0] = __uint_as_float(rb.x << 16); v0[1] = __uint_as_float(rb.x & 0xffff0000u); v0[2] = __uint_as_float(rb.y << 16); v0[3] = __uint_as_float(rb.y & 0xffff0000u);
                    v1[0] = __uint_as_float(rb.z << 16); v1[1] = __uint_as_float(rb.z & 0xffff0000u); v1[2] = __uint_as_float(rb.w << 16); v1[3] = __uint_as_float(rb.w & 0xffff0000u);
                    v0 += acc[ai][bj][m][0]; v1 += acc[ai][bj][m][1];
                    s += ((v0[0] * v0[0] + v0[1] * v0[1]) + (v0[2] * v0[2] + v0[3] * v0[3])) + ((v1[0] * v1[0] + v1[1] * v1[1]) + (v1[2] * v1[2] + v1[3] * v1[3]));
                    *(f32x4*)(out + off + bj * HALF) = v0; *(f32x4*)(out + off + bj * HALF + 4) = v1; }
                s += __shfl_xor(s, 16); s += __shfl_xor(s, 32);
                if (fq == 0) ss[(size_t)r * 16 + u.pn * 4 + wc] = s; }
    }
};
template <class Epi, class Sched, bool ALIGN_EPI = false, bool SP2 = false>
__device__ __forceinline__ void gemm_phase(PG8_LAS unsigned char* lds, const Gemm g, const Sched& S, const Epi& E) {
    const int tid = threadIdx.x, wid = __builtin_amdgcn_readfirstlane(tid >> 6), lane = tid & 63, wr = wid >> 2, wc = wid & 3, fr = lane & 15, fq = lane >> 4;
    const int K = g.K, nt = K / BK;
    unsigned voffA[2], voffB[2];
#pragma unroll
    for (int i = 0; i < 2; ++i) { int R, C; stage_rc(tid * 16 + i * 8192, R, C); const int Rb = Epi::PERM ? ((R & ~31) + perm32(R & 31)) : R;
        voffA[i] = (unsigned)(R * K + C) * 2u; voffB[i] = (unsigned)(Rb * K + C) * 2u; }
    const size_t kstep = (size_t)(BK * 2);
    const size_t hstep = (size_t)HALF * K * 2;
    const size_t tstep = 2 * hstep;
    const unsigned ldsw = (unsigned)wid * 1024u;
    const int aoff = lds_byte(wr * 64 + fr, fq * 8), boff = lds_byte(wc * 32 + fr, fq * 8);
#define PG8_SA(b, h) (((b) * 2 + (h)) * HTB)
#define PG8_SB(b, h) ((4 + (b) * 2 + (h)) * HTB)
#define PG8_STAGE(bufoff, gbase, voff) do { _Pragma("unroll") for (int _i = 0; _i < 2; ++_i) \
        __builtin_amdgcn_global_load_lds((const unsigned*)((const char*)(gbase) + (voff)[_i]), (PG8_LAS unsigned*)(lds + (bufoff) + ldsw + _i * 8192), 16, 0, 0); } while (0)
#define PG8_LDA(dst, b, h) do { _Pragma("unroll") for (int m = 0; m < 4; ++m) _Pragma("unroll") for (int k = 0; k < 2; ++k) dst[m][k] = *(const PG8_LAS bf16x8*)(lds + PG8_SA(b, h) + aoff + m * 2048 + k * 1024); } while (0)
#define PG8_LDB(dst, b, h) do { _Pragma("unroll") for (int n = 0; n < 2; ++n) _Pragma("unroll") for (int k = 0; k < 2; ++k) dst[n][k] = *(const PG8_LAS bf16x8*)(lds + PG8_SB(b, h) + boff + n * 2048 + k * 1024); } while (0)
#define PG8_MMA(ai, bj, At, Bt) do { __builtin_amdgcn_s_setprio(1); _Pragma("unroll") for (int m = 0; m < 4; ++m) _Pragma("unroll") for (int n = 0; n < 2; ++n) _Pragma("unroll") for (int k = 0; k < 2; ++k) \
        acc[ai][bj][m][n] = __builtin_amdgcn_mfma_f32_16x16x32_bf16(Bt[n][k], At[m][k], acc[ai][bj][m][n], 0, 0, 0); __builtin_amdgcn_s_setprio(0); } while (0)
#define PG8_WAIT_V(n) asm volatile("s_waitcnt vmcnt(" #n ")" ::: "memory")
#define PG8_WAIT_L(n) asm volatile("s_waitcnt lgkmcnt(" #n ")" ::: "memory")
#define PG8_BAR __builtin_amdgcn_s_barrier()
#define PG8_SCHED __builtin_amdgcn_sched_barrier(0)
    Unit cur, nxt; int ui = 0;
    if (!S.next(0, cur)) return;
    f32x4 acc[2][2][4][2];
#pragma unroll
    for (int a = 0; a < 2; ++a)
#pragma unroll
        for (int b = 0; b < 2; ++b)
#pragma unroll
            for (int m = 0; m < 4; ++m)
#pragma unroll
                for (int n = 0; n < 2; ++n) acc[a][b][m][n] = (f32x4){0.f, 0.f, 0.f, 0.f};
    bf16x8 At[4][2], B0[2][2], B1[2][2];
    const char* cA = (const char*)g.A + (size_t)cur.pm * tstep; const char* cB = (const char*)g.Bt + (size_t)cur.pn * tstep;
    S.a_ready(cur);
    if constexpr (SP2) {
        PG8_STAGE(PG8_SB(0, 0), cB, voffB); PG8_STAGE(PG8_SB(0, 1), cB + hstep, voffB); PG8_STAGE(PG8_SA(0, 0), cA, voffA); PG8_STAGE(PG8_SA(0, 1), cA + hstep, voffA);
        if (wr == 1) PG8_BAR;
        PG8_WAIT_V(2); PG8_BAR;
        PG8_STAGE(PG8_SB(1, 0), cB + kstep, voffB); PG8_STAGE(PG8_SA(1, 0), cA + kstep, voffA); PG8_STAGE(PG8_SB(1, 1), cB + hstep + kstep, voffB);
        PG8_WAIT_V(6); PG8_BAR;
    } else {
        PG8_STAGE(PG8_SB(0, 0), cB, voffB); PG8_STAGE(PG8_SA(0, 0), cA, voffA); PG8_STAGE(PG8_SB(0, 1), cB + hstep, voffB); PG8_STAGE(PG8_SA(0, 1), cA + hstep, voffA);
        if (wr == 1) PG8_BAR;
        PG8_WAIT_V(4); PG8_BAR;
        PG8_STAGE(PG8_SB(1, 0), cB + kstep, voffB); PG8_STAGE(PG8_SA(1, 0), cA + kstep, voffA); PG8_STAGE(PG8_SB(1, 1), cB + hstep + kstep, voffB);
        PG8_WAIT_V(6); PG8_BAR;
    }
    for (;;) {
        const bool has_next = S.next(ui + 1, nxt);
        const char* nA = has_next ? (const char*)g.A + (size_t)nxt.pm * tstep : cA; const char* nB = has_next ? (const char*)g.Bt + (size_t)nxt.pn * tstep : cB;
        for (int t = 0; t < nt; t += 2) {
            const bool last = (t == nt - 2);
            const char* a1 = cA + (size_t)(t + 1) * kstep;
            const char* a2 = last ? nA : cA + (size_t)(t + 2) * kstep; const char* b2 = last ? nB : cB + (size_t)(t + 2) * kstep;
            const char* a3 = a2 + kstep; const char* b3 = b2 + kstep;
            if (last && has_next) S.a_ready(nxt);
            if constexpr (SP2) {
            PG8_LDB(B0, 0, 0); PG8_LDB(B1, 0, 1); PG8_SCHED; PG8_LDA(At, 0, 0); PG8_STAGE(PG8_SA(1, 1), a1 + hstep, voffA);
            PG8_WAIT_V(8); PG8_WAIT_L(0); PG8_BAR; PG8_MMA(0, 0, At, B0); PG8_MMA(0, 1, At, B1); PG8_BAR; PG8_SCHED;
            PG8_LDA(At, 0, 1); PG8_STAGE(PG8_SB(0, 0), b2, voffB); PG8_STAGE(PG8_SB(0, 1), b2 + hstep, voffB); PG8_STAGE(PG8_SA(0, 0), a2, voffA);
            PG8_WAIT_V(8); PG8_WAIT_L(0); PG8_BAR; PG8_MMA(1, 0, At, B0); PG8_MMA(1, 1, At, B1); PG8_BAR; PG8_SCHED;
            PG8_LDB(B0, 1, 0); PG8_LDB(B1, 1, 1); PG8_SCHED; PG8_LDA(At, 1, 0); PG8_STAGE(PG8_SA(0, 1), a2 + hstep, voffA);
            PG8_WAIT_V(8); PG8_WAIT_L(0); PG8_BAR; PG8_MMA(0, 0, At, B0); PG8_MMA(0, 1, At, B1); PG8_BAR; PG8_SCHED;
            PG8_LDA(At, 1, 1); PG8_STAGE(PG8_SB(1, 0), b3, voffB); PG8_STAGE(PG8_SB(1, 1), b3 + hstep, voffB); PG8_STAGE(PG8_SA(1, 0), a3, voffA);
            PG8_WAIT_V(8); PG8_WAIT_L(0); PG8_BAR; PG8_MMA(1, 0, At, B0); PG8_MMA(1, 1, At, B1); PG8_BAR; PG8_SCHED;
            } else {
            PG8_LDB(B0, 0, 0); PG8_SCHED; PG8_LDA(At, 0, 0); PG8_STAGE(PG8_SA(1, 1), a1 + hstep, voffA);
            PG8_WAIT_L(8); PG8_BAR; PG8_WAIT_L(0); PG8_MMA(0, 0, At, B0); PG8_BAR; PG8_SCHED;
            PG8_LDB(B1, 0, 1); PG8_STAGE(PG8_SB(0, 0), b2, voffB);
            PG8_BAR; PG8_WAIT_L(0); PG8_MMA(0, 1, At, B1); PG8_BAR;
            PG8_LDA(At, 0, 1); PG8_STAGE(PG8_SA(0, 0), a2, voffA);
            PG8_BAR; PG8_WAIT_L(0); PG8_MMA(1, 0, At, B0); PG8_BAR; PG8_SCHED;
            PG8_STAGE(PG8_SB(0, 1), b2 + hstep, voffB);
            PG8_WAIT_V(6); PG8_BAR; PG8_MMA(1, 1, At, B1); PG8_BAR;
            PG8_LDB(B0, 1, 0); PG8_SCHED; PG8_LDA(At, 1, 0); PG8_STAGE(PG8_SA(0, 1), a2 + hstep, voffA);
            PG8_WAIT_L(8); PG8_BAR; PG8_WAIT_L(0); PG8_MMA(0, 0, At, B0); PG8_BAR; PG8_SCHED;
            PG8_LDB(B1, 1, 1); PG8_STAGE(PG8_SB(1, 0), b3, voffB);
            PG8_BAR; PG8_WAIT_L(0); PG8_MMA(0, 1, At, B1); PG8_BAR;
            PG8_LDA(At, 1, 1); PG8_STAGE(PG8_SA(1, 0), a3, voffA);
            PG8_BAR; PG8_WAIT_L(0); PG8_MMA(1, 0, At, B0); PG8_BAR; PG8_SCHED;
            PG8_STAGE(PG8_SB(1, 1), b3 + hstep, voffB);
            PG8_WAIT_V(6); PG8_BAR; PG8_MMA(1, 1, At, B1); PG8_BAR;
            }
        }
        if constexpr (ALIGN_EPI) { if (wr == 0) PG8_BAR; }
        if constexpr (!Epi::AFTER_DRAIN) { E(acc, cur, wr, wc, fr, fq); S.done(cur); }
        if (!has_next) break;
#pragma unroll
        for (int a = 0; a < 2; ++a)
#pragma unroll
            for (int b = 0; b < 2; ++b)
#pragma unroll
                for (int m = 0; m < 4; ++m)
#pragma unroll
                    for (int n = 0; n < 2; ++n) acc[a][b][m][n] = (f32x4){0.f, 0.f, 0.f, 0.f};
        cur = nxt; cA = nA; cB = nB; ++ui;
        if constexpr (ALIGN_EPI) { if (wr == 1) PG8_BAR; }
    }
    PG8_WAIT_V(0);
    if constexpr (!ALIGN_EPI) { if (wr == 0) PG8_BAR; }
    PG8_BAR;
    if constexpr (Epi::AFTER_DRAIN) { E.fused(acc, cur, wr, wc, fr, fq, lds, wid, lane); S.done(cur); }
#undef PG8_SA
#undef PG8_SB
#undef PG8_STAGE
#undef PG8_LDA
#undef PG8_LDB
#undef PG8_MMA
#undef PG8_WAIT_V
#undef PG8_WAIT_L
#undef PG8_BAR
#undef PG8_SCHED
}
}
#define GAS __attribute__((address_space(1)))
#define LAS __attribute__((address_space(3)))
typedef unsigned short bf16;
typedef unsigned v4u __attribute__((ext_vector_type(4)));
typedef unsigned v2u __attribute__((ext_vector_type(2)));
typedef float f32x4 __attribute__((ext_vector_type(4)));
typedef float f32x16 __attribute__((ext_vector_type(16)));
typedef short bf16x8 __attribute__((ext_vector_type(8)));
#define LDS_WAIT() asm volatile("s_waitcnt lgkmcnt(0)" ::: "memory")

#ifndef MK_N_LAUNCHES
#define MK_N_LAUNCHES 1
#endif
#ifndef MK_NAIVE_ATTN
#define MK_NAIVE_ATTN 0
#endif
constexpr int NWAVES = 8, NPH = 8;
constexpr int BATCH = 4, SEQ = 8192, D = 1024, NH = 12, HD = 64, AW = 768, GWD = 256, NG = 4, INW = 2816, FF = 4096, M = BATCH * SEQ, CHUNK = 128;
constexpr float EPS = 1e-6f;
constexpr size_t MiB = 1u << 20;
constexpr size_t WS_WIN = 2 * MiB, WS_WOUT = 8 * MiB, WS_W1 = 10 * MiB, WS_W2 = 18 * MiB, WS_SS1 = 26 * MiB, WS_SS2 = 28 * MiB, WS_LSE = 30 * MiB, WS_GM = 36 * MiB,
                 WS_XN = 64 * MiB, WS_PROJ = 128 * MiB, WS_OP = 304 * MiB, WS_H1B = 128 * MiB, WS_HID = 192 * MiB, WS_END = 448 * MiB;
static_assert(WS_WIN + (size_t)INW * D * 2 <= WS_WOUT && WS_LSE + (size_t)3 * M * NH * 4 <= WS_GM && WS_GM + (size_t)M * GWD * 2 <= WS_XN && WS_PROJ + (size_t)M * INW * 2 <= WS_OP && WS_OP + (size_t)3 * M * AW * 2 <= WS_END && WS_HID + (size_t)M * FF * 2 <= WS_END, "ws map");
constexpr int LDS_BYTES = 147456;

__device__ __forceinline__ float bflo(unsigned u) { return __uint_as_float(u << 16); }
__device__ __forceinline__ float bfhi(unsigned u) { return __uint_as_float(u & 0xffff0000u); }
__device__ __forceinline__ unsigned pk2(float lo, float hi) { return pg8::cvt_pk_bf16(lo, hi); }
__device__ __forceinline__ float wave_sum(float v) {
#pragma unroll
    for (int o = 1; o < 64; o <<= 1) v += __shfl_xor(v, o);
    return v;
}
__device__ __forceinline__ float gelu_t(float x) { const float y = 0.7978845608028654f * (x + 0.044715f * x * x * x); return x / (1.0f + __expf(-2.0f * y)); }

__device__ __forceinline__ void p0_transpose_item(const float* W, int K, int N, bf16* WT, const float* gk, int qcols, float qscale, LAS float* scr, int item, int lane) {
    const int nblk = N / 32, kb = item / nblk, nb = item % nblk, k0 = 64 * kb, n0 = 32 * nb;
#pragma unroll 8
    for (int i = 0; i < 32; ++i) { const int kk = 2 * i + (lane >> 5); const float g = gk ? gk[k0 + kk] : 1.0f; scr[kk * 33 + (lane & 31)] = W[(size_t)(k0 + kk) * N + n0 + (lane & 31)] * g; }
    LDS_WAIT();
    const int c = lane & 7;
#pragma unroll
    for (int j = 0; j < 4; ++j) { const int n = (lane >> 3) + 8 * j; const LAS float* s = scr + (8 * c) * 33 + n; const float sc = (n0 + n < qcols) ? qscale : 1.0f;
        v4u o; o.x = pk2(s[0 * 33] * sc, s[1 * 33] * sc); o.y = pk2(s[2 * 33] * sc, s[3 * 33] * sc); o.z = pk2(s[4 * 33] * sc, s[5 * 33] * sc); o.w = pk2(s[6 * 33] * sc, s[7 * 33] * sc);
        *(v4u*)(WT + (size_t)(n0 + n) * K + k0 + 8 * c) = o; }
    LDS_WAIT();
}
__device__ __forceinline__ void rms_row_to_bf16(const float* xrow, bf16* orow, int lane) {
    const f32x4* xr = (const f32x4*)xrow + lane;
    f32x4 v[4]; float s = 0.f;
#pragma unroll
    for (int j = 0; j < 4; ++j) { v[j] = xr[64 * j]; s += (v[j].x * v[j].x + v[j].y * v[j].y) + (v[j].z * v[j].z + v[j].w * v[j].w); }
    const float rstd = 1.0f / sqrtf(wave_sum(s) * (1.0f / D) + EPS);
    v2u* o8 = (v2u*)orow + lane;
#pragma unroll
    for (int j = 0; j < 4; ++j) { v2u w; w.x = pk2(v[j].x * rstd, v[j].y * rstd); w.y = pk2(v[j].z * rstd, v[j].w * rstd); o8[64 * j] = w; }
}

__device__ __forceinline__ void gmlp_unit(LAS unsigned char* lds, const bf16* PROJ, const float* ln_g, const float* ln_b, const float* sgu_w, const float* sgu_b, bf16* GM, int unit, int tid) {
    const int g = unit & 3, n = (unit >> 2) & 63, b = unit >> 8;
    const size_t row0 = (size_t)b * SEQ + (size_t)n * CHUNK;
    LAS float* zn = (LAS float*)lds;
    LAS float* wl = (LAS float*)(lds + 128 * 68 * 4);
    const float* wg = sgu_w + (size_t)g * CHUNK * CHUNK;
    for (int i = tid; i < CHUNK * CHUNK; i += NWAVES * 64) wl[(i >> 7) * 129 + (i & 127)] = wg[i];
    {
        const int t = tid >> 2, q = tid & 3;
        const bf16* zp = PROJ + (row0 + t) * INW + 2560 + g * 64 + 16 * q;
        const v4u r0 = *(const v4u*)zp, r1 = *(const v4u*)(zp + 8);
        float z[16];
        z[0] = bflo(r0.x); z[1] = bfhi(r0.x); z[2] = bflo(r0.y); z[3] = bfhi(r0.y); z[4] = bflo(r0.z); z[5] = bfhi(r0.z); z[6] = bflo(r0.w); z[7] = bfhi(r0.w);
        z[8] = bflo(r1.x); z[9] = bfhi(r1.x); z[10] = bflo(r1.y); z[11] = bfhi(r1.y); z[12] = bflo(r1.z); z[13] = bfhi(r1.z); z[14] = bflo(r1.w); z[15] = bfhi(r1.w);
        float s = 0.f;
#pragma unroll
        for (int e = 0; e < 16; ++e) { z[e] = gelu_t(z[e]); s += z[e]; }
        s += __shfl_xor(s, 1); s += __shfl_xor(s, 2);
        const float mean = s * (1.0f / 64.0f); float v = 0.f;
#pragma unroll
        for (int e = 0; e < 16; ++e) { z[e] -= mean; v += z[e] * z[e]; }
        v += __shfl_xor(v, 1); v += __shfl_xor(v, 2);
        const float rstd = 1.0f / sqrtf(v * (1.0f / 64.0f) + EPS);
        const float* lg = ln_g + g * 64 + 16 * q; const float* lb = ln_b + g * 64 + 16 * q;
#pragma unroll
        for (int e4 = 0; e4 < 4; ++e4) { f32x4 o;
#pragma unroll
            for (int e = 0; e < 4; ++e) o[e] = z[4 * e4 + e] * rstd * lg[4 * e4 + e] + lb[4 * e4 + e];
            *(LAS f32x4*)(zn + t * 68 + 16 * q + 4 * e4) = o; }
    }
    __syncthreads();
    const int wv = __builtin_amdgcn_readfirstlane(tid >> 6), lane = tid & 63, tr = lane >> 3, cq = lane & 7;
#pragma unroll 1
    for (int half = 0; half < 2; ++half) {
        const int blk = half ? 15 - wv : wv, t = 8 * blk + tr, smax = 8 * blk + 7;
        float acc[8];
#pragma unroll
        for (int e = 0; e < 8; ++e) acc[e] = 0.f;
#pragma unroll 4
        for (int s = 0; s <= smax; ++s) {
            float w = wl[t * 129 + s]; w = (s <= t) ? w : 0.f;
            const f32x4 z0 = *(const LAS f32x4*)(zn + s * 68 + 8 * cq), z1 = *(const LAS f32x4*)(zn + s * 68 + 8 * cq + 4);
#pragma unroll
            for (int e = 0; e < 4; ++e) { acc[e] += w * z0[e]; acc[4 + e] += w * z1[e]; }
        }
        const v4u ur = *(const v4u*)(PROJ + (row0 + t) * INW + 2304 + g * 64 + 8 * cq);
        const float bs = sgu_b[g * CHUNK + t];
        float u[8]; u[0] = bflo(ur.x); u[1] = bfhi(ur.x); u[2] = bflo(ur.y); u[3] = bfhi(ur.y); u[4] = bflo(ur.z); u[5] = bfhi(ur.z); u[6] = bflo(ur.w); u[7] = bfhi(ur.w);
#pragma unroll
        for (int e = 0; e < 8; ++e) u[e] = gelu_t(u[e]) * (acc[e] + bs);
        v4u o; o.x = pk2(u[0], u[1]); o.y = pk2(u[2], u[3]); o.z = pk2(u[4], u[5]); o.w = pk2(u[6], u[7]);
        *(v4u*)(GM + (row0 + t) * GWD + g * 64 + 8 * cq) = o;
    }
    __syncthreads();
}

__device__ __forceinline__ float alibi_slope(int h) { return (h < 8) ? exp2f(-(float)(h + 1)) : exp2f(-0.5f - (float)(h - 8)); }

#if MK_NAIVE_ATTN
__device__ __forceinline__ void attn_naive(const bf16* PROJ, bf16* OP, float* LSE, int gtid, int nthreads) {
#pragma unroll 1
    for (int it = gtid; it < M * NH * 3; it += nthreads) {
        const int h = it % NH, row = (it / NH) % M, p = it / (NH * M), dil = 1 << (2 * p), t = row % SEQ;
        const float slope = alibi_slope(h);
        const bf16* qp = PROJ + (size_t)row * INW + h * 64;
        float q[64], o[64];
#pragma unroll
        for (int c = 0; c < 8; ++c) { const v4u r = *(const v4u*)(qp + 8 * c); q[8*c] = bflo(r.x); q[8*c+1] = bfhi(r.x); q[8*c+2] = bflo(r.y); q[8*c+3] = bfhi(r.y); q[8*c+4] = bflo(r.z); q[8*c+5] = bfhi(r.z); q[8*c+6] = bflo(r.w); q[8*c+7] = bfhi(r.w); }
#pragma unroll
        for (int e = 0; e < 64; ++e) o[e] = 0.f;
        float m = -1e30f, l = 0.f;
#pragma unroll 1
        for (int j = 0; j <= 128; ++j) {
            const int tk = t - dil * j; if (tk < 0) break;
            const bf16* kp = qp + 768 - (size_t)(dil * j) * INW; const bf16* vp = kp + 768;
            float dot = 0.f;
#pragma unroll
            for (int c = 0; c < 8; ++c) { const v4u r = *(const v4u*)(kp + 8 * c);
                dot += q[8*c] * bflo(r.x) + q[8*c+1] * bfhi(r.x) + q[8*c+2] * bflo(r.y) + q[8*c+3] * bfhi(r.y) + q[8*c+4] * bflo(r.z) + q[8*c+5] * bfhi(r.z) + q[8*c+6] * bflo(r.w) + q[8*c+7] * bfhi(r.w); }
            const float s = dot - slope * (float)(dil * j);
            const float mn = fmaxf(m, s), sc = __expf(m - mn), pe = __expf(s - mn);
            l = l * sc + pe; m = mn;
#pragma unroll
            for (int c = 0; c < 8; ++c) { const v4u r = *(const v4u*)(vp + 8 * c);
                o[8*c] = o[8*c] * sc + pe * bflo(r.x); o[8*c+1] = o[8*c+1] * sc + pe * bfhi(r.x); o[8*c+2] = o[8*c+2] * sc + pe * bflo(r.y); o[8*c+3] = o[8*c+3] * sc + pe * bfhi(r.y);
                o[8*c+4] = o[8*c+4] * sc + pe * bflo(r.z); o[8*c+5] = o[8*c+5] * sc + pe * bfhi(r.z); o[8*c+6] = o[8*c+6] * sc + pe * bflo(r.w); o[8*c+7] = o[8*c+7] * sc + pe * bfhi(r.w); }
        }
        const float il = 1.0f / l;
        bf16* op = OP + ((size_t)p * M + row) * AW + h * 64;
#pragma unroll
        for (int c = 0; c < 8; ++c) { v4u w; w.x = pk2(o[8*c] * il, o[8*c+1] * il); w.y = pk2(o[8*c+2] * il, o[8*c+3] * il); w.z = pk2(o[8*c+4] * il, o[8*c+5] * il); w.w = pk2(o[8*c+6] * il, o[8*c+7] * il); *(v4u*)(op + 8 * c) = w; }
        LSE[((size_t)p * M + row) * NH + h] = m + __logf(l);
    }
}
#endif

__device__ __forceinline__ void mixnorm_row(const bf16* OP, const float* LSE, const bf16* GM, bf16* MIXED, int row, int lane) {
    float a[3][4]; float ssa = 0.f;
#pragma unroll
    for (int j = 0; j < 3; ++j) {
        const int c = 256 * j + 4 * lane, head = c >> 6;
        float ls[3];
#pragma unroll
        for (int p = 0; p < 3; ++p) ls[p] = LSE[((size_t)p * M + row) * NH + head];
        const float mx = fmaxf(ls[0], fmaxf(ls[1], ls[2]));
        float w[3]; float wsum = 0.f;
#pragma unroll
        for (int p = 0; p < 3; ++p) { w[p] = __expf(ls[p] - mx); wsum += w[p]; }
        const float iw = 1.0f / wsum;
#pragma unroll
        for (int e = 0; e < 4; ++e) a[j][e] = 0.f;
#pragma unroll
        for (int p = 0; p < 3; ++p) { const v2u r = *(const v2u*)(OP + ((size_t)p * M + row) * AW + c); const float wp = w[p] * iw;
            a[j][0] += wp * bflo(r.x); a[j][1] += wp * bfhi(r.x); a[j][2] += wp * bflo(r.y); a[j][3] += wp * bfhi(r.y); }
#pragma unroll
        for (int e = 0; e < 4; ++e) ssa += a[j][e] * a[j][e];
    }
    const v2u gr = *(const v2u*)(GM + (size_t)row * GWD + 4 * lane);
    float gv[4]; gv[0] = bflo(gr.x); gv[1] = bfhi(gr.x); gv[2] = bflo(gr.y); gv[3] = bfhi(gr.y);
    float ssg = (gv[0] * gv[0] + gv[1] * gv[1]) + (gv[2] * gv[2] + gv[3] * gv[3]);
    const float ra = 1.0f / sqrtf(wave_sum(ssa) * (1.0f / AW) + EPS), rg = 1.0f / sqrtf(wave_sum(ssg) * (1.0f / GWD) + EPS);
    bf16* mp = MIXED + (size_t)row * D;
#pragma unroll
    for (int j = 0; j < 3; ++j) { v2u w; w.x = pk2(a[j][0] * ra, a[j][1] * ra); w.y = pk2(a[j][2] * ra, a[j][3] * ra); *(v2u*)(mp + 256 * j + 4 * lane) = w; }
    { v2u w; w.x = pk2(gv[0] * rg, gv[1] * rg); w.y = pk2(gv[2] * rg, gv[3] * rg); *(v2u*)(mp + AW + 4 * lane) = w; }
}
#if !MK_NAIVE_ATTN
typedef short v4i16_t __attribute__((ext_vector_type(4)));
typedef float f32x2_t __attribute__((ext_vector_type(2)));
typedef __bf16 bf16x2_t __attribute__((ext_vector_type(2)));
__device__ __forceinline__ unsigned cvtpk_s(float lo, float hi) { f32x2_t v = {lo, hi}; bf16x2_t b = __builtin_convertvector(v, bf16x2_t); return __builtin_bit_cast(unsigned, b); }
__device__ __forceinline__ v4i16_t vtr(const LAS unsigned char* p) { return __builtin_amdgcn_ds_read_tr16_b64_v4i16((LAS v4i16_t*)p); }
__device__ __forceinline__ float xhalf_max(float v) { auto rr = __builtin_amdgcn_permlane32_swap(__float_as_uint(v), __float_as_uint(v), false, false); return fmaxf(__uint_as_float(rr[0]), __uint_as_float(rr[1])); }
__device__ __forceinline__ float xhalf_sum(float v) { auto rr = __builtin_amdgcn_permlane32_swap(__float_as_uint(v), __float_as_uint(v), false, false); return __uint_as_float(rr[0]) + __uint_as_float(rr[1]); }
constexpr int ATT_KS = 144, ATT_VS = 192, ATT_KROWS = 384, ATT_VOFF = ATT_KROWS * ATT_KS, ATT_OOFF = ATT_VOFF + ATT_KROWS * ATT_VS, ATT_OS = 72;
static_assert(ATT_OOFF + NWAVES * 32 * ATT_OS <= LDS_BYTES, "attention LDS map");
constexpr int ATT_NU = BATCH * NH * 96;

struct AttUnit { int p, h, dil, i0w; size_t rowb; };
__device__ __forceinline__ AttUnit att_decode(int u) {
    AttUnit a; const int bh = u / 96, rem = u - bh * 96, b = bh / NH; a.h = bh - b * NH; a.p = rem >> 5; const int sub = rem & 31, dsh = 2 * a.p; a.dil = 1 << dsh;
    const int nblk = 32 >> dsh, r = sub / nblk, blk = sub - r * nblk; a.i0w = 256 * blk; a.rowb = (size_t)b * SEQ + r; return a;
}

__device__ __forceinline__ void attn_phase(LAS unsigned char* lds, const bf16* PROJ, bf16* OP, float* LSE, int vcu, int G, int wave, int lane, int tid) {
    constexpr float LOG2E = 1.4426950408889634f, LN2 = 0.6931471805599453f;
    const int ql = lane & 31, h2 = lane >> 5;
    LAS unsigned char* KL = lds; LAS unsigned char* VL = lds + ATT_VOFF; LAS unsigned char* OL = lds + ATT_OOFF + wave * (32 * ATT_OS);
    const LAS unsigned char* krd = KL + (32 * wave + ql) * ATT_KS + 16 * h2;
    const LAS unsigned char* vrd = VL + (32 * wave + 4 * h2 + ((lane & 15) >> 2)) * ATT_VS + (((lane >> 4) & 1) * 16 + (lane & 3) * 4) * 2;
    v4u kreg[6], vreg[6]; bf16x8 qn[4];
#define ATT_LOAD(u_) do { const AttUnit a_ = att_decode(u_); const bf16* base_ = PROJ + a_.h * 64; \
        _Pragma("unroll") for (int j = 0; j < 6; ++j) { const int c_ = tid + 512 * j; int di_ = a_.i0w - 128 + (c_ >> 3); di_ = di_ < 0 ? 0 : di_; \
            const bf16* kp_ = base_ + AW + (a_.rowb + (size_t)di_ * a_.dil) * INW + (c_ & 7) * 8; kreg[j] = *(const v4u*)kp_; vreg[j] = *(const v4u*)(kp_ + AW); } \
        const bf16* qp_ = base_ + (a_.rowb + (size_t)(a_.i0w + 32 * wave + ql) * a_.dil) * INW + 8 * h2; \
        _Pragma("unroll") for (int s = 0; s < 4; ++s) qn[s] = *(const bf16x8*)(qp_ + 16 * s); } while (0)
    int u = vcu;
    if (u < ATT_NU) ATT_LOAD(u);
#pragma unroll 1
    for (; u < ATT_NU; u += G) {
        asm volatile("" ::: "memory"); __builtin_amdgcn_s_barrier(); asm volatile("" ::: "memory");
#pragma unroll
        for (int j = 0; j < 6; ++j) { const int c = tid + 512 * j; *(LAS v4u*)(KL + (c >> 3) * ATT_KS + (c & 7) * 16) = kreg[j]; *(LAS v4u*)(VL + (c >> 3) * ATT_VS + (c & 7) * 16) = vreg[j]; }
        bf16x8 qf[4];
#pragma unroll
        for (int s = 0; s < 4; ++s) qf[s] = qn[s];
        asm volatile("s_waitcnt lgkmcnt(0)" ::: "memory"); __builtin_amdgcn_s_barrier(); asm volatile("" ::: "memory");
        const AttUnit au = att_decode(u);
        if (u + G < ATT_NU) ATT_LOAD(u + G);
        const int i0 = au.i0w + 32 * wave, dil = au.dil;
        const float c2 = alibi_slope(au.h) * (float)dil * LOG2E;
        f32x16 o0, o1, bias;
#pragma unroll
        for (int e = 0; e < 16; ++e) { o0[e] = 0.f; o1[e] = 0.f; bias[e] = c2 * (float)((e & 3) + 8 * (e >> 2) + 4 * h2 - ql); }
        float m = -1e30f, l = 0.f;
#pragma unroll
        for (int kk = 0; kk < 5; ++kk) {
            const int kt = 4 - kk;
            const int k0 = i0 - 128 + 32 * kt;
            if (k0 >= 0) {
                f32x16 sa = bias;
#pragma unroll
                for (int s = 0; s < 4; ++s) { const bf16x8 kc = *(const LAS bf16x8*)(krd + (32 * kt) * ATT_KS + 32 * s); sa = __builtin_amdgcn_mfma_f32_32x32x16_bf16(kc, qf[s], sa, 0, 0, 0); }
                float mx = -INFINITY;
#pragma unroll
                for (int e = 0; e < 16; ++e) { const int kr = (e & 3) + 8 * (e >> 2);
                    if (kt == 0) sa[e] = (kr + 4 * h2 >= ql) ? sa[e] : -INFINITY;
                    if (kt == 4) sa[e] = (kr + 4 * h2 <= ql) ? sa[e] : -INFINITY;
                    mx = fmaxf(mx, sa[e]); }
                mx = xhalf_max(mx);
                const float delta = c2 * (float)(128 - 32 * kt);
                if (kt == 4) m = mx;
                else {
                    const float mxt = mx - delta; const bool need = mxt > m + 8.0f;
                    if (__builtin_amdgcn_ballot_w64(need) != 0ull) {
                        const float mn = need ? mxt : m, alpha = __builtin_amdgcn_exp2f(m - mn); m = mn; l *= alpha;
#pragma unroll
                        for (int e = 0; e < 16; ++e) { o0[e] *= alpha; o1[e] *= alpha; }
                    }
                }
                const float msub = m + delta;
                float ls = 0.f;
#pragma unroll
                for (int e = 0; e < 16; ++e) { sa[e] = __builtin_amdgcn_exp2f(sa[e] - msub); ls += sa[e]; }
                l += ls;
#pragma unroll
                for (int s2 = 0; s2 < 2; ++s2) {
                    v4u pw; pw.x = cvtpk_s(sa[8 * s2], sa[8 * s2 + 1]); pw.y = cvtpk_s(sa[8 * s2 + 2], sa[8 * s2 + 3]); pw.z = cvtpk_s(sa[8 * s2 + 4], sa[8 * s2 + 5]); pw.w = cvtpk_s(sa[8 * s2 + 6], sa[8 * s2 + 7]);
                    const bf16x8 pb = __builtin_bit_cast(bf16x8, pw);
                    const LAS unsigned char* vb = vrd + (32 * kt + 16 * s2) * ATT_VS;
                    { const v4i16_t a = vtr(vb), c = vtr(vb + 8 * ATT_VS);
                      const bf16x8 vf = {a[0], a[1], a[2], a[3], c[0], c[1], c[2], c[3]};
                      o0 = __builtin_amdgcn_mfma_f32_32x32x16_bf16(vf, pb, o0, 0, 0, 0); }
                    { const v4i16_t a = vtr(vb + 64), c = vtr(vb + 8 * ATT_VS + 64);
                      const bf16x8 vf = {a[0], a[1], a[2], a[3], c[0], c[1], c[2], c[3]};
                      o1 = __builtin_amdgcn_mfma_f32_32x32x16_bf16(vf, pb, o1, 0, 0, 0); }
                }
            }
        }
        const float lt = xhalf_sum(l), il = 1.0f / lt;
        if (h2 == 0) LSE[((size_t)au.p * M + au.rowb + (size_t)(i0 + ql) * dil) * NH + au.h] = (m + __log2f(lt)) * LN2;
        bf16* og = OP + ((size_t)au.p * M + au.rowb + (size_t)(i0 + (lane >> 1)) * dil) * AW + au.h * 64 + 16 * (lane & 1);
        LAS unsigned char* ow = OL + ql * ATT_OS + 8 * h2;
        const LAS unsigned char* orr = OL + (lane >> 1) * ATT_OS + 32 * (lane & 1);
#pragma unroll
        for (int dt = 0; dt < 2; ++dt) {
#pragma unroll
            for (int g4 = 0; g4 < 4; ++g4) { v2u w;
                if (dt == 0) { w.x = cvtpk_s(o0[4 * g4] * il, o0[4 * g4 + 1] * il); w.y = cvtpk_s(o0[4 * g4 + 2] * il, o0[4 * g4 + 3] * il); }
                else { w.x = cvtpk_s(o1[4 * g4] * il, o1[4 * g4 + 1] * il); w.y = cvtpk_s(o1[4 * g4 + 2] * il, o1[4 * g4 + 3] * il); }
                *(LAS v2u*)(ow + 16 * g4) = w; }
            const v2u r0 = *(const LAS v2u*)(orr), r1 = *(const LAS v2u*)(orr + 8), r2 = *(const LAS v2u*)(orr + 16), r3 = *(const LAS v2u*)(orr + 24);
            v4u s0; s0.x = r0.x; s0.y = r0.y; s0.z = r1.x; s0.w = r1.y; v4u s1; s1.x = r2.x; s1.y = r2.y; s1.z = r3.x; s1.w = r3.y;
            *(v4u*)(og + 32 * dt) = s0; *(v4u*)(og + 32 * dt + 8) = s1;
        }
    }
#undef ATT_LOAD
    asm volatile("" ::: "memory"); __builtin_amdgcn_s_barrier(); asm volatile("" ::: "memory");
}
#endif
struct Args { const float* in[14]; float* out; unsigned char* ws; int ph_lo, ph_hi; };
__global__ void __launch_bounds__(NWAVES * 64, 2) hymba_fwd(Args args) {
    extern __shared__ __attribute__((aligned(16))) unsigned char lds_raw[];
    LAS unsigned char* lds = (LAS unsigned char*)lds_raw;
    cg::grid_group grid = cg::this_grid();
    const int tid = threadIdx.x, lane = tid & 63, wave = __builtin_amdgcn_readfirstlane(tid >> 6);
    const int G = gridDim.x, bx = blockIdx.x;
    const int vcu = (G % 8 == 0) ? (bx % 8) * (G / 8) + bx / 8 : bx;
    const int gw = vcu * NWAVES + wave, NGW = G * NWAVES;
    unsigned char* ws = args.ws;
    const float* x = args.in[0]; const float* norm1_g = args.in[1]; const float* w_in = args.in[2]; const float* sgu_ln_g = args.in[3]; const float* sgu_ln_b = args.in[4];
    const float* sgu_w = args.in[5]; const float* sgu_b = args.in[6]; const float* attn_out_g = args.in[7]; const float* gmlp_out_g = args.in[8]; const float* w_out = args.in[9];
    const float* norm2_g = args.in[10]; const float* w_ff1 = args.in[11]; const float* w_ff2 = args.in[12]; const float* final_g = args.in[13];
    float* out = args.out;
    bf16* WIN = (bf16*)(ws + WS_WIN); bf16* WOUT = (bf16*)(ws + WS_WOUT); bf16* W1 = (bf16*)(ws + WS_W1); bf16* W2 = (bf16*)(ws + WS_W2);
    float* SS1 = (float*)(ws + WS_SS1); float* SS2 = (float*)(ws + WS_SS2); float* LSE = (float*)(ws + WS_LSE);
    bf16* GM = (bf16*)(ws + WS_GM); bf16* XN = (bf16*)(ws + WS_XN); bf16* PROJ = (bf16*)(ws + WS_PROJ); bf16* OP = (bf16*)(ws + WS_OP);
    bf16* H1B = (bf16*)(ws + WS_H1B); bf16* HID = (bf16*)(ws + WS_HID);
    const int lo = args.ph_lo, hi = args.ph_hi;
#define IN(k) (lo <= (k) && (k) < hi)
#define SEAM(k) do { if (IN(k) && IN((k) + 1)) grid.sync(); } while (0)
#define REPS(k) for (int rep_ = 0; rep_ < ((MK_DBL == (k)) ? 2 : 1); ++rep_)
#define REPSYNC() do { if (rep_) grid.sync(); } while (0)

    if (IN(0)) REPS(0) { REPSYNC();
        LAS float* scr = (LAS float*)(lds + wave * 16384);
        constexpr int I_IN = (D / 64) * (INW / 32), I_O = (D / 64) * (D / 32), I_1 = (D / 64) * (FF / 32), I_2 = (FF / 64) * (D / 32);
        constexpr int NITEMS = I_IN + I_O + I_1 + I_2;
#pragma unroll 1
        for (int it = gw; it < NITEMS; it += NGW) {
            int r = it;
            if (r < I_IN) { p0_transpose_item(w_in, D, INW, WIN, norm1_g, AW, MK_NAIVE_ATTN ? 0.125f : 0.125f * 1.4426950408889634f, scr, r, lane); continue; } r -= I_IN;
            if (r < I_O) { p0_transpose_item(w_out, D, D, WOUT, (r / (D / 32)) < (AW / 64) ? attn_out_g : gmlp_out_g - AW, 0, 1.0f, scr, r, lane); continue; } r -= I_O;
            if (r < I_1) { p0_transpose_item(w_ff1, D, FF, W1, norm2_g, 0, 1.0f, scr, r, lane); continue; } r -= I_1;
            p0_transpose_item(w_ff2, FF, D, W2, nullptr, 0, 1.0f, scr, r, lane);
        }
#pragma unroll 1
        for (int m = gw; m < M; m += NGW) rms_row_to_bf16(x + (size_t)m * D, XN + (size_t)m * D, lane);
    }
    SEAM(0);
    if (IN(1)) REPS(1) { REPSYNC();
        pg8::Gemm g{XN, WIN, M, INW, D}; pg8::StaticOrder S; S.init(M, INW, G, bx);
        pg8::EpiBf16 E{PROJ, INW};
        pg8::gemm_phase<pg8::EpiBf16, pg8::StaticOrder, true, true>(lds, g, S, E);
    }
    SEAM(1);
    if (IN(2)) REPS(2) { REPSYNC();
        for (int rg_ = 0; rg_ < (MK_DBL == 20 ? 2 : 1); ++rg_)
#pragma unroll 1
        for (int u = vcu; u < BATCH * (SEQ / CHUNK) * NG; u += G) gmlp_unit(lds, PROJ, sgu_ln_g, sgu_ln_b, sgu_w, sgu_b, GM, u, tid);
#if MK_NAIVE_ATTN
        attn_naive(PROJ, OP, LSE, bx * (NWAVES * 64) + tid, G * NWAVES * 64);
#else
        for (int ra_ = 0; ra_ < (MK_DBL == 21 ? 2 : 1); ++ra_) attn_phase(lds, PROJ, OP, LSE, vcu, G, wave, lane, tid);
#endif
    }
    SEAM(2);
    if (IN(3)) REPS(3) { REPSYNC();
#pragma unroll 1
        for (int m = gw; m < M; m += NGW) mixnorm_row(OP, LSE, GM, XN, m, lane);
    }
    SEAM(3);
    if (IN(4)) REPS(4) { REPSYNC();
        pg8::Gemm g{XN, WOUT, M, D, D}; pg8::StaticOrder S; S.init(M, D, G, bx);
        pg8::EpiResA E{x, H1B, SS1, D};
        pg8::gemm_phase<pg8::EpiResA, pg8::StaticOrder, true, true>(lds, g, S, E);
    }
    SEAM(4);
    if (IN(5)) REPS(5) { REPSYNC();
        pg8::Gemm g{H1B, W1, M, FF, D}; pg8::StaticOrder S; S.init(M, FF, G, bx);
        pg8::EpiSqRelu E{HID, FF, SS1};
        pg8::gemm_phase<pg8::EpiSqRelu, pg8::StaticOrder, true, true>(lds, g, S, E);
    }
    SEAM(5);
    if (IN(6)) REPS(6) { REPSYNC();
        pg8::Gemm g{HID, W2, M, D, FF}; pg8::StaticOrder S; S.init(M, D, G, bx);
        pg8::EpiResB E{H1B, out, SS2, D};
        pg8::gemm_phase<pg8::EpiResB, pg8::StaticOrder, true, true>(lds, g, S, E);
    }
    SEAM(6);
    if (IN(7)) REPS(7) { REPSYNC();
#pragma unroll 1
        for (int m = gw; m < M; m += NGW) {
            f32x4* orow = (f32x4*)(out + (size_t)m * D) + lane;
            float s = SS2[(size_t)m * 16 + (lane & 15)];
            s += __shfl_xor(s, 1); s += __shfl_xor(s, 2); s += __shfl_xor(s, 4); s += __shfl_xor(s, 8);
            const float rstd = 1.0f / sqrtf(s * (1.0f / D) + EPS);
#pragma unroll
            for (int j = 0; j < 4; ++j) { const f32x4 v = orow[64 * j]; const f32x4 gq = *((const f32x4*)final_g + lane + 64 * j); orow[64 * j] = v * rstd * gq; }
        }
    }
#undef IN
#undef SEAM
}

extern "C" void kernel_launch(void* const* d_in, const int* in_sizes, int n_in, void* d_out, int out_size, void* d_ws, size_t ws_size, hipStream_t stream) {
    static int grid = 0;
    if (grid == 0) {
        if (n_in != 14 || in_sizes[0] != M * D || out_size != M * D || ws_size < WS_END) { fprintf(stderr, "kernel_launch: unexpected shapes (n_in %d, in0 %d, out %d, ws %zu); nothing launched\n", n_in, n_in > 0 ? in_sizes[0] : -1, out_size, ws_size); grid = -1; return; }
        int dev = 0, cus = 0, per_cu = 0;
        if (hipGetDevice(&dev) != hipSuccess || hipDeviceGetAttribute(&cus, hipDeviceAttributeMultiprocessorCount, dev) != hipSuccess) { grid = -1; return; }
        if (hipFuncSetAttribute((const void*)hymba_fwd, hipFuncAttributeMaxDynamicSharedMemorySize, LDS_BYTES) != hipSuccess) { fprintf(stderr, "kernel_launch: hipFuncSetAttribute failed\n"); grid = -1; return; }
        if (hipOccupancyMaxActiveBlocksPerMultiprocessor(&per_cu, (const void*)hymba_fwd, NWAVES * 64, LDS_BYTES) != hipSuccess || per_cu < 1) { fprintf(stderr, "kernel_launch: occupancy query says %d blocks per CU\n", per_cu); per_cu = 1; }
        (void)hipGetLastError();
        grid = cus;
    }
    if (grid < 0) return;
    Args a{};
    for (int i = 0; i < 14; ++i) a.in[i] = (const float*)d_in[i];
    a.out = (float*)d_out; a.ws = (unsigned char*)d_ws;
#if MK_N_LAUNCHES == 1
    a.ph_lo = 0; a.ph_hi = NPH;
    void* kargs[] = {&a};
    hipError_t e = hipLaunchCooperativeKernel((const void*)hymba_fwd, dim3(grid), dim3(NWAVES * 64), kargs, LDS_BYTES, stream);
    if (e != hipSuccess) fprintf(stderr, "kernel_launch: cooperative launch failed: %s (grid %d)\n", hipGetErrorString(e), grid);
#else
    for (int ph = 0; ph < NPH; ++ph) {
        a.ph_lo = ph; a.ph_hi = ph + 1;
        hipLaunchKernelGGL(hymba_fwd, dim3(grid), dim3(NWAVES * 64), LDS_BYTES, stream, a);
    }
#endif
}
```

```cpp
#include <hip/hip_runtime.h>
#include <hip/hip_cooperative_groups.h>
#include <cstdio>
#include <cstdint>
namespace cg = cooperative_groups;
#define MK_NAIVE_ATTN 0
#define MK_N_LAUNCHES 1
#define MK_DBL -1
namespace pg8 {
#define PG8_LAS __attribute__((address_space(3)))
typedef unsigned short bf16_t;
typedef short bf16x8 __attribute__((ext_vector_type(8)));
typedef float f32x4 __attribute__((ext_vector_type(4)));
typedef unsigned u32x4 __attribute__((ext_vector_type(4)));
constexpr int BM = 256, BK = 64, HALF = 128, HTB = HALF * BK * 2  , STAGE_BYTES = 8 * HTB, NXCD = 8, WGM = 8;

__host__ __device__ __forceinline__ int lds_byte(int r, int c) { const int st = (r >> 4) * 2 + (c >> 5), rr = r & 15, cc = c & 31, ob = rr * 64 + cc * 2; return st * 1024 + (ob ^ (((ob >> 9) & 1) << 5)); }
__host__ __device__ __forceinline__ void stage_rc(int b, int& R, int& C) { const int st = b / 1024, sb = b % 1024, swz = sb ^ (((sb >> 9) & 1) << 5); R = (st >> 1) * 16 + swz / 64; C = (st & 1) * 32 + (swz % 64) / 2; }
__host__ __device__ __forceinline__ int perm32(int rho) { const int n = rho >> 4, i = rho & 15; return 8 * (i >> 2) + 4 * n + (i & 3); }

struct Unit { int pm, pn; };
struct Gemm { const bf16_t* A; const bf16_t* Bt; int M, N, K; };

struct StaticOrder {
    int nM, nN, nwg, G, c;
    __host__ __device__ void init(int M, int N, int G_, int c_) { nM = M / BM; nN = N / BM; nwg = nM * nN; G = G_; c = c_; }
    __host__ __device__ bool next(int i, Unit& u) const {
        const long L = (long)i * G + c; if (L >= nwg) return false;
        int wgid = (int)L; { const int q = nwg / NXCD, r = nwg % NXCD, xcd = wgid % NXCD, off = wgid / NXCD; wgid = (xcd < r ? xcd * (q + 1) : r * (q + 1) + (xcd - r) * q) + off; }
        const int nig = WGM * nN, gid = wgid / nig, fm = gid * WGM, gsz = (nM - fm) < WGM ? (nM - fm) : WGM;
        u.pm = fm + ((wgid % nig) % gsz); u.pn = (wgid % nig) / gsz; return true;
    }
    __device__ __forceinline__ void a_ready(const Unit&) const {}
    __device__ __forceinline__ void done(const Unit&) const {}
};

__device__ __forceinline__ unsigned cvt_pk_bf16(float lo, float hi) { unsigned r; asm volatile("v_cvt_pk_bf16_f32 %0, %1, %2" : "=v"(r) : "v"(lo), "v"(hi)); return r; }
typedef unsigned u32x2 __attribute__((ext_vector_type(2)));
struct EpiBf16 {
    static constexpr bool PERM = true, AFTER_DRAIN = false;
    bf16_t* O; int ldc;
    __device__ __forceinline__ void operator()(const f32x4 (&acc)[2][2][4][2], const Unit& u, int wr, int wc, int fr, int fq) const {
        const int row0 = u.pm * BM + wr * 64 + fr; const int col0 = u.pn * BM + wc * 32 + 8 * fq;
#pragma unroll
        for (int ai = 0; ai < 2; ++ai)
#pragma unroll
            for (int m = 0; m < 4; ++m) { bf16_t* rowp = O + (size_t)(row0 + ai * HALF + m * 16) * ldc + col0;
#pragma unroll
                for (int bj = 0; bj < 2; ++bj) { const f32x4 v0 = acc[ai][bj][m][0], v1 = acc[ai][bj][m][1];
                    u32x4 w; w.x = cvt_pk_bf16(v0[0], v0[1]); w.y = cvt_pk_bf16(v0[2], v0[3]); w.z = cvt_pk_bf16(v1[0], v1[1]); w.w = cvt_pk_bf16(v1[2], v1[3]);
                    *(u32x4*)(rowp + bj * HALF) = w; } }
    }
};
struct EpiSqRelu {
    static constexpr bool PERM = true, AFTER_DRAIN = false;
    bf16_t* O; int ldc; const float* ss;
    __device__ __forceinline__ void operator()(const f32x4 (&acc)[2][2][4][2], const Unit& u, int wr, int wc, int fr, int fq) const {
        const int row0 = u.pm * BM + wr * 64 + fr; const int col0 = u.pn * BM + wc * 32 + 8 * fq;
#pragma unroll
        for (int ai = 0; ai < 2; ++ai)
#pragma unroll
            for (int m = 0; m < 4; ++m) { const int r = row0 + ai * HALF + m * 16; bf16_t* rowp = O + (size_t)r * ldc + col0;
                const f32x4* sp = (const f32x4*)(ss + (size_t)r * 16); const f32x4 s0 = sp[0], s1 = sp[1], s2 = sp[2], s3 = sp[3];
                const float tot = ((s0[0] + s0[1]) + (s0[2] + s0[3])) + ((s1[0] + s1[1]) + (s1[2] + s1[3])) + ((s2[0] + s2[1]) + (s2[2] + s2[3])) + ((s3[0] + s3[1]) + (s3[2] + s3[3]));
                const float rstd = 1.0f / sqrtf(tot * (1.0f / 1024.0f) + 1e-6f);
#pragma unroll
                for (int bj = 0; bj < 2; ++bj) { f32x4 v0 = acc[ai][bj][m][0] * rstd, v1 = acc[ai][bj][m][1] * rstd;
#pragma unroll
                    for (int e = 0; e < 4; ++e) { const float a = fmaxf(v0[e], 0.f), b = fmaxf(v1[e], 0.f); v0[e] = a * a; v1[e] = b * b; }
                    u32x4 w; w.x = cvt_pk_bf16(v0[0], v0[1]); w.y = cvt_pk_bf16(v0[2], v0[3]); w.z = cvt_pk_bf16(v1[0], v1[1]); w.w = cvt_pk_bf16(v1[2], v1[3]);
                    *(u32x4*)(rowp + bj * HALF) = w; } }
    }
};
struct EpiResA {
    static constexpr bool PERM = true, AFTER_DRAIN = false;
    const float* base; bf16_t* ob; float* ss; int ldc;
    __device__ __forceinline__ void operator()(const f32x4 (&acc)[2][2][4][2], const Unit& u, int wr, int wc, int fr, int fq) const {
        const int row0 = u.pm * BM + wr * 64 + fr; const int col0 = u.pn * BM + wc * 32 + 8 * fq;
#pragma unroll
        for (int ai = 0; ai < 2; ++ai)
#pragma unroll
            for (int m = 0; m < 4; ++m) { const int r = row0 + ai * HALF + m * 16; const size_t off = (size_t)r * ldc + col0; float s = 0.f;
#pragma unroll
                for (int bj = 0; bj < 2; ++bj) { const f32x4 v0 = *(const f32x4*)(base + off + bj * HALF) + acc[ai][bj][m][0], v1 = *(const f32x4*)(base + off + bj * HALF + 4) + acc[ai][bj][m][1];
                    s += ((v0[0] * v0[0] + v0[1] * v0[1]) + (v0[2] * v0[2] + v0[3] * v0[3])) + ((v1[0] * v1[0] + v1[1] * v1[1]) + (v1[2] * v1[2] + v1[3] * v1[3]));
                    u32x4 w; w.x = cvt_pk_bf16(v0[0], v0[1]); w.y = cvt_pk_bf16(v0[2], v0[3]); w.z = cvt_pk_bf16(v1[0], v1[1]); w.w = cvt_pk_bf16(v1[2], v1[3]);
                    *(u32x4*)(ob + off + bj * HALF) = w; }
                s += __shfl_xor(s, 16); s += __shfl_xor(s, 32);
                if (fq == 0) ss[(size_t)r * 16 + u.pn * 4 + wc] = s; }
    }
};
struct EpiResB {
    static constexpr bool PERM = true, AFTER_DRAIN = false;
    const bf16_t* hb; float* out; float* ss; int ldc;
    __device__ __forceinline__ void operator()(const f32x4 (&acc)[2][2][4][2], const Unit& u, int wr, int wc, int fr, int fq) const {
        const int row0 = u.pm * BM + wr * 64 + fr; const int col0 = u.pn * BM + wc * 32 + 8 * fq;
#pragma unroll
        for (int ai = 0; ai < 2; ++ai)
#pragma unroll
            for (int m = 0; m < 4; ++m) { const int r = row0 + ai * HALF + m * 16; const size_t off = (size_t)r * ldc + col0; float s = 0.f;
#pragma unroll
                for (int bj = 0; bj < 2; ++bj) { const u32x4 rb = *(const u32x4*)(hb + off + bj * HALF);
                    f32x4 v0, v1; v0[0] = __uint_as_float(rb.x << 16); v0[1] = __uint_as_float(rb.x & 0xffff0000u); v0[2] = __uint_as_float(rb.y << 16); v0[3] = __uint_as_float(rb.y & 0xffff0000u);
                    v1[0] = __uint_as_float(rb.z << 16); v1[1] = __uint_as_float(rb.z & 0xffff0000u); v1[2] = __uint_as_float(rb.w << 16); v1[3] = __uint_as_float(rb.w & 0xffff0000u);
                    v0 += acc[ai][bj][m][0]; v1 += acc[ai][bj][m][1];
                    s += ((v0[0] * v0[0] + v0[1] * v0[1]) + (v0[2] * v0[2] + v0[3] * v0[3])) + ((v1[0] * v1[0] + v1[1] * v1[1]) + (v1[2] * v1[2] + v1[3] * v1[3]));
                    *(f32x4*)(out + off + bj * HALF) = v0; *(f32x4*)(out + off + bj * HALF + 4) = v1; }
                s += __shfl_xor(s, 16); s += __shfl_xor(s, 32);
                if (fq == 0) ss[(size_t)r * 16 + u.pn * 4 + wc] = s; }
    }
};
template <class Epi, class Sched, bool ALIGN_EPI = false, bool SP2 = false>
__device__ __forceinline__ void gemm_phase(PG8_LAS unsigned char* lds, const Gemm g, const Sched& S, const Epi& E) {
    const int tid = threadIdx.x, wid = __builtin_amdgcn_readfirstlane(tid >> 6), lane = tid & 63, wr = wid >> 2, wc = wid & 3, fr = lane & 15, fq = lane >> 4;
    const int K = g.K, nt = K / BK;
    unsigned voffA[2], voffB[2];
#pragma unroll
    for (int i = 0; i < 2; ++i) { int R, C; stage_rc(tid * 16 + i * 8192, R, C); const int Rb = Epi::PERM ? ((R & ~31) + perm32(R & 31)) : R;
        voffA[i] = (unsigned)(R * K + C) * 2u; voffB[i] = (unsigned)(Rb * K + C) * 2u; }
    const size_t kstep = (size_t)(BK * 2);
    const size_t hstep = (size_t)HALF * K * 2;
    const size_t tstep = 2 * hstep;
    const unsigned ldsw = (unsigned)wid * 1024u;
    const int aoff = lds_byte(wr * 64 + fr, fq * 8), boff = lds_byte(wc * 32 + fr, fq * 8);
#define PG8_SA(b, h) (((b) * 2 + (h)) * HTB)
#define PG8_SB(b, h) ((4 + (b) * 2 + (h)) * HTB)
#define PG8_STAGE(bufoff, gbase, voff) do { _Pragma("unroll") for (int _i = 0; _i < 2; ++_i) \
        __builtin_amdgcn_global_load_lds((const unsigned*)((const char*)(gbase) + (voff)[_i]), (PG8_LAS unsigned*)(lds + (bufoff) + ldsw + _i * 8192), 16, 0, 0); } while (0)
#define PG8_LDA(dst, b, h) do { _Pragma("unroll") for (int m = 0; m < 4; ++m) _Pragma("unroll") for (int k = 0; k < 2; ++k) dst[m][k] = *(const PG8_LAS bf16x8*)(lds + PG8_SA(b, h) + aoff + m * 2048 + k * 1024); } while (0)
#define PG8_LDB(dst, b, h) do { _Pragma("unroll") for (int n = 0; n < 2; ++n) _Pragma("unroll") for (int k = 0; k < 2; ++k) dst[n][k] = *(const PG8_LAS bf16x8*)(lds + PG8_SB(b, h) + boff + n * 2048 + k * 1024); } while (0)
#define PG8_MMA(ai, bj, At, Bt) do { __builtin_amdgcn_s_setprio(1); _Pragma("unroll") for (int m = 0; m < 4; ++m) _Pragma("unroll") for (int n = 0; n < 2; ++n) _Pragma("unroll") for (int k = 0; k < 2; ++k) \
        acc[ai][bj][m][n] = __builtin_amdgcn_mfma_f32_16x16x32_bf16(Bt[n][k], At[m][k], acc[ai][bj][m][n], 0, 0, 0); __builtin_amdgcn_s_setprio(0); } while (0)
#define PG8_WAIT_V(n) asm volatile("s_waitcnt vmcnt(" #n ")" ::: "memory")
#define PG8_WAIT_L(n) asm volatile("s_waitcnt lgkmcnt(" #n ")" ::: "memory")
#define PG8_BAR __builtin_amdgcn_s_barrier()
#define PG8_SCHED __builtin_amdgcn_sched_barrier(0)
    Unit cur, nxt; int ui = 0;
    if (!S.next(0, cur)) return;
    f32x4 acc[2][2][4][2];
#pragma unroll
    for (int a = 0; a < 2; ++a)
#pragma unroll
        for (int b = 0; b < 2; ++b)
#pragma unroll
            for (int m = 0; m < 4; ++m)
#pragma unroll
                for (int n = 0; n < 2; ++n) acc[a][b][m][n] = (f32x4){0.f, 0.f, 0.f, 0.f};
    bf16x8 At[4][2], B0[2][2], B1[2][2];
    const char* cA = (const char*)g.A + (size_t)cur.pm * tstep; const char* cB = (const char*)g.Bt + (size_t)cur.pn * tstep;
    S.a_ready(cur);
    if constexpr (SP2) {
        PG8_STAGE(PG8_SB(0, 0), cB, voffB); PG8_STAGE(PG8_SB(0, 1), cB + hstep, voffB); PG8_STAGE(PG8_SA(0, 0), cA, voffA); PG8_STAGE(PG8_SA(0, 1), cA + hstep, voffA);
        if (wr == 1) PG8_BAR;
        PG8_WAIT_V(2); PG8_BAR;
        PG8_STAGE(PG8_SB(1, 0), cB + kstep, voffB); PG8_STAGE(PG8_SA(1, 0), cA + kstep, voffA); PG8_STAGE(PG8_SB(1, 1), cB + hstep + kstep, voffB);
        PG8_WAIT_V(6); PG8_BAR;
    } else {
        PG8_STAGE(PG8_SB(0, 0), cB, voffB); PG8_STAGE(PG8_SA(0, 0), cA, voffA); PG8_STAGE(PG8_SB(0, 1), cB + hstep, voffB); PG8_STAGE(PG8_SA(0, 1), cA + hstep, voffA);
        if (wr == 1) PG8_BAR;
        PG8_WAIT_V(4); PG8_BAR;
        PG8_STAGE(PG8_SB(1, 0), cB + kstep, voffB); PG8_STAGE(PG8_SA(1, 0), cA + kstep, voffA); PG8_STAGE(PG8_SB(1, 1), cB + hstep + kstep, voffB);
        PG8_WAIT_V(6); PG8_BAR;
    }
    for (;;) {
        const bool has_next = S.next(ui + 1, nxt);
        const char* nA = has_next ? (const char*)g.A + (size_t)nxt.pm * tstep : cA; const char* nB = has_next ? (const char*)g.Bt + (size_t)nxt.pn * tstep : cB;
        for (int t = 0; t < nt; t += 2) {
            const bool last = (t == nt - 2);
            const char* a1 = cA + (size_t)(t + 1) * kstep;
            const char* a2 = last ? nA : cA + (size_t)(t + 2) * kstep; const char* b2 = last ? nB : cB + (size_t)(t + 2) * kstep;
            const char* a3 = a2 + kstep; const char* b3 = b2 + kstep;
            if (last && has_next) S.a_ready(nxt);
            if constexpr (SP2) {
            PG8_LDB(B0, 0, 0); PG8_LDB(B1, 0, 1); PG8_SCHED; PG8_LDA(At, 0, 0); PG8_STAGE(PG8_SA(1, 1), a1 + hstep, voffA);
            PG8_WAIT_V(8); PG8_WAIT_L(0); PG8_BAR; PG8_MMA(0, 0, At, B0); PG8_MMA(0, 1, At, B1); PG8_BAR; PG8_SCHED;
            PG8_LDA(At, 0, 1); PG8_STAGE(PG8_SB(0, 0), b2, voffB); PG8_STAGE(PG8_SB(0, 1), b2 + hstep, voffB); PG8_STAGE(PG8_SA(0, 0), a2, voffA);
            PG8_WAIT_V(8); PG8_WAIT_L(0); PG8_BAR; PG8_MMA(1, 0, At, B0); PG8_MMA(1, 1, At, B1); PG8_BAR; PG8_SCHED;
            PG8_LDB(B0, 1, 0); PG8_LDB(B1, 1, 1); PG8_SCHED; PG8_LDA(At, 1, 0); PG8_STAGE(PG8_SA(0, 1), a2 + hstep, voffA);
            PG8_WAIT_V(8); PG8_WAIT_L(0); PG8_BAR; PG8_MMA(0, 0, At, B0); PG8_MMA(0, 1, At, B1); PG8_BAR; PG8_SCHED;
            PG8_LDA(At, 1, 1); PG8_STAGE(PG8_SB(1, 0), b3, voffB); PG8_STAGE(PG8_SB(1, 1), b3 + hstep, voffB); PG8_STAGE(PG8_SA(1, 0), a3, voffA);
            PG8_WAIT_V(8); PG8_WAIT_L(0); PG8_BAR; PG8_MMA(1, 0, At, B0); PG8_MMA(1, 1, At, B1); PG8_BAR; PG8_SCHED;
            } else {
            PG8_LDB(B0, 0, 0); PG8_SCHED; PG8_LDA(At, 0, 0); PG8_STAGE(PG8_SA(1, 1), a1 + hstep, voffA);
            PG8_WAIT_L(8); PG8_BAR; PG8_WAIT_L(0); PG8_MMA(0, 0, At, B0); PG8_BAR; PG8_SCHED;
            PG8_LDB(B1, 0, 1); PG8_STAGE(PG8_SB(0, 0), b2, voffB);
            PG8_BAR; PG8_WAIT_L(0); PG8_MMA(0, 1, At, B1); PG8_BAR;
            PG8_LDA(At, 0, 1); PG8_STAGE(PG8_SA(0, 0), a2, voffA);
            PG8_BAR; PG8_WAIT_L(0); PG8_MMA(1, 0, At, B0); PG8_BAR; PG8_SCHED;
            PG8_STAGE(PG8_SB(0, 1), b2 + hstep, voffB);
            PG8_WAIT_V(6); PG8_BAR; PG8_MMA(1, 1, At, B1); PG8_BAR;
            PG8_LDB(B0, 1, 0); PG8_SCHED; PG8_LDA(At, 1, 0); PG8_STAGE(PG8_SA(0, 1), a2 + hstep, voffA);
            PG8_WAIT_L(8); PG8_BAR; PG8_WAIT_L(0); PG8_MMA(0, 0, At, B0); PG8_BAR; PG8_SCHED;
            PG8_LDB(B1, 1, 1); PG8_STAGE(PG8_SB(1, 0), b3, voffB);
            PG8_BAR; PG8_WAIT_L(0); PG8_MMA(0, 1, At, B1); PG8_BAR;
            PG8_LDA(At, 1, 1); PG8_STAGE(PG8_SA(1, 0), a3, voffA);
            PG8_BAR; PG8_WAIT_L(0); PG8_MMA(1, 0, At, B0); PG8_BAR; PG8_SCHED;
            PG8_STAGE(PG8_SB(1, 1), b3 + hstep, voffB);
            PG8_WAIT_V(6); PG8_BAR; PG8_MMA(1, 1, At, B1); PG8_BAR;
            }
        }
        if constexpr (ALIGN_EPI) { if (wr == 0) PG8_BAR; }
        if constexpr (!Epi::AFTER_DRAIN) { E(acc, cur, wr, wc, fr, fq); S.done(cur); }
        if (!has_next) break;
#pragma unroll
        for (int a = 0; a < 2; ++a)
#pragma unroll
            for (int b = 0; b < 2; ++b)
#pragma unroll
                for (int m = 0; m < 4; ++m)
#pragma unroll
                    for (int n = 0; n < 2; ++n) acc[a][b][m][n] = (f32x4){0.f, 0.f, 0.f, 0.f};
        cur = nxt; cA = nA; cB = nB; ++ui;
        if constexpr (ALIGN_EPI) { if (wr == 1) PG8_BAR; }
    }
    PG8_WAIT_V(0);
    if constexpr (!ALIGN_EPI) { if (wr == 0) PG8_BAR; }
    PG8_BAR;
    if constexpr (Epi::AFTER_DRAIN) { E.fused(acc, cur, wr, wc, fr, fq, lds, wid, lane); S.done(cur); }
#undef PG8_SA
#undef PG8_SB
#undef PG8_STAGE
#undef PG8_LDA
#undef PG8_LDB
#undef PG8_MMA
#undef PG8_WAIT_V
#undef PG8_WAIT_L
#undef PG8_BAR
#undef PG8_SCHED
}
}
#define GAS __attribute__((address_space(1)))
#define LAS __attribute__((address_space(3)))
typedef unsigned short bf16;
typedef unsigned v4u __attribute__((ext_vector_type(4)));
typedef unsigned v2u __attribute__((ext_vector_type(2)));
typedef float f32x4 __attribute__((ext_vector_type(4)));
typedef float f32x16 __attribute__((ext_vector_type(16)));
typedef short bf16x8 __attribute__((ext_vector_type(8)));
#define LDS_WAIT() asm volatile("s_waitcnt lgkmcnt(0)" ::: "memory")

#ifndef MK_N_LAUNCHES
#define MK_N_LAUNCHES 1
#endif
#ifndef MK_NAIVE_ATTN
#define MK_NAIVE_ATTN 0
#endif
constexpr int NWAVES = 8, NPH = 8;
constexpr int BATCH = 4, SEQ = 8192, D = 1024, NH = 12, HD = 64, AW = 768, GWD = 256, NG = 4, INW = 2816, FF = 4096, M = BATCH * SEQ, CHUNK = 128;
constexpr float EPS = 1e-6f;
constexpr size_t MiB = 1u << 20;
constexpr size_t WS_WIN = 2 * MiB, WS_WOUT = 8 * MiB, WS_W1 = 10 * MiB, WS_W2 = 18 * MiB, WS_SS1 = 26 * MiB, WS_SS2 = 28 * MiB, WS_LSE = 30 * MiB, WS_GM = 36 * MiB,
                 WS_XN = 64 * MiB, WS_PROJ = 128 * MiB, WS_OP = 304 * MiB, WS_H1B = 128 * MiB, WS_HID = 192 * MiB, WS_END = 448 * MiB;
static_assert(WS_WIN + (size_t)INW * D * 2 <= WS_WOUT && WS_LSE + (size_t)3 * M * NH * 4 <= WS_GM && WS_GM + (size_t)M * GWD * 2 <= WS_XN && WS_PROJ + (size_t)M * INW * 2 <= WS_OP && WS_OP + (size_t)3 * M * AW * 2 <= WS_END && WS_HID + (size_t)M * FF * 2 <= WS_END, "ws map");
constexpr int LDS_BYTES = 147456;

__device__ __forceinline__ float bflo(unsigned u) { return __uint_as_float(u << 16); }
__device__ __forceinline__ float bfhi(unsigned u) { return __uint_as_float(u & 0xffff0000u); }
typedef float pk_f32x2 __attribute__((ext_vector_type(2)));
typedef __bf16 pk_bf16x2 __attribute__((ext_vector_type(2)));
__device__ __forceinline__ unsigned pk2(float lo, float hi) { pk_f32x2 v = {lo, hi}; pk_bf16x2 b = __builtin_convertvector(v, pk_bf16x2); return __builtin_bit_cast(unsigned, b); }
__device__ __forceinline__ float wave_sum(float v) {
#pragma unroll
    for (int o = 1; o < 64; o <<= 1) v += __shfl_xor(v, o);
    return v;
}
__device__ __forceinline__ float gelu_t(float x) { const float y = 0.7978845608028654f * (x + 0.044715f * x * x * x); return x / (1.0f + __expf(-2.0f * y)); }

__device__ __forceinline__ void p0_transpose_item(const float* W, int K, int N, bf16* WT, const float* gk, int qcols, float qscale, LAS float* scr, int item, int lane) {
    const int nblk = N / 32, kb = item / nblk, nb = item % nblk, k0 = 64 * kb, n0 = 32 * nb;
#pragma unroll 8
    for (int i = 0; i < 32; ++i) { const int kk = 2 * i + (lane >> 5); const float g = gk ? gk[k0 + kk] : 1.0f; scr[kk * 33 + (lane & 31)] = W[(size_t)(k0 + kk) * N + n0 + (lane & 31)] * g; }
    LDS_WAIT();
    const int c = lane & 7;
#pragma unroll
    for (int j = 0; j < 4; ++j) { const int n = (lane >> 3) + 8 * j; const LAS float* s = scr + (8 * c) * 33 + n; const float sc = (n0 + n < qcols) ? qscale : 1.0f;
        v4u o; o.x = pk2(s[0 * 33] * sc, s[1 * 33] * sc); o.y = pk2(s[2 * 33] * sc, s[3 * 33] * sc); o.z = pk2(s[4 * 33] * sc, s[5 * 33] * sc); o.w = pk2(s[6 * 33] * sc, s[7 * 33] * sc);
        *(v4u*)(WT + (size_t)(n0 + n) * K + k0 + 8 * c) = o; }
    LDS_WAIT();
}
__device__ __forceinline__ void rms_row_to_bf16(const float* xrow, bf16* orow, int lane) {
    const f32x4* xr = (const f32x4*)xrow + lane;
    f32x4 v[4]; float s = 0.f;
#pragma unroll
    for (int j = 0; j < 4; ++j) { v[j] = xr[64 * j]; s += (v[j].x * v[j].x + v[j].y * v[j].y) + (v[j].z * v[j].z + v[j].w * v[j].w); }
    const float rstd = 1.0f / sqrtf(wave_sum(s) * (1.0f / D) + EPS);
    v2u* o8 = (v2u*)orow + lane;
#pragma unroll
    for (int j = 0; j < 4; ++j) { v2u w; w.x = pk2(v[j].x * rstd, v[j].y * rstd); w.y = pk2(v[j].z * rstd, v[j].w * rstd); o8[64 * j] = w; }
}

typedef short gm_v4i16 __attribute__((ext_vector_type(4)));
__device__ __forceinline__ void gmlp_unit(LAS unsigned char* lds, const bf16* PROJ, const float* ln_g, const float* ln_b, const float* sgu_w, const float* sgu_b, bf16* GM, int unit, int tid) {
    const int g = unit & 3, n = (unit >> 2) & 63, b = unit >> 8;
    const size_t row0 = (size_t)b * SEQ + (size_t)n * CHUNK;
    const int wave = __builtin_amdgcn_readfirstlane(tid >> 6), lane = tid & 63, ql = lane & 31, h2 = lane >> 5, ti = wave >> 1, ci = wave & 1;
    const int tq = 32 * ti + ql;
    const float* wrow = sgu_w + ((size_t)g * CHUNK + tq) * CHUNK + 8 * h2;
    f32x4 wf[8][2];
#pragma unroll
    for (int ks = 0; ks < 8; ++ks) if (ks < 2 * (ti + 1)) { wf[ks][0] = *(const f32x4*)(wrow + 16 * ks); wf[ks][1] = *(const f32x4*)(wrow + 16 * ks + 4); }
    const bf16* up = PROJ + (row0 + tq) * INW + 2304 + g * 64 + 32 * ci + 4 * h2;
    v2u ur[4];
#pragma unroll
    for (int g4 = 0; g4 < 4; ++g4) ur[g4] = *(const v2u*)(up + 8 * g4);
    const float bs = sgu_b[g * CHUNK + tq];
    {
        const int t = tid >> 2, q = tid & 3;
        const bf16* zp = PROJ + (row0 + t) * INW + 2560 + g * 64 + 16 * q;
        const v4u r0 = *(const v4u*)zp, r1 = *(const v4u*)(zp + 8);
        float z[16];
        z[0] = bflo(r0.x); z[1] = bfhi(r0.x); z[2] = bflo(r0.y); z[3] = bfhi(r0.y); z[4] = bflo(r0.z); z[5] = bfhi(r0.z); z[6] = bflo(r0.w); z[7] = bfhi(r0.w);
        z[8] = bflo(r1.x); z[9] = bfhi(r1.x); z[10] = bflo(r1.y); z[11] = bfhi(r1.y); z[12] = bflo(r1.z); z[13] = bfhi(r1.z); z[14] = bflo(r1.w); z[15] = bfhi(r1.w);
        float s = 0.f;
#pragma unroll
        for (int e = 0; e < 16; ++e) { z[e] = gelu_t(z[e]); s += z[e]; }
        s += __shfl_xor(s, 1); s += __shfl_xor(s, 2);
        const float mean = s * (1.0f / 64.0f); float v = 0.f;
#pragma unroll
        for (int e = 0; e < 16; ++e) { z[e] -= mean; v += z[e] * z[e]; }
        v += __shfl_xor(v, 1); v += __shfl_xor(v, 2);
        const float rstd = 1.0f / sqrtf(v * (1.0f / 64.0f) + EPS);
        const float* lg = ln_g + g * 64 + 16 * q; const float* lb = ln_b + g * 64 + 16 * q;
#pragma unroll
        for (int e = 0; e < 16; ++e) z[e] = z[e] * rstd * lg[e] + lb[e];
        v4u w0, w1; w0.x = pk2(z[0], z[1]); w0.y = pk2(z[2], z[3]); w0.z = pk2(z[4], z[5]); w0.w = pk2(z[6], z[7]); w1.x = pk2(z[8], z[9]); w1.y = pk2(z[10], z[11]); w1.z = pk2(z[12], z[13]); w1.w = pk2(z[14], z[15]);
        *(LAS v4u*)(lds + t * 192 + q * 32) = w0; *(LAS v4u*)(lds + t * 192 + q * 32 + 16) = w1;
    }
    __syncthreads();
    f32x16 acc;
#pragma unroll
    for (int e = 0; e < 16; ++e) acc[e] = 0.f;
    const LAS unsigned char* zrd = lds + (8 * h2 + ((lane & 15) >> 2)) * 192 + (32 * ci + ((lane >> 4) & 1) * 16 + (lane & 3) * 4) * 2;
#pragma unroll
    for (int ks = 0; ks < 8; ++ks) if (ks < 2 * (ti + 1)) {
        float w[8];
#pragma unroll
        for (int e = 0; e < 4; ++e) { w[e] = wf[ks][0][e]; w[4 + e] = wf[ks][1][e]; }
#pragma unroll
        for (int e = 0; e < 8; ++e) w[e] = (16 * ks + 8 * h2 + e <= tq) ? w[e] : 0.f;
        v4u bw; bw.x = pk2(w[0], w[1]); bw.y = pk2(w[2], w[3]); bw.z = pk2(w[4], w[5]); bw.w = pk2(w[6], w[7]);
        const bf16x8 bfr = __builtin_bit_cast(bf16x8, bw);
        const gm_v4i16 a0 = __builtin_amdgcn_ds_read_tr16_b64_v4i16((LAS gm_v4i16*)(zrd + (16 * ks) * 192)), a1 = __builtin_amdgcn_ds_read_tr16_b64_v4i16((LAS gm_v4i16*)(zrd + (16 * ks + 4) * 192));
        const bf16x8 afr = {a0[0], a0[1], a0[2], a0[3], a1[0], a1[1], a1[2], a1[3]};
        acc = __builtin_amdgcn_mfma_f32_32x32x16_bf16(afr, bfr, acc, 0, 0, 0);
    }
    bf16* gp = GM + (row0 + tq) * GWD + g * 64 + 32 * ci + 4 * h2;
#pragma unroll
    for (int g4 = 0; g4 < 4; ++g4) {
        const float u0 = gelu_t(bflo(ur[g4].x)) * (acc[4 * g4] + bs), u1 = gelu_t(bfhi(ur[g4].x)) * (acc[4 * g4 + 1] + bs), u2 = gelu_t(bflo(ur[g4].y)) * (acc[4 * g4 + 2] + bs), u3 = gelu_t(bfhi(ur[g4].y)) * (acc[4 * g4 + 3] + bs);
        v2u o; o.x = pk2(u0, u1); o.y = pk2(u2, u3); *(v2u*)(gp + 8 * g4) = o;
    }
    __syncthreads();
}

__device__ __forceinline__ float alibi_slope(int h) { return (h < 8) ? exp2f(-(float)(h + 1)) : exp2f(-0.5f - (float)(h - 8)); }

#if MK_NAIVE_ATTN
__device__ __forceinline__ void attn_naive(const bf16* PROJ, bf16* OP, float* LSE, int gtid, int nthreads) {
#pragma unroll 1
    for (int it = gtid; it < M * NH * 3; it += nthreads) {
        const int h = it % NH, row = (it / NH) % M, p = it / (NH * M), dil = 1 << (2 * p), t = row % SEQ;
        const float slope = alibi_slope(h);
        const bf16* qp = PROJ + (size_t)row * INW + h * 64;
        float q[64], o[64];
#pragma unroll
        for (int c = 0; c < 8; ++c) { const v4u r = *(const v4u*)(qp + 8 * c); q[8*c] = bflo(r.x); q[8*c+1] = bfhi(r.x); q[8*c+2] = bflo(r.y); q[8*c+3] = bfhi(r.y); q[8*c+4] = bflo(r.z); q[8*c+5] = bfhi(r.z); q[8*c+6] = bflo(r.w); q[8*c+7] = bfhi(r.w); }
#pragma unroll
        for (int e = 0; e < 64; ++e) o[e] = 0.f;
        float m = -1e30f, l = 0.f;
#pragma unroll 1
        for (int j = 0; j <= 128; ++j) {
            const int tk = t - dil * j; if (tk < 0) break;
            const bf16* kp = qp + 768 - (size_t)(dil * j) * INW; const bf16* vp = kp + 768;
            float dot = 0.f;
#pragma unroll
            for (int c = 0; c < 8; ++c) { const v4u r = *(const v4u*)(kp + 8 * c);
                dot += q[8*c] * bflo(r.x) + q[8*c+1] * bfhi(r.x) + q[8*c+2] * bflo(r.y) + q[8*c+3] * bfhi(r.y) + q[8*c+4] * bflo(r.z) + q[8*c+5] * bfhi(r.z) + q[8*c+6] * bflo(r.w) + q[8*c+7] * bfhi(r.w); }
            const float s = dot - slope * (float)(dil * j);
            const float mn = fmaxf(m, s), sc = __expf(m - mn), pe = __expf(s - mn);
            l = l * sc + pe; m = mn;
#pragma unroll
            for (int c = 0; c < 8; ++c) { const v4u r = *(const v4u*)(vp + 8 * c);
                o[8*c] = o[8*c] * sc + pe * bflo(r.x); o[8*c+1] = o[8*c+1] * sc + pe * bfhi(r.x); o[8*c+2] = o[8*c+2] * sc + pe * bflo(r.y); o[8*c+3] = o[8*c+3] * sc + pe * bfhi(r.y);
                o[8*c+4] = o[8*c+4] * sc + pe * bflo(r.z); o[8*c+5] = o[8*c+5] * sc + pe * bfhi(r.z); o[8*c+6] = o[8*c+6] * sc + pe * bflo(r.w); o[8*c+7] = o[8*c+7] * sc + pe * bfhi(r.w); }
        }
        const float il = 1.0f / l;
        bf16* op = OP + ((size_t)p * M + row) * AW + h * 64;
#pragma unroll
        for (int c = 0; c < 8; ++c) { v4u w; w.x = pk2(o[8*c] * il, o[8*c+1] * il); w.y = pk2(o[8*c+2] * il, o[8*c+3] * il); w.z = pk2(o[8*c+4] * il, o[8*c+5] * il); w.w = pk2(o[8*c+6] * il, o[8*c+7] * il); *(v4u*)(op + 8 * c) = w; }
        LSE[((size_t)p * M + row) * NH + h] = m + __logf(l);
    }
}
#endif

__device__ __forceinline__ void mixnorm_row(const bf16* OP, const float* LSE, const bf16* GM, bf16* MIXED, int row, int lane) {
    float a[3][4]; float ssa = 0.f;
#pragma unroll
    for (int j = 0; j < 3; ++j) {
        const int c = 256 * j + 4 * lane, head = c >> 6;
        float ls[3];
#pragma unroll
        for (int p = 0; p < 3; ++p) ls[p] = LSE[((size_t)p * M + row) * NH + head];
        const float mx = fmaxf(ls[0], fmaxf(ls[1], ls[2]));
        float w[3]; float wsum = 0.f;
#pragma unroll
        for (int p = 0; p < 3; ++p) { w[p] = __expf(ls[p] - mx); wsum += w[p]; }
        const float iw = 1.0f / wsum;
#pragma unroll
        for (int e = 0; e < 4; ++e) a[j][e] = 0.f;
#pragma unroll
        for (int p = 0; p < 3; ++p) { const v2u r = *(const v2u*)(OP + ((size_t)p * M + row) * AW + c); const float wp = w[p] * iw;
            a[j][0] += wp * bflo(r.x); a[j][1] += wp * bfhi(r.x); a[j][2] += wp * bflo(r.y); a[j][3] += wp * bfhi(r.y); }
#pragma unroll
        for (int e = 0; e < 4; ++e) ssa += a[j][e] * a[j][e];
    }
    const v2u gr = *(const v2u*)(GM + (size_t)row * GWD + 4 * lane);
    float gv[4]; gv[0] = bflo(gr.x); gv[1] = bfhi(gr.x); gv[2] = bflo(gr.y); gv[3] = bfhi(gr.y);
    float ssg = (gv[0] * gv[0] + gv[1] * gv[1]) + (gv[2] * gv[2] + gv[3] * gv[3]);
    const float ra = 1.0f / sqrtf(wave_sum(ssa) * (1.0f / AW) + EPS), rg = 1.0f / sqrtf(wave_sum(ssg) * (1.0f / GWD) + EPS);
    bf16* mp = MIXED + (size_t)row * D;
#pragma unroll
    for (int j = 0; j < 3; ++j) { v2u w; w.x = pk2(a[j][0] * ra, a[j][1] * ra); w.y = pk2(a[j][2] * ra, a[j][3] * ra); *(v2u*)(mp + 256 * j + 4 * lane) = w; }
    { v2u w; w.x = pk2(gv[0] * rg, gv[1] * rg); w.y = pk2(gv[2] * rg, gv[3] * rg); *(v2u*)(mp + AW + 4 * lane) = w; }
}
#if !MK_NAIVE_ATTN
typedef short v4i16_t __attribute__((ext_vector_type(4)));
typedef float f32x2_t __attribute__((ext_vector_type(2)));
typedef __bf16 bf16x2_t __attribute__((ext_vector_type(2)));
__device__ __forceinline__ unsigned cvtpk_s(float lo, float hi) { f32x2_t v = {lo, hi}; bf16x2_t b = __builtin_convertvector(v, bf16x2_t); return __builtin_bit_cast(unsigned, b); }
__device__ __forceinline__ v4i16_t vtr(const LAS unsigned char* p) { return __builtin_amdgcn_ds_read_tr16_b64_v4i16((LAS v4i16_t*)p); }
__device__ __forceinline__ float xhalf_max(float v) { auto rr = __builtin_amdgcn_permlane32_swap(__float_as_uint(v), __float_as_uint(v), false, false); return fmaxf(__uint_as_float(rr[0]), __uint_as_float(rr[1])); }
__device__ __forceinline__ float xhalf_sum(float v) { auto rr = __builtin_amdgcn_permlane32_swap(__float_as_uint(v), __float_as_uint(v), false, false); return __uint_as_float(rr[0]) + __uint_as_float(rr[1]); }
constexpr int ATT_KS = 144, ATT_VS = 192, ATT_KROWS = 384, ATT_VOFF = ATT_KROWS * ATT_KS, ATT_OOFF = ATT_VOFF + ATT_KROWS * ATT_VS, ATT_OS = 72;
static_assert(ATT_OOFF + NWAVES * 32 * ATT_OS <= LDS_BYTES, "attention LDS map");
constexpr int ATT_NU = BATCH * NH * 96;

struct AttUnit { int p, h, dil, i0w; size_t rowb; };
__device__ __forceinline__ AttUnit att_decode(int u) {
    AttUnit a; const int bh = u / 96, rem = u - bh * 96, b = bh / NH; a.h = bh - b * NH; a.p = rem >> 5; const int sub = rem & 31, dsh = 2 * a.p; a.dil = 1 << dsh;
    const int nblk = 32 >> dsh, r = sub / nblk, blk = sub - r * nblk; a.i0w = 256 * blk; a.rowb = (size_t)b * SEQ + r; return a;
}

__device__ __forceinline__ void attn_phase(LAS unsigned char* lds, const bf16* PROJ, bf16* OP, float* LSE, int vcu, int G, int wave, int lane, int tid) {
    constexpr float LOG2E = 1.4426950408889634f, LN2 = 0.6931471805599453f;
    const int ql = lane & 31, h2 = lane >> 5;
    LAS unsigned char* KL = lds; LAS unsigned char* VL = lds + ATT_VOFF; LAS unsigned char* OL = lds + ATT_OOFF + wave * (32 * ATT_OS);
    const LAS unsigned char* krd = KL + (32 * wave + ql) * ATT_KS + 16 * h2;
    const LAS unsigned char* vrd = VL + (32 * wave + 4 * h2 + ((lane & 15) >> 2)) * ATT_VS + (((lane >> 4) & 1) * 16 + (lane & 3) * 4) * 2;
    v4u kreg[6], vreg[6]; bf16x8 qn[4];
#define ATT_LOAD(u_) do { const AttUnit a_ = att_decode(u_); const bf16* base_ = PROJ + a_.h * 64; \
        _Pragma("unroll") for (int j = 0; j < 6; ++j) { const int c_ = tid + 512 * j; int di_ = a_.i0w - 128 + (c_ >> 3); di_ = di_ < 0 ? 0 : di_; \
            const bf16* kp_ = base_ + AW + (a_.rowb + (size_t)di_ * a_.dil) * INW + (c_ & 7) * 8; kreg[j] = *(const v4u*)kp_; vreg[j] = *(const v4u*)(kp_ + AW); } \
        const bf16* qp_ = base_ + (a_.rowb + (size_t)(a_.i0w + 32 * wave + ql) * a_.dil) * INW + 8 * h2; \
        _Pragma("unroll") for (int s = 0; s < 4; ++s) qn[s] = *(const bf16x8*)(qp_ + 16 * s); } while (0)
    int u = vcu;
    if (u < ATT_NU) ATT_LOAD(u);
#pragma unroll 1
    for (; u < ATT_NU; u += G) {
        asm volatile("" ::: "memory"); __builtin_amdgcn_s_barrier(); asm volatile("" ::: "memory");
#pragma unroll
        for (int j = 0; j < 6; ++j) { const int c = tid + 512 * j; *(LAS v4u*)(KL + (c >> 3) * ATT_KS + (c & 7) * 16) = kreg[j]; *(LAS v4u*)(VL + (c >> 3) * ATT_VS + (c & 7) * 16) = vreg[j]; }
        bf16x8 qf[4];
#pragma unroll
        for (int s = 0; s < 4; ++s) qf[s] = qn[s];
        asm volatile("s_waitcnt lgkmcnt(0)" ::: "memory"); __builtin_amdgcn_s_barrier(); asm volatile("" ::: "memory");
        const AttUnit au = att_decode(u);
        if (u + G < ATT_NU) ATT_LOAD(u + G);
        const int i0 = au.i0w + 32 * wave, dil = au.dil;
        const float c2 = alibi_slope(au.h) * (float)dil * LOG2E;
        f32x16 o0, o1, bias;
#pragma unroll
        for (int e = 0; e < 16; ++e) { o0[e] = 0.f; o1[e] = 0.f; bias[e] = c2 * (float)((e & 3) + 8 * (e >> 2) + 4 * h2 - ql); }
        float m = -1e30f, l = 0.f;
#pragma unroll
        for (int kk = 0; kk < 5; ++kk) {
            const int kt = 4 - kk;
            const int k0 = i0 - 128 + 32 * kt;
            if (k0 >= 0) {
                f32x16 sa = bias;
#pragma unroll
                for (int s = 0; s < 4; ++s) { const bf16x8 kc = *(const LAS bf16x8*)(krd + (32 * kt) * ATT_KS + 32 * s); sa = __builtin_amdgcn_mfma_f32_32x32x16_bf16(kc, qf[s], sa, 0, 0, 0); }
                float mx = -INFINITY;
#pragma unroll
                for (int e = 0; e < 16; ++e) { const int kr = (e & 3) + 8 * (e >> 2);
                    if (kt == 0) sa[e] = (kr + 4 * h2 >= ql) ? sa[e] : -INFINITY;
                    if (kt == 4) sa[e] = (kr + 4 * h2 <= ql) ? sa[e] : -INFINITY;
                    mx = fmaxf(mx, sa[e]); }
                mx = xhalf_max(mx);
                const float delta = c2 * (float)(128 - 32 * kt);
                if (kt == 4) m = mx;
                else {
                    const float mxt = mx - delta; const bool need = mxt > m + 8.0f;
                    if (__builtin_amdgcn_ballot_w64(need) != 0ull) {
                        const float mn = need ? mxt : m, alpha = __builtin_amdgcn_exp2f(m - mn); m = mn; l *= alpha;
#pragma unroll
                        for (int e = 0; e < 16; ++e) { o0[e] *= alpha; o1[e] *= alpha; }
                    }
                }
                const float msub = m + delta;
                float ls = 0.f;
#pragma unroll
                for (int e = 0; e < 16; ++e) { sa[e] = __builtin_amdgcn_exp2f(sa[e] - msub); ls += sa[e]; }
                l += ls;
#pragma unroll
                for (int s2 = 0; s2 < 2; ++s2) {
                    v4u pw; pw.x = cvtpk_s(sa[8 * s2], sa[8 * s2 + 1]); pw.y = cvtpk_s(sa[8 * s2 + 2], sa[8 * s2 + 3]); pw.z = cvtpk_s(sa[8 * s2 + 4], sa[8 * s2 + 5]); pw.w = cvtpk_s(sa[8 * s2 + 6], sa[8 * s2 + 7]);
                    const bf16x8 pb = __builtin_bit_cast(bf16x8, pw);
                    const LAS unsigned char* vb = vrd + (32 * kt + 16 * s2) * ATT_VS;
                    { const v4i16_t a = vtr(vb), c = vtr(vb + 8 * ATT_VS);
                      const bf16x8 vf = {a[0], a[1], a[2], a[3], c[0], c[1], c[2], c[3]};
                      o0 = __builtin_amdgcn_mfma_f32_32x32x16_bf16(vf, pb, o0, 0, 0, 0); }
                    { const v4i16_t a = vtr(vb + 64), c = vtr(vb + 8 * ATT_VS + 64);
                      const bf16x8 vf = {a[0], a[1], a[2], a[3], c[0], c[1], c[2], c[3]};
                      o1 = __builtin_amdgcn_mfma_f32_32x32x16_bf16(vf, pb, o1, 0, 0, 0); }
                }
            }
        }
        const float lt = xhalf_sum(l), il = 1.0f / lt;
        if (h2 == 0) LSE[((size_t)au.p * M + au.rowb + (size_t)(i0 + ql) * dil) * NH + au.h] = (m + __log2f(lt)) * LN2;
        bf16* og = OP + ((size_t)au.p * M + au.rowb + (size_t)(i0 + (lane >> 1)) * dil) * AW + au.h * 64 + 16 * (lane & 1);
        LAS unsigned char* ow = OL + ql * ATT_OS + 8 * h2;
        const LAS unsigned char* orr = OL + (lane >> 1) * ATT_OS + 32 * (lane & 1);
#pragma unroll
        for (int dt = 0; dt < 2; ++dt) {
#pragma unroll
            for (int g4 = 0; g4 < 4; ++g4) { v2u w;
                if (dt == 0) { w.x = cvtpk_s(o0[4 * g4] * il, o0[4 * g4 + 1] * il); w.y = cvtpk_s(o0[4 * g4 + 2] * il, o0[4 * g4 + 3] * il); }
                else { w.x = cvtpk_s(o1[4 * g4] * il, o1[4 * g4 + 1] * il); w.y = cvtpk_s(o1[4 * g4 + 2] * il, o1[4 * g4 + 3] * il); }
                *(LAS v2u*)(ow + 16 * g4) = w; }
            const v2u r0 = *(const LAS v2u*)(orr), r1 = *(const LAS v2u*)(orr + 8), r2 = *(const LAS v2u*)(orr + 16), r3 = *(const LAS v2u*)(orr + 24);
            v4u s0; s0.x = r0.x; s0.y = r0.y; s0.z = r1.x; s0.w = r1.y; v4u s1; s1.x = r2.x; s1.y = r2.y; s1.z = r3.x; s1.w = r3.y;
            *(v4u*)(og + 32 * dt) = s0; *(v4u*)(og + 32 * dt + 8) = s1;
        }
    }
#undef ATT_LOAD
    asm volatile("" ::: "memory"); __builtin_amdgcn_s_barrier(); asm volatile("" ::: "memory");
}
#endif
struct Args { const float* in[14]; float* out; unsigned char* ws; int ph_lo, ph_hi; };
__global__ void __launch_bounds__(NWAVES * 64, 2) hymba_fwd(Args args) {
    extern __shared__ __attribute__((aligned(16))) unsigned char lds_raw[];
    LAS unsigned char* lds = (LAS unsigned char*)lds_raw;
    cg::grid_group grid = cg::this_grid();
    const int tid = threadIdx.x, lane = tid & 63, wave = __builtin_amdgcn_readfirstlane(tid >> 6);
    const int G = gridDim.x, bx = blockIdx.x;
    const int vcu = (G % 8 == 0) ? (bx % 8) * (G / 8) + bx / 8 : bx;
    const int gw = vcu * NWAVES + wave, NGW = G * NWAVES;
    unsigned char* ws = args.ws;
    const float* x = args.in[0]; const float* norm1_g = args.in[1]; const float* w_in = args.in[2]; const float* sgu_ln_g = args.in[3]; const float* sgu_ln_b = args.in[4];
    const float* sgu_w = args.in[5]; const float* sgu_b = args.in[6]; const float* attn_out_g = args.in[7]; const float* gmlp_out_g = args.in[8]; const float* w_out = args.in[9];
    const float* norm2_g = args.in[10]; const float* w_ff1 = args.in[11]; const float* w_ff2 = args.in[12]; const float* final_g = args.in[13];
    float* out = args.out;
    bf16* WIN = (bf16*)(ws + WS_WIN); bf16* WOUT = (bf16*)(ws + WS_WOUT); bf16* W1 = (bf16*)(ws + WS_W1); bf16* W2 = (bf16*)(ws + WS_W2);
    float* SS1 = (float*)(ws + WS_SS1); float* SS2 = (float*)(ws + WS_SS2); float* LSE = (float*)(ws + WS_LSE);
    bf16* GM = (bf16*)(ws + WS_GM); bf16* XN = (bf16*)(ws + WS_XN); bf16* PROJ = (bf16*)(ws + WS_PROJ); bf16* OP = (bf16*)(ws + WS_OP);
    bf16* H1B = (bf16*)(ws + WS_H1B); bf16* HID = (bf16*)(ws + WS_HID);
    const int lo = args.ph_lo, hi = args.ph_hi;
#define IN(k) (lo <= (k) && (k) < hi)
#define SEAM(k) do { if (IN(k) && IN((k) + 1)) grid.sync(); } while (0)
#define REPS(k) for (int rep_ = 0; rep_ < ((MK_DBL == (k)) ? 2 : 1); ++rep_)
#define REPSYNC() do { if (rep_) grid.sync(); } while (0)

    if (IN(0)) REPS(0) { REPSYNC();
        LAS float* scr = (LAS float*)(lds + wave * 16384);
        constexpr int I_IN = (D / 64) * (INW / 32), I_O = (D / 64) * (D / 32), I_1 = (D / 64) * (FF / 32), I_2 = (FF / 64) * (D / 32);
        constexpr int NITEMS = I_IN + I_O + I_1 + I_2;
#pragma unroll 1
        for (int it = gw; it < NITEMS; it += NGW) {
            int r = it;
            if (r < I_IN) { p0_transpose_item(w_in, D, INW, WIN, norm1_g, AW, MK_NAIVE_ATTN ? 0.125f : 0.125f * 1.4426950408889634f, scr, r, lane); continue; } r -= I_IN;
            if (r < I_O) { p0_transpose_item(w_out, D, D, WOUT, (r / (D / 32)) < (AW / 64) ? attn_out_g : gmlp_out_g - AW, 0, 1.0f, scr, r, lane); continue; } r -= I_O;
            if (r < I_1) { p0_transpose_item(w_ff1, D, FF, W1, norm2_g, 0, 1.0f, scr, r, lane); continue; } r -= I_1;
            p0_transpose_item(w_ff2, FF, D, W2, nullptr, 0, 1.0f, scr, r, lane);
        }
#pragma unroll 1
        for (int m = gw; m < M; m += NGW) rms_row_to_bf16(x + (size_t)m * D, XN + (size_t)m * D, lane);
    }
    SEAM(0);
    if (IN(1)) REPS(1) { REPSYNC();
        pg8::Gemm g{XN, WIN, M, INW, D}; pg8::StaticOrder S; S.init(M, INW, G, bx);
        pg8::EpiBf16 E{PROJ, INW};
        pg8::gemm_phase<pg8::EpiBf16, pg8::StaticOrder, true, true>(lds, g, S, E);
    }
    SEAM(1);
    if (IN(2)) REPS(2) { REPSYNC();
        for (int rg_ = 0; rg_ < (MK_DBL == 20 ? 2 : 1); ++rg_)
#pragma unroll 1
        for (int u = vcu; u < BATCH * (SEQ / CHUNK) * NG; u += G) gmlp_unit(lds, PROJ, sgu_ln_g, sgu_ln_b, sgu_w, sgu_b, GM, u, tid);
#if MK_NAIVE_ATTN
        attn_naive(PROJ, OP, LSE, bx * (NWAVES * 64) + tid, G * NWAVES * 64);
#else
        for (int ra_ = 0; ra_ < (MK_DBL == 21 ? 2 : 1); ++ra_) attn_phase(lds, PROJ, OP, LSE, vcu, G, wave, lane, tid);
#endif
    }
    SEAM(2);
    if (IN(3)) REPS(3) { REPSYNC();
#pragma unroll 1
        for (int m = gw; m < M; m += NGW) mixnorm_row(OP, LSE, GM, XN, m, lane);
    }
    SEAM(3);
    if (IN(4)) REPS(4) { REPSYNC();
        pg8::Gemm g{XN, WOUT, M, D, D}; pg8::StaticOrder S; S.init(M, D, G, bx);
        pg8::EpiResA E{x, H1B, SS1, D};
        pg8::gemm_phase<pg8::EpiResA, pg8::StaticOrder, true, true>(lds, g, S, E);
    }
    SEAM(4);
    if (IN(5)) REPS(5) { REPSYNC();
        pg8::Gemm g{H1B, W1, M, FF, D}; pg8::StaticOrder S; S.init(M, FF, G, bx);
        pg8::EpiSqRelu E{HID, FF, SS1};
        pg8::gemm_phase<pg8::EpiSqRelu, pg8::StaticOrder, true, true>(lds, g, S, E);
    }
    SEAM(5);
    if (IN(6)) REPS(6) { REPSYNC();
        pg8::Gemm g{HID, W2, M, D, FF}; pg8::StaticOrder S; S.init(M, D, G, bx);
        pg8::EpiResB E{H1B, out, SS2, D};
        pg8::gemm_phase<pg8::EpiResB, pg8::StaticOrder, true, true>(lds, g, S, E);
    }
    SEAM(6);
    if (IN(7)) REPS(7) { REPSYNC();
#pragma unroll 1
        for (int m = gw; m < M; m += NGW) {
            f32x4* orow = (f32x4*)(out + (size_t)m * D) + lane;
            float s = SS2[(size_t)m * 16 + (lane & 15)];
            s += __shfl_xor(s, 1); s += __shfl_xor(s, 2); s += __shfl_xor(s, 4); s += __shfl_xor(s, 8);
            const float rstd = 1.0f / sqrtf(s * (1.0f / D) + EPS);
#pragma unroll
            for (int j = 0; j < 4; ++j) { const f32x4 v = orow[64 * j]; const f32x4 gq = *((const f32x4*)final_g + lane + 64 * j); orow[64 * j] = v * rstd * gq; }
        }
    }
#undef IN
#undef SEAM
}

extern "C" void kernel_launch(void* const* d_in, const int* in_sizes, int n_in, void* d_out, int out_size, void* d_ws, size_t ws_size, hipStream_t stream) {
    static int grid = 0;
    if (grid == 0) {
        if (n_in != 14 || in_sizes[0] != M * D || out_size != M * D || ws_size < WS_END) { fprintf(stderr, "kernel_launch: unexpected shapes (n_in %d, in0 %d, out %d, ws %zu); nothing launched\n", n_in, n_in > 0 ? in_sizes[0] : -1, out_size, ws_size); grid = -1; return; }
        int dev = 0, cus = 0, per_cu = 0;
        if (hipGetDevice(&dev) != hipSuccess || hipDeviceGetAttribute(&cus, hipDeviceAttributeMultiprocessorCount, dev) != hipSuccess) { grid = -1; return; }
        if (hipFuncSetAttribute((const void*)hymba_fwd, hipFuncAttributeMaxDynamicSharedMemorySize, LDS_BYTES) != hipSuccess) { fprintf(stderr, "kernel_launch: hipFuncSetAttribute failed\n"); grid = -1; return; }
        if (hipOccupancyMaxActiveBlocksPerMultiprocessor(&per_cu, (const void*)hymba_fwd, NWAVES * 64, LDS_BYTES) != hipSuccess || per_cu < 1) { fprintf(stderr, "kernel_launch: occupancy query says %d blocks per CU\n", per_cu); per_cu = 1; }
        (void)hipGetLastError();
        grid = cus;
    }
    if (grid < 0) return;
    Args a{};
    for (int i = 0; i < 14; ++i) a.in[i] = (const float*)d_in[i];
    a.out = (float*)d_out; a.ws = (unsigned char*)d_ws;
#if MK_N_LAUNCHES == 1
    a.ph_lo = 0; a.ph_hi = NPH;
    void* kargs[] = {&a};
    hipError_t e = hipLaunchCooperativeKernel((const void*)hymba_fwd, dim3(grid), dim3(NWAVES * 64), kargs, LDS_BYTES, stream);
    if (e != hipSuccess) fprintf(stderr, "kernel_launch: cooperative launch failed: %s (grid %d)\n", hipGetErrorString(e), grid);
#else
    for (int ph = 0; ph < NPH; ++ph) {
        a.ph_lo = ph; a.ph_hi = ph + 1;
        hipLaunchKernelGGL(hymba_fwd, dim3(grid), dim3(NWAVES * 64), LDS_BYTES, stream, a);
    }
#endif
}
```

```cpp
#include <hip/hip_runtime.h>
#include <hip/hip_cooperative_groups.h>
#include <cstdio>
#include <cstdint>
namespace cg = cooperative_groups;
#define MK_NAIVE_ATTN 0
#define MK_N_LAUNCHES 1
#define MK_DBL -1
namespace pg8 {
#define PG8_LAS __attribute__((address_space(3)))
typedef unsigned short bf16_t;
typedef short bf16x8 __attribute__((ext_vector_type(8)));
typedef float f32x4 __attribute__((ext_vector_type(4)));
typedef unsigned u32x4 __attribute__((ext_vector_type(4)));
constexpr int BM = 256, BK = 64, HALF = 128, HTB = HALF * BK * 2  , STAGE_BYTES = 8 * HTB, NXCD = 8, WGM = 8;

__host__ __device__ __forceinline__ int lds_byte(int r, int c) { const int st = (r >> 4) * 2 + (c >> 5), rr = r & 15, cc = c & 31, ob = rr * 64 + cc * 2; return st * 1024 + (ob ^ (((ob >> 9) & 1) << 5)); }
__host__ __device__ __forceinline__ void stage_rc(int b, int& R, int& C) { const int st = b / 1024, sb = b % 1024, swz = sb ^ (((sb >> 9) & 1) << 5); R = (st >> 1) * 16 + swz / 64; C = (st & 1) * 32 + (swz % 64) / 2; }
__host__ __device__ __forceinline__ int perm32(int rho) { const int n = rho >> 4, i = rho & 15; return 8 * (i >> 2) + 4 * n + (i & 3); }

struct Unit { int pm, pn; };
struct Gemm { const bf16_t* A; const bf16_t* Bt; int M, N, K; };

struct StaticOrder {
    int nM, nN, nwg, G, c;
    __host__ __device__ void init(int M, int N, int G_, int c_) { nM = M / BM; nN = N / BM; nwg = nM * nN; G = G_; c = c_; }
    __host__ __device__ bool next(int i, Unit& u) const {
        const long L = (long)i * G + c; if (L >= nwg) return false;
        int wgid = (int)L; { const int q = nwg / NXCD, r = nwg % NXCD, xcd = wgid % NXCD, off = wgid / NXCD; wgid = (xcd < r ? xcd * (q + 1) : r * (q + 1) + (xcd - r) * q) + off; }
        const int nig = WGM * nN, gid = wgid / nig, fm = gid * WGM, gsz = (nM - fm) < WGM ? (nM - fm) : WGM;
        u.pm = fm + ((wgid % nig) % gsz); u.pn = (wgid % nig) / gsz; return true;
    }
    __device__ __forceinline__ void a_ready(const Unit&) const {}
    __device__ __forceinline__ void done(const Unit&) const {}
};

__device__ __forceinline__ unsigned cvt_pk_bf16(float lo, float hi) { unsigned r; asm volatile("v_cvt_pk_bf16_f32 %0, %1, %2" : "=v"(r) : "v"(lo), "v"(hi)); return r; }
typedef unsigned u32x2 __attribute__((ext_vector_type(2)));
struct EpiBf16 {
    static constexpr bool PERM = true, AFTER_DRAIN = false;
    bf16_t* O; int ldc;
    __device__ __forceinline__ void operator()(const f32x4 (&acc)[2][2][4][2], const Unit& u, int wr, int wc, int fr, int fq) const {
        const int row0 = u.pm * BM + wr * 64 + fr; const int col0 = u.pn * BM + wc * 32 + 8 * fq;
#pragma unroll
        for (int ai = 0; ai < 2; ++ai)
#pragma unroll
            for (int m = 0; m < 4; ++m) { bf16_t* rowp = O + (size_t)(row0 + ai * HALF + m * 16) * ldc + col0;
#pragma unroll
                for (int bj = 0; bj < 2; ++bj) { const f32x4 v0 = acc[ai][bj][m][0], v1 = acc[ai][bj][m][1];
                    u32x4 w; w.x = cvt_pk_bf16(v0[0], v0[1]); w.y = cvt_pk_bf16(v0[2], v0[3]); w.z = cvt_pk_bf16(v1[0], v1[1]); w.w = cvt_pk_bf16(v1[2], v1[3]);
                    *(u32x4*)(rowp + bj * HALF) = w; } }
    }
};
struct EpiSqRelu {
    static constexpr bool PERM = true, AFTER_DRAIN = false;
    bf16_t* O; int ldc; const float* ss;
    __device__ __forceinline__ void operator()(const f32x4 (&acc)[2][2][4][2], const Unit& u, int wr, int wc, int fr, int fq) const {
        const int row0 = u.pm * BM + wr * 64 + fr; const int col0 = u.pn * BM + wc * 32 + 8 * fq;
#pragma unroll
        for (int ai = 0; ai < 2; ++ai)
#pragma unroll
            for (int m = 0; m < 4; ++m) { const int r = row0 + ai * HALF + m * 16; bf16_t* rowp = O + (size_t)r * ldc + col0;
                const f32x4* sp = (const f32x4*)(ss + (size_t)r * 16); const f32x4 s0 = sp[0], s1 = sp[1], s2 = sp[2], s3 = sp[3];
                const float tot = ((s0[0] + s0[1]) + (s0[2] + s0[3])) + ((s1[0] + s1[1]) + (s1[2] + s1[3])) + ((s2[0] + s2[1]) + (s2[2] + s2[3])) + ((s3[0] + s3[1]) + (s3[2] + s3[3]));
                const float rstd = 1.0f / sqrtf(tot * (1.0f / 1024.0f) + 1e-6f);
#pragma unroll
                for (int bj = 0; bj < 2; ++bj) { f32x4 v0 = acc[ai][bj][m][0] * rstd, v1 = acc[ai][bj][m][1] * rstd;
#pragma unroll
                    for (int e = 0; e < 4; ++e) { const float a = fmaxf(v0[e], 0.f), b = fmaxf(v1[e], 0.f); v0[e] = a * a; v1[e] = b * b; }
                    u32x4 w; w.x = cvt_pk_bf16(v0[0], v0[1]); w.y = cvt_pk_bf16(v0[2], v0[3]); w.z = cvt_pk_bf16(v1[0], v1[1]); w.w = cvt_pk_bf16(v1[2], v1[3]);
                    *(u32x4*)(rowp + bj * HALF) = w; } }
    }
};
struct EpiResA {
    static constexpr bool PERM = true, AFTER_DRAIN = false;
    const float* base; bf16_t* ob; float* ss; int ldc;
    __device__ __forceinline__ void operator()(const f32x4 (&acc)[2][2][4][2], const Unit& u, int wr, int wc, int fr, int fq) const {
        const int row0 = u.pm * BM + wr * 64 + fr; const int col0 = u.pn * BM + wc * 32 + 8 * fq;
#pragma unroll
        for (int ai = 0; ai < 2; ++ai)
#pragma unroll
            for (int m = 0; m < 4; ++m) { const int r = row0 + ai * HALF + m * 16; const size_t off = (size_t)r * ldc + col0; float s = 0.f;
#pragma unroll
                for (int bj = 0; bj < 2; ++bj) { const f32x4 v0 = *(const f32x4*)(base + off + bj * HALF) + acc[ai][bj][m][0], v1 = *(const f32x4*)(base + off + bj * HALF + 4) + acc[ai][bj][m][1];
                    s += ((v0[0] * v0[0] + v0[1] * v0[1]) + (v0[2] * v0[2] + v0[3] * v0[3])) + ((v1[0] * v1[0] + v1[1] * v1[1]) + (v1[2] * v1[2] + v1[3] * v1[3]));
                    u32x4 w; w.x = cvt_pk_bf16(v0[0], v0[1]); w.y = cvt_pk_bf16(v0[2], v0[3]); w.z = cvt_pk_bf16(v1[0], v1[1]); w.w = cvt_pk_bf16(v1[2], v1[3]);
                    *(u32x4*)(ob + off + bj * HALF) = w; }
                s += __shfl_xor(s, 16); s += __shfl_xor(s, 32);
                if (fq == 0) ss[(size_t)r * 16 + u.pn * 4 + wc] = s; }
    }
};
struct EpiResB {
    static constexpr bool PERM = true, AFTER_DRAIN = false;
    const bf16_t* hb; float* out; float* ss; int ldc;
    __device__ __forceinline__ void operator()(const f32x4 (&acc)[2][2][4][2], const Unit& u, int wr, int wc, int fr, int fq) const {
        const int row0 = u.pm * BM + wr * 64 + fr; const int col0 = u.pn * BM + wc * 32 + 8 * fq;
#pragma unroll
        for (int ai = 0; ai < 2; ++ai)
#pragma unroll
            for (int m = 0; m < 4; ++m) { const int r = row0 + ai * HALF + m * 16; const size_t off = (size_t)r * ldc + col0; float s = 0.f;
#pragma unroll
                for (int bj = 0; bj < 2; ++bj) { const u32x4 rb = *(const u32x4*)(hb + off + bj * HALF);
                    f32x4 v0, v1; v0[0] = __uint_as_float(rb.x << 16); v0[1] = __uint_as_float(rb.x & 0xffff0000u); v0[2] = __uint_as_float(rb.y << 16); v0[3] = __uint_as_float(rb.y & 0xffff0000u);
                    v1[0] = __uint_as_float(rb.z << 16); v1[1] = __uint_as_float(rb.z & 0xffff0000u); v1[2] = __uint_as_float(rb.w << 16); v1[3] = __uint_as_float(rb.w & 0xffff0000u);
                    v0 += acc[ai][bj][m][0]; v1 += acc[ai][bj][m][1];
                    s += ((v0[0] * v0[0] + v0[1] * v0[1]) + (v0[2] * v0[2] + v0[3] * v0[3])) + ((v1[0] * v1[0] + v1[1] * v1[1]) + (v1[2] * v1[2] + v1[3] * v1[3]));
                    *(f32x4*)(out + off + bj * HALF) = v0; *(f32x4*)(out + off + bj * HALF + 4) = v1; }
                s += __shfl_xor(s, 16); s += __shfl_xor(s, 32);
                if (fq == 0) ss[(size_t)r * 16 + u.pn * 4 + wc] = s; }
    }
};
template <class Epi, class Sched, bool ALIGN_EPI = false, bool SP2 = false>
__device__ __forceinline__ void gemm_phase(PG8_LAS unsigned char* lds, const Gemm g, const Sched& S, const Epi& E) {
    const int tid = threadIdx.x, wid = __builtin_amdgcn_readfirstlane(tid >> 6), lane = tid & 63, wr = wid >> 2, wc = wid & 3, fr = lane & 15, fq = lane >> 4;
    const int K = g.K, nt = K / BK;
    unsigned voffA[2], voffB[2];
#pragma unroll
    for (int i = 0; i < 2; ++i) { int R, C; stage_rc(tid * 16 + i * 8192, R, C); const int Rb = Epi::PERM ? ((R & ~31) + perm32(R & 31)) : R;
        voffA[i] = (unsigned)(R * K + C) * 2u; voffB[i] = (unsigned)(Rb * K + C) * 2u; }
    const size_t kstep = (size_t)(BK * 2);
    const size_t hstep = (size_t)HALF * K * 2;
    const size_t tstep = 2 * hstep;
    const unsigned ldsw = (unsigned)wid * 1024u;
    const int aoff = lds_byte(wr * 64 + fr, fq * 8), boff = lds_byte(wc * 32 + fr, fq * 8);
#define PG8_SA(b, h) (((b) * 2 + (h)) * HTB)
#define PG8_SB(b, h) ((4 + (b) * 2 + (h)) * HTB)
#define PG8_STAGE(bufoff, gbase, voff) do { _Pragma("unroll") for (int _i = 0; _i < 2; ++_i) \
        __builtin_amdgcn_global_load_lds((const unsigned*)((const char*)(gbase) + (voff)[_i]), (PG8_LAS unsigned*)(lds + (bufoff) + ldsw + _i * 8192), 16, 0, 0); } while (0)
#define PG8_LDA(dst, b, h) do { _Pragma("unroll") for (int m = 0; m < 4; ++m) _Pragma("unroll") for (int k = 0; k < 2; ++k) dst[m][k] = *(const PG8_LAS bf16x8*)(lds + PG8_SA(b, h) + aoff + m * 2048 + k * 1024); } while (0)
#define PG8_LDB(dst, b, h) do { _Pragma("unroll") for (int n = 0; n < 2; ++n) _Pragma("unroll") for (int k = 0; k < 2; ++k) dst[n][k] = *(const PG8_LAS bf16x8*)(lds + PG8_SB(b, h) + boff + n * 2048 + k * 1024); } while (0)
#define PG8_MMA(ai, bj, At, Bt) do { __builtin_amdgcn_s_setprio(1); _Pragma("unroll") for (int m = 0; m < 4; ++m) _Pragma("unroll") for (int n = 0; n < 2; ++n) _Pragma("unroll") for (int k = 0; k < 2; ++k) \
        acc[ai][bj][m][n] = __builtin_amdgcn_mfma_f32_16x16x32_bf16(Bt[n][k], At[m][k], acc[ai][bj][m][n], 0, 0, 0); __builtin_amdgcn_s_setprio(0); } while (0)
#define PG8_WAIT_V(n) asm volatile("s_waitcnt vmcnt(" #n ")" ::: "memory")
#define PG8_WAIT_L(n) asm volatile("s_waitcnt lgkmcnt(" #n ")" ::: "memory")
#define PG8_BAR __builtin_amdgcn_s_barrier()
#define PG8_SCHED __builtin_amdgcn_sched_barrier(0)
    Unit cur, nxt; int ui = 0;
    if (!S.next(0, cur)) return;
    f32x4 acc[2][2][4][2];
#pragma unroll
    for (int a = 0; a < 2; ++a)
#pragma unroll
        for (int b = 0; b < 2; ++b)
#pragma unroll
            for (int m = 0; m < 4; ++m)
#pragma unroll
                for (int n = 0; n < 2; ++n) acc[a][b][m][n] = (f32x4){0.f, 0.f, 0.f, 0.f};
    bf16x8 At[4][2], B0[2][2], B1[2][2];
    const char* cA = (const char*)g.A + (size_t)cur.pm * tstep; const char* cB = (const char*)g.Bt + (size_t)cur.pn * tstep;
    S.a_ready(cur);
    if constexpr (SP2) {
        PG8_STAGE(PG8_SB(0, 0), cB, voffB); PG8_STAGE(PG8_SB(0, 1), cB + hstep, voffB); PG8_STAGE(PG8_SA(0, 0), cA, voffA); PG8_STAGE(PG8_SA(0, 1), cA + hstep, voffA);
        if (wr == 1) PG8_BAR;
        PG8_WAIT_V(2); PG8_BAR;
        PG8_STAGE(PG8_SB(1, 0), cB + kstep, voffB); PG8_STAGE(PG8_SA(1, 0), cA + kstep, voffA); PG8_STAGE(PG8_SB(1, 1), cB + hstep + kstep, voffB);
        PG8_WAIT_V(6); PG8_BAR;
    } else {
        PG8_STAGE(PG8_SB(0, 0), cB, voffB); PG8_STAGE(PG8_SA(0, 0), cA, voffA); PG8_STAGE(PG8_SB(0, 1), cB + hstep, voffB); PG8_STAGE(PG8_SA(0, 1), cA + hstep, voffA);
        if (wr == 1) PG8_BAR;
        PG8_WAIT_V(4); PG8_BAR;
        PG8_STAGE(PG8_SB(1, 0), cB + kstep, voffB); PG8_STAGE(PG8_SA(1, 0), cA + kstep, voffA); PG8_STAGE(PG8_SB(1, 1), cB + hstep + kstep, voffB);
        PG8_WAIT_V(6); PG8_BAR;
    }
    for (;;) {
        const bool has_next = S.next(ui + 1, nxt);
        const char* nA = has_next ? (const char*)g.A + (size_t)nxt.pm * tstep : cA; const char* nB = has_next ? (const char*)g.Bt + (size_t)nxt.pn * tstep : cB;
        for (int t = 0; t < nt; t += 2) {
            const bool last = (t == nt - 2);
            const char* a1 = cA + (size_t)(t + 1) * kstep;
            const char* a2 = last ? nA : cA + (size_t)(t + 2) * kstep; const char* b2 = last ? nB : cB + (size_t)(t + 2) * kstep;
            const char* a3 = a2 + kstep; const char* b3 = b2 + kstep;
            if (last && has_next) S.a_ready(nxt);
            if constexpr (SP2) {
            PG8_LDB(B0, 0, 0); PG8_LDB(B1, 0, 1); PG8_SCHED; PG8_LDA(At, 0, 0); PG8_STAGE(PG8_SA(1, 1), a1 + hstep, voffA);
            PG8_WAIT_V(8); PG8_WAIT_L(0); PG8_BAR; PG8_MMA(0, 0, At, B0); PG8_MMA(0, 1, At, B1); PG8_BAR; PG8_SCHED;
            PG8_LDA(At, 0, 1); PG8_STAGE(PG8_SB(0, 0), b2, voffB); PG8_STAGE(PG8_SB(0, 1), b2 + hstep, voffB); PG8_STAGE(PG8_SA(0, 0), a2, voffA);
            PG8_WAIT_V(8); PG8_WAIT_L(0); PG8_BAR; PG8_MMA(1, 0, At, B0); PG8_MMA(1, 1, At, B1); PG8_BAR; PG8_SCHED;
            PG8_LDB(B0, 1, 0); PG8_LDB(B1, 1, 1); PG8_SCHED; PG8_LDA(At, 1, 0); PG8_STAGE(PG8_SA(0, 1), a2 + hstep, voffA);
            PG8_WAIT_V(8); PG8_WAIT_L(0); PG8_BAR; PG8_MMA(0, 0, At, B0); PG8_MMA(0, 1, At, B1); PG8_BAR; PG8_SCHED;
            PG8_LDA(At, 1, 1); PG8_STAGE(PG8_SB(1, 0), b3, voffB); PG8_STAGE(PG8_SB(1, 1), b3 + hstep, voffB); PG8_STAGE(PG8_SA(1, 0), a3, voffA);
            PG8_WAIT_V(8); PG8_WAIT_L(0); PG8_BAR; PG8_MMA(1, 0, At, B0); PG8_MMA(1, 1, At, B1); PG8_BAR; PG8_SCHED;
            } else {
            PG8_LDB(B0, 0, 0); PG8_SCHED; PG8_LDA(At, 0, 0); PG8_STAGE(PG8_SA(1, 1), a1 + hstep, voffA);
            PG8_WAIT_L(8); PG8_BAR; PG8_WAIT_L(0); PG8_MMA(0, 0, At, B0); PG8_BAR; PG8_SCHED;
            PG8_LDB(B1, 0, 1); PG8_STAGE(PG8_SB(0, 0), b2, voffB);
            PG8_BAR; PG8_WAIT_L(0); PG8_MMA(0, 1, At, B1); PG8_BAR;
            PG8_LDA(At, 0, 1); PG8_STAGE(PG8_SA(0, 0), a2, voffA);
            PG8_BAR; PG8_WAIT_L(0); PG8_MMA(1, 0, At, B0); PG8_BAR; PG8_SCHED;
            PG8_STAGE(PG8_SB(0, 1), b2 + hstep, voffB);
            PG8_WAIT_V(6); PG8_BAR; PG8_MMA(1, 1, At, B1); PG8_BAR;
            PG8_LDB(B0, 1, 0); PG8_SCHED; PG8_LDA(At, 1, 0); PG8_STAGE(PG8_SA(0, 1), a2 + hstep, voffA);
            PG8_WAIT_L(8); PG8_BAR; PG8_WAIT_L(0); PG8_MMA(0, 0, At, B0); PG8_BAR; PG8_SCHED;
            PG8_LDB(B1, 1, 1); PG8_STAGE(PG8_SB(1, 0), b3, voffB);
            PG8_BAR; PG8_WAIT_L(0); PG8_MMA(0, 1, At, B1); PG8_BAR;
            PG8_LDA(At, 1, 1); PG8_STAGE(PG8_SA(1, 0), a3, voffA);
            PG8_BAR; PG8_WAIT_L(0); PG8_MMA(1, 0, At, B0); PG8_BAR; PG8_SCHED;
            PG8_STAGE(PG8_SB(1, 1), b3 + hstep, voffB);
            PG8_WAIT_V(6); PG8_BAR; PG8_MMA(1, 1, At, B1); PG8_BAR;
            }
        }
        if constexpr (ALIGN_EPI) { if (wr == 0) PG8_BAR; }
        if constexpr (!Epi::AFTER_DRAIN) { E(acc, cur, wr, wc, fr, fq); S.done(cur); }
        if (!has_next) break;
#pragma unroll
        for (int a = 0; a < 2; ++a)
#pragma unroll
            for (int b = 0; b < 2; ++b)
#pragma unroll
                for (int m = 0; m < 4; ++m)
#pragma unroll
                    for (int n = 0; n < 2; ++n) acc[a][b][m][n] = (f32x4){0.f, 0.f, 0.f, 0.f};
        cur = nxt; cA = nA; cB = nB; ++ui;
        if constexpr (ALIGN_EPI) { if (wr == 1) PG8_BAR; }
    }
    PG8_WAIT_V(0);
    if constexpr (!ALIGN_EPI) { if (wr == 0) PG8_BAR; }
    PG8_BAR;
    if constexpr (Epi::AFTER_DRAIN) { E.fused(acc, cur, wr, wc, fr, fq, lds, wid, lane); S.done(cur); }
#undef PG8_SA
#undef PG8_SB
#undef PG8_STAGE
#undef PG8_LDA
#undef PG8_LDB
#undef PG8_MMA
#undef PG8_WAIT_V
#undef PG8_WAIT_L
#undef PG8_BAR
#undef PG8_SCHED
}
}
#define GAS __attribute__((address_space(1)))
#define LAS __attribute__((address_space(3)))
typedef unsigned short bf16;
typedef unsigned v4u __attribute__((ext_vector_type(4)));
typedef unsigned v2u __attribute__((ext_vector_type(2)));
typedef float f32x4 __attribute__((ext_vector_type(4)));
typedef float f32x16 __attribute__((ext_vector_type(16)));
typedef short bf16x8 __attribute__((ext_vector_type(8)));
#define LDS_WAIT() asm volatile("s_waitcnt lgkmcnt(0)" ::: "memory")

#ifndef MK_N_LAUNCHES
#define MK_N_LAUNCHES 1
#endif
#ifndef MK_NAIVE_ATTN
#define MK_NAIVE_ATTN 0
#endif
constexpr int NWAVES = 8, NPH = 8;
constexpr int BATCH = 4, SEQ = 8192, D = 1024, NH = 12, HD = 64, AW = 768, GWD = 256, NG = 4, INW = 2816, FF = 4096, M = BATCH * SEQ, CHUNK = 128;
constexpr float EPS = 1e-6f;
constexpr size_t MiB = 1u << 20;
constexpr size_t WS_WIN = 2 * MiB, WS_WOUT = 8 * MiB, WS_W1 = 10 * MiB, WS_W2 = 18 * MiB, WS_SS1 = 26 * MiB, WS_SS2 = 28 * MiB, WS_LSE = 30 * MiB, WS_GM = 36 * MiB,
                 WS_XN = 64 * MiB, WS_PROJ = 128 * MiB, WS_OP = 304 * MiB, WS_H1B = 128 * MiB, WS_HID = 192 * MiB, WS_END = 448 * MiB;
static_assert(WS_WIN + (size_t)INW * D * 2 <= WS_WOUT && WS_LSE + (size_t)3 * M * NH * 4 <= WS_GM && WS_GM + (size_t)M * GWD * 2 <= WS_XN && WS_PROJ + (size_t)M * INW * 2 <= WS_OP && WS_OP + (size_t)3 * M * AW * 2 <= WS_END && WS_HID + (size_t)M * FF * 2 <= WS_END, "ws map");
constexpr int ATT_LDS_END = 147456, LDS_BYTES = ATT_LDS_END + 256;
constexpr size_t WS_CTL = 0, CTL_ZERO_BYTES = 65536;

__device__ __forceinline__ float bflo(unsigned u) { return __uint_as_float(u << 16); }
__device__ __forceinline__ float bfhi(unsigned u) { return __uint_as_float(u & 0xffff0000u); }
typedef float pk_f32x2 __attribute__((ext_vector_type(2)));
typedef __bf16 pk_bf16x2 __attribute__((ext_vector_type(2)));
__device__ __forceinline__ unsigned pk2(float lo, float hi) { pk_f32x2 v = {lo, hi}; pk_bf16x2 b = __builtin_convertvector(v, pk_bf16x2); return __builtin_bit_cast(unsigned, b); }
__device__ __forceinline__ float wave_sum(float v) {
#pragma unroll
    for (int o = 1; o < 64; o <<= 1) v += __shfl_xor(v, o);
    return v;
}
__device__ __forceinline__ float gelu_t(float x) { const float y = 0.7978845608028654f * (x + 0.044715f * x * x * x); return x / (1.0f + __expf(-2.0f * y)); }

__device__ __forceinline__ void p0_transpose_item(const float* W, int K, int N, bf16* WT, const float* gk, int qcols, float qscale, LAS float* scr, int item, int lane) {
    const int nblk = N / 32, kb = item / nblk, nb = item % nblk, k0 = 64 * kb, n0 = 32 * nb;
#pragma unroll 8
    for (int i = 0; i < 32; ++i) { const int kk = 2 * i + (lane >> 5); const float g = gk ? gk[k0 + kk] : 1.0f; scr[kk * 33 + (lane & 31)] = W[(size_t)(k0 + kk) * N + n0 + (lane & 31)] * g; }
    LDS_WAIT();
    const int c = lane & 7;
#pragma unroll
    for (int j = 0; j < 4; ++j) { const int n = (lane >> 3) + 8 * j; const LAS float* s = scr + (8 * c) * 33 + n; const float sc = (n0 + n < qcols) ? qscale : 1.0f;
        v4u o; o.x = pk2(s[0 * 33] * sc, s[1 * 33] * sc); o.y = pk2(s[2 * 33] * sc, s[3 * 33] * sc); o.z = pk2(s[4 * 33] * sc, s[5 * 33] * sc); o.w = pk2(s[6 * 33] * sc, s[7 * 33] * sc);
        *(v4u*)(WT + (size_t)(n0 + n) * K + k0 + 8 * c) = o; }
    LDS_WAIT();
}
__device__ __forceinline__ void rms_row_to_bf16(const float* xrow, bf16* orow, int lane) {
    const f32x4* xr = (const f32x4*)xrow + lane;
    f32x4 v[4]; float s = 0.f;
#pragma unroll
    for (int j = 0; j < 4; ++j) { v[j] = xr[64 * j]; s += (v[j].x * v[j].x + v[j].y * v[j].y) + (v[j].z * v[j].z + v[j].w * v[j].w); }
    const float rstd = 1.0f / sqrtf(wave_sum(s) * (1.0f / D) + EPS);
    v2u* o8 = (v2u*)orow + lane;
#pragma unroll
    for (int j = 0; j < 4; ++j) { v2u w; w.x = pk2(v[j].x * rstd, v[j].y * rstd); w.y = pk2(v[j].z * rstd, v[j].w * rstd); o8[64 * j] = w; }
}

typedef short gm_v4i16 __attribute__((ext_vector_type(4)));
__device__ __forceinline__ void gmlp_unit(LAS unsigned char* lds, const bf16* PROJ, const float* ln_g, const float* ln_b, const float* sgu_w, const float* sgu_b, bf16* GM, int unit, int tid) {
    const int g = unit & 3, n = (unit >> 2) & 63, b = unit >> 8;
    const size_t row0 = (size_t)b * SEQ + (size_t)n * CHUNK;
    const int wave = __builtin_amdgcn_readfirstlane(tid >> 6), lane = tid & 63, ql = lane & 31, h2 = lane >> 5, ti = wave >> 1, ci = wave & 1;
    const int tq = 32 * ti + ql;
    const float* wrow = sgu_w + ((size_t)g * CHUNK + tq) * CHUNK + 8 * h2;
    f32x4 wf[8][2];
#pragma unroll
    for (int ks = 0; ks < 8; ++ks) if (ks < 2 * (ti + 1)) { wf[ks][0] = *(const f32x4*)(wrow + 16 * ks); wf[ks][1] = *(const f32x4*)(wrow + 16 * ks + 4); }
    const bf16* up = PROJ + (row0 + tq) * INW + 2304 + g * 64 + 32 * ci + 4 * h2;
    v2u ur[4];
#pragma unroll
    for (int g4 = 0; g4 < 4; ++g4) ur[g4] = *(const v2u*)(up + 8 * g4);
    const float bs = sgu_b[g * CHUNK + tq];
    {
        const int t = tid >> 2, q = tid & 3;
        const bf16* zp = PROJ + (row0 + t) * INW + 2560 + g * 64 + 16 * q;
        const v4u r0 = *(const v4u*)zp, r1 = *(const v4u*)(zp + 8);
        float z[16];
        z[0] = bflo(r0.x); z[1] = bfhi(r0.x); z[2] = bflo(r0.y); z[3] = bfhi(r0.y); z[4] = bflo(r0.z); z[5] = bfhi(r0.z); z[6] = bflo(r0.w); z[7] = bfhi(r0.w);
        z[8] = bflo(r1.x); z[9] = bfhi(r1.x); z[10] = bflo(r1.y); z[11] = bfhi(r1.y); z[12] = bflo(r1.z); z[13] = bfhi(r1.z); z[14] = bflo(r1.w); z[15] = bfhi(r1.w);
        float s = 0.f;
#pragma unroll
        for (int e = 0; e < 16; ++e) { z[e] = gelu_t(z[e]); s += z[e]; }
        s += __shfl_xor(s, 1); s += __shfl_xor(s, 2);
        const float mean = s * (1.0f / 64.0f); float v = 0.f;
#pragma unroll
        for (int e = 0; e < 16; ++e) { z[e] -= mean; v += z[e] * z[e]; }
        v += __shfl_xor(v, 1); v += __shfl_xor(v, 2);
        const float rstd = 1.0f / sqrtf(v * (1.0f / 64.0f) + EPS);
        const float* lg = ln_g + g * 64 + 16 * q; const float* lb = ln_b + g * 64 + 16 * q;
#pragma unroll
        for (int e = 0; e < 16; ++e) z[e] = z[e] * rstd * lg[e] + lb[e];
        v4u w0, w1; w0.x = pk2(z[0], z[1]); w0.y = pk2(z[2], z[3]); w0.z = pk2(z[4], z[5]); w0.w = pk2(z[6], z[7]); w1.x = pk2(z[8], z[9]); w1.y = pk2(z[10], z[11]); w1.z = pk2(z[12], z[13]); w1.w = pk2(z[14], z[15]);
        *(LAS v4u*)(lds + t * 192 + q * 32) = w0; *(LAS v4u*)(lds + t * 192 + q * 32 + 16) = w1;
    }
    __syncthreads();
    f32x16 acc;
#pragma unroll
    for (int e = 0; e < 16; ++e) acc[e] = 0.f;
    const LAS unsigned char* zrd = lds + (8 * h2 + ((lane & 15) >> 2)) * 192 + (32 * ci + ((lane >> 4) & 1) * 16 + (lane & 3) * 4) * 2;
#pragma unroll
    for (int ks = 0; ks < 8; ++ks) if (ks < 2 * (ti + 1)) {
        float w[8];
#pragma unroll
        for (int e = 0; e < 4; ++e) { w[e] = wf[ks][0][e]; w[4 + e] = wf[ks][1][e]; }
#pragma unroll
        for (int e = 0; e < 8; ++e) w[e] = (16 * ks + 8 * h2 + e <= tq) ? w[e] : 0.f;
        v4u bw; bw.x = pk2(w[0], w[1]); bw.y = pk2(w[2], w[3]); bw.z = pk2(w[4], w[5]); bw.w = pk2(w[6], w[7]);
        const bf16x8 bfr = __builtin_bit_cast(bf16x8, bw);
        const gm_v4i16 a0 = __builtin_amdgcn_ds_read_tr16_b64_v4i16((LAS gm_v4i16*)(zrd + (16 * ks) * 192)), a1 = __builtin_amdgcn_ds_read_tr16_b64_v4i16((LAS gm_v4i16*)(zrd + (16 * ks + 4) * 192));
        const bf16x8 afr = {a0[0], a0[1], a0[2], a0[3], a1[0], a1[1], a1[2], a1[3]};
        acc = __builtin_amdgcn_mfma_f32_32x32x16_bf16(afr, bfr, acc, 0, 0, 0);
    }
    bf16* gp = GM + (row0 + tq) * GWD + g * 64 + 32 * ci + 4 * h2;
#pragma unroll
    for (int g4 = 0; g4 < 4; ++g4) {
        const float u0 = gelu_t(bflo(ur[g4].x)) * (acc[4 * g4] + bs), u1 = gelu_t(bfhi(ur[g4].x)) * (acc[4 * g4 + 1] + bs), u2 = gelu_t(bflo(ur[g4].y)) * (acc[4 * g4 + 2] + bs), u3 = gelu_t(bfhi(ur[g4].y)) * (acc[4 * g4 + 3] + bs);
        v2u o; o.x = pk2(u0, u1); o.y = pk2(u2, u3); *(v2u*)(gp + 8 * g4) = o;
    }
    __syncthreads();
}

__device__ __forceinline__ float alibi_slope(int h) { return (h < 8) ? exp2f(-(float)(h + 1)) : exp2f(-0.5f - (float)(h - 8)); }

#if MK_NAIVE_ATTN
__device__ __forceinline__ void attn_naive(const bf16* PROJ, bf16* OP, float* LSE, int gtid, int nthreads) {
#pragma unroll 1
    for (int it = gtid; it < M * NH * 3; it += nthreads) {
        const int h = it % NH, row = (it / NH) % M, p = it / (NH * M), dil = 1 << (2 * p), t = row % SEQ;
        const float slope = alibi_slope(h);
        const bf16* qp = PROJ + (size_t)row * INW + h * 64;
        float q[64], o[64];
#pragma unroll
        for (int c = 0; c < 8; ++c) { const v4u r = *(const v4u*)(qp + 8 * c); q[8*c] = bflo(r.x); q[8*c+1] = bfhi(r.x); q[8*c+2] = bflo(r.y); q[8*c+3] = bfhi(r.y); q[8*c+4] = bflo(r.z); q[8*c+5] = bfhi(r.z); q[8*c+6] = bflo(r.w); q[8*c+7] = bfhi(r.w); }
#pragma unroll
        for (int e = 0; e < 64; ++e) o[e] = 0.f;
        float m = -1e30f, l = 0.f;
#pragma unroll 1
        for (int j = 0; j <= 128; ++j) {
            const int tk = t - dil * j; if (tk < 0) break;
            const bf16* kp = qp + 768 - (size_t)(dil * j) * INW; const bf16* vp = kp + 768;
            float dot = 0.f;
#pragma unroll
            for (int c = 0; c < 8; ++c) { const v4u r = *(const v4u*)(kp + 8 * c);
                dot += q[8*c] * bflo(r.x) + q[8*c+1] * bfhi(r.x) + q[8*c+2] * bflo(r.y) + q[8*c+3] * bfhi(r.y) + q[8*c+4] * bflo(r.z) + q[8*c+5] * bfhi(r.z) + q[8*c+6] * bflo(r.w) + q[8*c+7] * bfhi(r.w); }
            const float s = dot - slope * (float)(dil * j);
            const float mn = fmaxf(m, s), sc = __expf(m - mn), pe = __expf(s - mn);
            l = l * sc + pe; m = mn;
#pragma unroll
            for (int c = 0; c < 8; ++c) { const v4u r = *(const v4u*)(vp + 8 * c);
                o[8*c] = o[8*c] * sc + pe * bflo(r.x); o[8*c+1] = o[8*c+1] * sc + pe * bfhi(r.x); o[8*c+2] = o[8*c+2] * sc + pe * bflo(r.y); o[8*c+3] = o[8*c+3] * sc + pe * bfhi(r.y);
                o[8*c+4] = o[8*c+4] * sc + pe * bflo(r.z); o[8*c+5] = o[8*c+5] * sc + pe * bfhi(r.z); o[8*c+6] = o[8*c+6] * sc + pe * bflo(r.w); o[8*c+7] = o[8*c+7] * sc + pe * bfhi(r.w); }
        }
        const float il = 1.0f / l;
        bf16* op = OP + ((size_t)p * M + row) * AW + h * 64;
#pragma unroll
        for (int c = 0; c < 8; ++c) { v4u w; w.x = pk2(o[8*c] * il, o[8*c+1] * il); w.y = pk2(o[8*c+2] * il, o[8*c+3] * il); w.z = pk2(o[8*c+4] * il, o[8*c+5] * il); w.w = pk2(o[8*c+6] * il, o[8*c+7] * il); *(v4u*)(op + 8 * c) = w; }
        LSE[((size_t)p * M + row) * NH + h] = m + __logf(l);
    }
}
#endif

__device__ __forceinline__ void mixnorm_row(const bf16* OP, const float* LSE, const bf16* GM, bf16* MIXED, int row, int lane) {
    float a[3][4]; float ssa = 0.f;
#pragma unroll
    for (int j = 0; j < 3; ++j) {
        const int c = 256 * j + 4 * lane, head = c >> 6;
        float ls[3];
#pragma unroll
        for (int p = 0; p < 3; ++p) ls[p] = LSE[((size_t)p * M + row) * NH + head];
        const float mx = fmaxf(ls[0], fmaxf(ls[1], ls[2]));
        float w[3]; float wsum = 0.f;
#pragma unroll
        for (int p = 0; p < 3; ++p) { w[p] = __expf(ls[p] - mx); wsum += w[p]; }
        const float iw = 1.0f / wsum;
#pragma unroll
        for (int e = 0; e < 4; ++e) a[j][e] = 0.f;
#pragma unroll
        for (int p = 0; p < 3; ++p) { const v2u r = *(const v2u*)(OP + ((size_t)p * M + row) * AW + c); const float wp = w[p] * iw;
            a[j][0] += wp * bflo(r.x); a[j][1] += wp * bfhi(r.x); a[j][2] += wp * bflo(r.y); a[j][3] += wp * bfhi(r.y); }
#pragma unroll
        for (int e = 0; e < 4; ++e) ssa += a[j][e] * a[j][e];
    }
    const v2u gr = *(const v2u*)(GM + (size_t)row * GWD + 4 * lane);
    float gv[4]; gv[0] = bflo(gr.x); gv[1] = bfhi(gr.x); gv[2] = bflo(gr.y); gv[3] = bfhi(gr.y);
    float ssg = (gv[0] * gv[0] + gv[1] * gv[1]) + (gv[2] * gv[2] + gv[3] * gv[3]);
    const float ra = 1.0f / sqrtf(wave_sum(ssa) * (1.0f / AW) + EPS), rg = 1.0f / sqrtf(wave_sum(ssg) * (1.0f / GWD) + EPS);
    bf16* mp = MIXED + (size_t)row * D;
#pragma unroll
    for (int j = 0; j < 3; ++j) { v2u w; w.x = pk2(a[j][0] * ra, a[j][1] * ra); w.y = pk2(a[j][2] * ra, a[j][3] * ra); *(v2u*)(mp + 256 * j + 4 * lane) = w; }
    { v2u w; w.x = pk2(gv[0] * rg, gv[1] * rg); w.y = pk2(gv[2] * rg, gv[3] * rg); *(v2u*)(mp + AW + 4 * lane) = w; }
}
#if !MK_NAIVE_ATTN
typedef short v4i16_t __attribute__((ext_vector_type(4)));
typedef float f32x2_t __attribute__((ext_vector_type(2)));
typedef __bf16 bf16x2_t __attribute__((ext_vector_type(2)));
__device__ __forceinline__ unsigned cvtpk_s(float lo, float hi) { f32x2_t v = {lo, hi}; bf16x2_t b = __builtin_convertvector(v, bf16x2_t); return __builtin_bit_cast(unsigned, b); }
__device__ __forceinline__ v4i16_t vtr(const LAS unsigned char* p) { return __builtin_amdgcn_ds_read_tr16_b64_v4i16((LAS v4i16_t*)p); }
__device__ __forceinline__ float xhalf_max(float v) { auto rr = __builtin_amdgcn_permlane32_swap(__float_as_uint(v), __float_as_uint(v), false, false); return fmaxf(__uint_as_float(rr[0]), __uint_as_float(rr[1])); }
__device__ __forceinline__ float xhalf_sum(float v) { auto rr = __builtin_amdgcn_permlane32_swap(__float_as_uint(v), __float_as_uint(v), false, false); return __uint_as_float(rr[0]) + __uint_as_float(rr[1]); }
constexpr int ATT_KS = 144, ATT_VS = 192, ATT_KROWS = 384, ATT_VOFF = ATT_KROWS * ATT_KS, ATT_OOFF = ATT_VOFF + ATT_KROWS * ATT_VS, ATT_OS = 72;
static_assert(ATT_OOFF + NWAVES * 32 * ATT_OS <= ATT_LDS_END, "attention LDS map");
constexpr int ATT_NU = BATCH * NH * 96;

struct AttUnit { int p, h, dil, i0w; size_t rowb; };
__device__ __forceinline__ AttUnit att_decode(int u) {
    AttUnit a; const int bh = u / 96, rem = u - bh * 96, b = bh / NH; a.h = bh - b * NH; a.p = rem >> 5; const int sub = rem & 31, dsh = 2 * a.p; a.dil = 1 << dsh;
    const int nblk = 32 >> dsh, r = sub / nblk, blk = sub - r * nblk; a.i0w = 256 * blk; a.rowb = (size_t)b * SEQ + r; return a;
}

__device__ __forceinline__ void attn_phase(LAS unsigned char* lds, const bf16* PROJ, bf16* OP, float* LSE, int vcu, int G, int wave, int lane, int tid) {
    constexpr float LOG2E = 1.4426950408889634f, LN2 = 0.6931471805599453f;
    const int ql = lane & 31, h2 = lane >> 5;
    LAS unsigned char* KL = lds; LAS unsigned char* VL = lds + ATT_VOFF; LAS unsigned char* OL = lds + ATT_OOFF + wave * (32 * ATT_OS);
    const LAS unsigned char* krd = KL + (32 * wave + ql) * ATT_KS + 16 * h2;
    const LAS unsigned char* vrd = VL + (32 * wave + 4 * h2 + ((lane & 15) >> 2)) * ATT_VS + (((lane >> 4) & 1) * 16 + (lane & 3) * 4) * 2;
    v4u kreg[6], vreg[6]; bf16x8 qn[4];
#define ATT_LOAD(u_) do { const AttUnit a_ = att_decode(u_); const bf16* base_ = PROJ + a_.h * 64; \
        _Pragma("unroll") for (int j = 0; j < 6; ++j) { const int c_ = tid + 512 * j; int di_ = a_.i0w - 128 + (c_ >> 3); di_ = di_ < 0 ? 0 : di_; \
            const bf16* kp_ = base_ + AW + (a_.rowb + (size_t)di_ * a_.dil) * INW + (c_ & 7) * 8; kreg[j] = *(const v4u*)kp_; vreg[j] = *(const v4u*)(kp_ + AW); } \
        const bf16* qp_ = base_ + (a_.rowb + (size_t)(a_.i0w + 32 * wave + ql) * a_.dil) * INW + 8 * h2; \
        _Pragma("unroll") for (int s = 0; s < 4; ++s) qn[s] = *(const bf16x8*)(qp_ + 16 * s); } while (0)
    int u = vcu;
    if (u < ATT_NU) ATT_LOAD(u);
#pragma unroll 1
    for (; u < ATT_NU; u += G) {
        asm volatile("" ::: "memory"); __builtin_amdgcn_s_barrier(); asm volatile("" ::: "memory");
#pragma unroll
        for (int j = 0; j < 6; ++j) { const int c = tid + 512 * j; *(LAS v4u*)(KL + (c >> 3) * ATT_KS + (c & 7) * 16) = kreg[j]; *(LAS v4u*)(VL + (c >> 3) * ATT_VS + (c & 7) * 16) = vreg[j]; }
        bf16x8 qf[4];
#pragma unroll
        for (int s = 0; s < 4; ++s) qf[s] = qn[s];
        asm volatile("s_waitcnt lgkmcnt(0)" ::: "memory"); __builtin_amdgcn_s_barrier(); asm volatile("" ::: "memory");
        const AttUnit au = att_decode(u);
        if (u + G < ATT_NU) ATT_LOAD(u + G);
        const int i0 = au.i0w + 32 * wave, dil = au.dil;
        const float c2 = alibi_slope(au.h) * (float)dil * LOG2E;
        f32x16 o0, o1, bias;
#pragma unroll
        for (int e = 0; e < 16; ++e) { o0[e] = 0.f; o1[e] = 0.f; bias[e] = c2 * (float)((e & 3) + 8 * (e >> 2) + 4 * h2 - ql); }
        float m = -1e30f, l = 0.f;
#pragma unroll
        for (int kk = 0; kk < 5; ++kk) {
            const int kt = 4 - kk;
            const int k0 = i0 - 128 + 32 * kt;
            if (k0 >= 0) {
                f32x16 sa = bias;
#pragma unroll
                for (int s = 0; s < 4; ++s) { const bf16x8 kc = *(const LAS bf16x8*)(krd + (32 * kt) * ATT_KS + 32 * s); sa = __builtin_amdgcn_mfma_f32_32x32x16_bf16(kc, qf[s], sa, 0, 0, 0); }
                float mx = -INFINITY;
#pragma unroll
                for (int e = 0; e < 16; ++e) { const int kr = (e & 3) + 8 * (e >> 2);
                    if (kt == 0) sa[e] = (kr + 4 * h2 >= ql) ? sa[e] : -INFINITY;
                    if (kt == 4) sa[e] = (kr + 4 * h2 <= ql) ? sa[e] : -INFINITY;
                    mx = fmaxf(mx, sa[e]); }
                mx = xhalf_max(mx);
                const float delta = c2 * (float)(128 - 32 * kt);
                if (kt == 4) m = mx;
                else {
                    const float mxt = mx - delta; const bool need = mxt > m + 8.0f;
                    if (__builtin_amdgcn_ballot_w64(need) != 0ull) {
                        const float mn = need ? mxt : m, alpha = __builtin_amdgcn_exp2f(m - mn); m = mn; l *= alpha;
#pragma unroll
                        for (int e = 0; e < 16; ++e) { o0[e] *= alpha; o1[e] *= alpha; }
                    }
                }
                const float msub = m + delta;
                float ls = 0.f;
#pragma unroll
                for (int e = 0; e < 16; ++e) { sa[e] = __builtin_amdgcn_exp2f(sa[e] - msub); ls += sa[e]; }
                l += ls;
#pragma unroll
                for (int s2 = 0; s2 < 2; ++s2) {
                    v4u pw; pw.x = cvtpk_s(sa[8 * s2], sa[8 * s2 + 1]); pw.y = cvtpk_s(sa[8 * s2 + 2], sa[8 * s2 + 3]); pw.z = cvtpk_s(sa[8 * s2 + 4], sa[8 * s2 + 5]); pw.w = cvtpk_s(sa[8 * s2 + 6], sa[8 * s2 + 7]);
                    const bf16x8 pb = __builtin_bit_cast(bf16x8, pw);
                    const LAS unsigned char* vb = vrd + (32 * kt + 16 * s2) * ATT_VS;
                    { const v4i16_t a = vtr(vb), c = vtr(vb + 8 * ATT_VS);
                      const bf16x8 vf = {a[0], a[1], a[2], a[3], c[0], c[1], c[2], c[3]};
                      o0 = __builtin_amdgcn_mfma_f32_32x32x16_bf16(vf, pb, o0, 0, 0, 0); }
                    { const v4i16_t a = vtr(vb + 64), c = vtr(vb + 8 * ATT_VS + 64);
                      const bf16x8 vf = {a[0], a[1], a[2], a[3], c[0], c[1], c[2], c[3]};
                      o1 = __builtin_amdgcn_mfma_f32_32x32x16_bf16(vf, pb, o1, 0, 0, 0); }
                }
            }
        }
        const float lt = xhalf_sum(l), il = 1.0f / lt;
        if (h2 == 0) LSE[((size_t)au.p * M + au.rowb + (size_t)(i0 + ql) * dil) * NH + au.h] = (m + __log2f(lt)) * LN2;
        bf16* og = OP + ((size_t)au.p * M + au.rowb + (size_t)(i0 + (lane >> 1)) * dil) * AW + au.h * 64 + 16 * (lane & 1);
        LAS unsigned char* ow = OL + ql * ATT_OS + 8 * h2;
        const LAS unsigned char* orr = OL + (lane >> 1) * ATT_OS + 32 * (lane & 1);
#pragma unroll
        for (int dt = 0; dt < 2; ++dt) {
#pragma unroll
            for (int g4 = 0; g4 < 4; ++g4) { v2u w;
                if (dt == 0) { w.x = cvtpk_s(o0[4 * g4] * il, o0[4 * g4 + 1] * il); w.y = cvtpk_s(o0[4 * g4 + 2] * il, o0[4 * g4 + 3] * il); }
                else { w.x = cvtpk_s(o1[4 * g4] * il, o1[4 * g4 + 1] * il); w.y = cvtpk_s(o1[4 * g4 + 2] * il, o1[4 * g4 + 3] * il); }
                *(LAS v2u*)(ow + 16 * g4) = w; }
            const v2u r0 = *(const LAS v2u*)(orr), r1 = *(const LAS v2u*)(orr + 8), r2 = *(const LAS v2u*)(orr + 16), r3 = *(const LAS v2u*)(orr + 24);
            v4u s0; s0.x = r0.x; s0.y = r0.y; s0.z = r1.x; s0.w = r1.y; v4u s1; s1.x = r2.x; s1.y = r2.y; s1.z = r3.x; s1.w = r3.y;
            *(v4u*)(og + 32 * dt) = s0; *(v4u*)(og + 32 * dt + 8) = s1;
        }
    }
#undef ATT_LOAD
    asm volatile("" ::: "memory"); __builtin_amdgcn_s_barrier(); asm volatile("" ::: "memory");
}
#endif
#define XB_TMO      128
#define XB_XCNT(j)  (256  + 64 * (j))
#define XB_XSUB(j)  (1280 + 64 * (j))
#define XB_XGEN(j)  (2304 + 64 * (j))
#define XB_TOP      3328
#define XB_TOPGEN   3392
#define XCD_BAR_WORDS 3456
#define XB_SPIN_CAP (1u << 18)

__device__ __forceinline__ unsigned xb_ld(unsigned* p)              { return __hip_atomic_load(p, __ATOMIC_RELAXED, __HIP_MEMORY_SCOPE_AGENT); }
__device__ __forceinline__ unsigned xb_add(unsigned* p, unsigned v) { return __hip_atomic_fetch_add(p, v, __ATOMIC_RELAXED, __HIP_MEMORY_SCOPE_AGENT); }
__device__ __forceinline__ unsigned xb_xcc_id() { return (unsigned)__builtin_amdgcn_s_getreg((3 << 11) | 20) & 0xFu; }
#define XB_SPIN(cond, bar) do { unsigned _sp = 0; while (cond) { __builtin_amdgcn_s_sleep(1); \
    if ((++_sp & 255u) == 0u) { if (xb_ld(&(bar)[XB_TMO])) break; if (_sp > XB_SPIN_CAP) { atomicAdd(&(bar)[XB_TMO], 1u); break; } } } } while (0)

struct XcdBarrier {
    unsigned* bar; unsigned x;
    volatile LAS unsigned* st;
};

__device__ __forceinline__ XcdBarrier xcd_barrier_post(unsigned* bar, volatile LAS unsigned* st) {
    XcdBarrier b; b.bar = bar; b.x = xb_xcc_id(); b.st = st;
    if (threadIdx.x == 0) (void)xb_add(&bar[XB_XCNT(b.x)], 1u);
    return b;
}
__device__ __forceinline__ void xcd_barrier_complete(unsigned* bar, unsigned x, unsigned& nloc, unsigned& nx) {
    const unsigned G = gridDim.x * gridDim.y * gridDim.z;
    unsigned sum, cnt, mine, sp = 0u;
    for (;;) {
        sum = 0u; cnt = 0u; mine = 0u;
#pragma unroll
        for (unsigned j = 0; j < 16; ++j) { const unsigned c = xb_ld(&bar[XB_XCNT(j)]); sum += c; cnt += (c > 0u) ? 1u : 0u; mine = (j == x) ? c : mine; }
        if (sum == G) break;
        __builtin_amdgcn_s_sleep(1);
        if ((++sp & 255u) == 0u) { if (xb_ld(&bar[XB_TMO])) break; if (sp > XB_SPIN_CAP) { atomicAdd(&bar[XB_TMO], 1u); break; } }
    }
    nloc = mine > 0u ? mine : 1u; nx = cnt > 0u ? cnt : 1u;
}

__device__ __forceinline__ void xcd_barrier(const XcdBarrier& b) {
    asm volatile("s_waitcnt vmcnt(0)" ::: "memory");
    __syncthreads();
    if (threadIdx.x == 0) {
        unsigned* bar = b.bar;
        __builtin_amdgcn_s_waitcnt(0);
        unsigned nloc = b.st[0], nx = b.st[1];
        if (nloc == 0u) { xcd_barrier_complete(bar, b.x, nloc, nx); b.st[0] = nloc; b.st[1] = nx; }
        const unsigned old = xb_add(&bar[XB_XSUB(b.x)], 1u);
        const unsigned gen = old / nloc;
        if (old + 1u == (gen + 1u) * nloc) {
            __builtin_amdgcn_fence(__ATOMIC_RELEASE, "agent");
            asm volatile("s_waitcnt vmcnt(0)" ::: "memory");
            const unsigned og = xb_add(&bar[XB_TOP], 1u);
            const unsigned tg = og / nx;
            if (og + 1u == (tg + 1u) * nx) xb_add(&bar[XB_TOPGEN], 1u);
            else XB_SPIN(xb_ld(&bar[XB_TOPGEN]) == tg, bar);
            __builtin_amdgcn_fence(__ATOMIC_ACQUIRE, "agent");
            xb_add(&bar[XB_XGEN(b.x)], 1u);
            asm volatile("s_waitcnt vmcnt(0)" ::: "memory");
        } else {
            XB_SPIN(xb_ld(&bar[XB_XGEN(b.x)]) == gen, bar);
            __builtin_amdgcn_fence(__ATOMIC_ACQUIRE, "agent");
            asm volatile("s_waitcnt vmcnt(0)" ::: "memory");
        }
    }
    __syncthreads();
}

struct Args { const float* in[14]; float* out; unsigned char* ws; int ph_lo, ph_hi; };
__global__ void __launch_bounds__(NWAVES * 64, 2) hymba_fwd(Args args) {
    extern __shared__ __attribute__((aligned(16))) unsigned char lds_raw[];
    LAS unsigned char* lds = (LAS unsigned char*)lds_raw;
    cg::grid_group grid = cg::this_grid();
    const int tid = threadIdx.x, lane = tid & 63, wave = __builtin_amdgcn_readfirstlane(tid >> 6);
    const int G = gridDim.x, bx = blockIdx.x;
    const int vcu = (G % 8 == 0) ? (bx % 8) * (G / 8) + bx / 8 : bx;
    const int gw = vcu * NWAVES + wave, NGW = G * NWAVES;
    unsigned char* ws = args.ws;
    const float* x = args.in[0]; const float* norm1_g = args.in[1]; const float* w_in = args.in[2]; const float* sgu_ln_g = args.in[3]; const float* sgu_ln_b = args.in[4];
    const float* sgu_w = args.in[5]; const float* sgu_b = args.in[6]; const float* attn_out_g = args.in[7]; const float* gmlp_out_g = args.in[8]; const float* w_out = args.in[9];
    const float* norm2_g = args.in[10]; const float* w_ff1 = args.in[11]; const float* w_ff2 = args.in[12]; const float* final_g = args.in[13];
    float* out = args.out;
    bf16* WIN = (bf16*)(ws + WS_WIN); bf16* WOUT = (bf16*)(ws + WS_WOUT); bf16* W1 = (bf16*)(ws + WS_W1); bf16* W2 = (bf16*)(ws + WS_W2);
    float* SS1 = (float*)(ws + WS_SS1); float* SS2 = (float*)(ws + WS_SS2); float* LSE = (float*)(ws + WS_LSE);
    bf16* GM = (bf16*)(ws + WS_GM); bf16* XN = (bf16*)(ws + WS_XN); bf16* PROJ = (bf16*)(ws + WS_PROJ); bf16* OP = (bf16*)(ws + WS_OP);
    bf16* H1B = (bf16*)(ws + WS_H1B); bf16* HID = (bf16*)(ws + WS_HID);
    const int lo = args.ph_lo, hi = args.ph_hi;
    volatile LAS unsigned* MISC = (volatile LAS unsigned*)(lds + ATT_LDS_END);
    if (tid < 16) MISC[tid] = 0u;
    __syncthreads();
    XcdBarrier bar = xcd_barrier_post((unsigned*)(ws + WS_CTL), MISC + 8);
    if (lo < 0) grid.sync();
#define IN(k) (lo <= (k) && (k) < hi)
#define SEAM(k) do { if (IN(k) && IN((k) + 1)) xcd_barrier(bar); } while (0)
#define REPS(k) for (int rep_ = 0; rep_ < ((MK_DBL == (k)) ? 2 : 1); ++rep_)
#define REPSYNC() do { if (rep_) xcd_barrier(bar); } while (0)

    if (IN(0)) REPS(0) { REPSYNC();
        LAS float* scr = (LAS float*)(lds + wave * 16384);
        constexpr int I_IN = (D / 64) * (INW / 32), I_O = (D / 64) * (D / 32), I_1 = (D / 64) * (FF / 32), I_2 = (FF / 64) * (D / 32);
        constexpr int NITEMS = I_IN + I_O + I_1 + I_2;
#pragma unroll 1
        for (int it = gw; it < NITEMS; it += NGW) {
            int r = it;
            if (r < I_IN) { p0_transpose_item(w_in, D, INW, WIN, norm1_g, AW, MK_NAIVE_ATTN ? 0.125f : 0.125f * 1.4426950408889634f, scr, r, lane); continue; } r -= I_IN;
            if (r < I_O) { p0_transpose_item(w_out, D, D, WOUT, (r / (D / 32)) < (AW / 64) ? attn_out_g : gmlp_out_g - AW, 0, 1.0f, scr, r, lane); continue; } r -= I_O;
            if (r < I_1) { p0_transpose_item(w_ff1, D, FF, W1, norm2_g, 0, 1.0f, scr, r, lane); continue; } r -= I_1;
            p0_transpose_item(w_ff2, FF, D, W2, nullptr, 0, 1.0f, scr, r, lane);
        }
#pragma unroll 1
        for (int m = gw; m < M; m += NGW) rms_row_to_bf16(x + (size_t)m * D, XN + (size_t)m * D, lane);
    }
    SEAM(0);
    if (IN(1)) REPS(1) { REPSYNC();
        pg8::Gemm g{XN, WIN, M, INW, D}; pg8::StaticOrder S; S.init(M, INW, G, bx);
        pg8::EpiBf16 E{PROJ, INW};
        pg8::gemm_phase<pg8::EpiBf16, pg8::StaticOrder, true, true>(lds, g, S, E);
    }
    SEAM(1);
    if (IN(2)) REPS(2) { REPSYNC();
        for (int rg_ = 0; rg_ < (MK_DBL == 20 ? 2 : 1); ++rg_)
#pragma unroll 1
        for (int u = vcu; u < BATCH * (SEQ / CHUNK) * NG; u += G) gmlp_unit(lds, PROJ, sgu_ln_g, sgu_ln_b, sgu_w, sgu_b, GM, u, tid);
#if MK_NAIVE_ATTN
        attn_naive(PROJ, OP, LSE, bx * (NWAVES * 64) + tid, G * NWAVES * 64);
#else
        for (int ra_ = 0; ra_ < (MK_DBL == 21 ? 2 : 1); ++ra_) attn_phase(lds, PROJ, OP, LSE, vcu, G, wave, lane, tid);
#endif
    }
    SEAM(2);
    if (IN(3)) REPS(3) { REPSYNC();
#pragma unroll 1
        for (int m = gw; m < M; m += NGW) mixnorm_row(OP, LSE, GM, XN, m, lane);
    }
    SEAM(3);
    if (IN(4)) REPS(4) { REPSYNC();
        pg8::Gemm g{XN, WOUT, M, D, D}; pg8::StaticOrder S; S.init(M, D, G, bx);
        pg8::EpiResA E{x, H1B, SS1, D};
        pg8::gemm_phase<pg8::EpiResA, pg8::StaticOrder, true, true>(lds, g, S, E);
    }
    SEAM(4);
    if (IN(5)) REPS(5) { REPSYNC();
        pg8::Gemm g{H1B, W1, M, FF, D}; pg8::StaticOrder S; S.init(M, FF, G, bx);
        pg8::EpiSqRelu E{HID, FF, SS1};
        pg8::gemm_phase<pg8::EpiSqRelu, pg8::StaticOrder, true, true>(lds, g, S, E);
    }
    SEAM(5);
    if (IN(6)) REPS(6) { REPSYNC();
        pg8::Gemm g{HID, W2, M, D, FF}; pg8::StaticOrder S; S.init(M, D, G, bx);
        pg8::EpiResB E{H1B, out, SS2, D};
        pg8::gemm_phase<pg8::EpiResB, pg8::StaticOrder, true, true>(lds, g, S, E);
    }
    SEAM(6);
    if (IN(7)) REPS(7) { REPSYNC();
#pragma unroll 1
        for (int m = gw; m < M; m += NGW) {
            f32x4* orow = (f32x4*)(out + (size_t)m * D) + lane;
            float s = SS2[(size_t)m * 16 + (lane & 15)];
            s += __shfl_xor(s, 1); s += __shfl_xor(s, 2); s += __shfl_xor(s, 4); s += __shfl_xor(s, 8);
            const float rstd = 1.0f / sqrtf(s * (1.0f / D) + EPS);
#pragma unroll
            for (int j = 0; j < 4; ++j) { const f32x4 v = orow[64 * j]; const f32x4 gq = *((const f32x4*)final_g + lane + 64 * j); orow[64 * j] = v * rstd * gq; }
        }
    }
#undef IN
#undef SEAM
}

extern "C" void kernel_launch(void* const* d_in, const int* in_sizes, int n_in, void* d_out, int out_size, void* d_ws, size_t ws_size, hipStream_t stream) {
    static int grid = 0;
    if (grid == 0) {
        if (n_in != 14 || in_sizes[0] != M * D || out_size != M * D || ws_size < WS_END) { fprintf(stderr, "kernel_launch: unexpected shapes (n_in %d, in0 %d, out %d, ws %zu); nothing launched\n", n_in, n_in > 0 ? in_sizes[0] : -1, out_size, ws_size); grid = -1; return; }
        int dev = 0, cus = 0, per_cu = 0;
        if (hipGetDevice(&dev) != hipSuccess || hipDeviceGetAttribute(&cus, hipDeviceAttributeMultiprocessorCount, dev) != hipSuccess) { grid = -1; return; }
        if (hipFuncSetAttribute((const void*)hymba_fwd, hipFuncAttributeMaxDynamicSharedMemorySize, LDS_BYTES) != hipSuccess) { fprintf(stderr, "kernel_launch: hipFuncSetAttribute failed\n"); grid = -1; return; }
        if (hipOccupancyMaxActiveBlocksPerMultiprocessor(&per_cu, (const void*)hymba_fwd, NWAVES * 64, LDS_BYTES) != hipSuccess || per_cu < 1) { fprintf(stderr, "kernel_launch: occupancy query says %d blocks per CU\n", per_cu); per_cu = 1; }
        (void)hipGetLastError();
        grid = cus;
    }
    if (grid < 0) return;
    if (hipMemsetAsync((char*)d_ws + WS_CTL, 0, CTL_ZERO_BYTES, stream) != hipSuccess) { fprintf(stderr, "kernel_launch: memset of the barrier words failed\n"); return; }
    Args a{};
    for (int i = 0; i < 14; ++i) a.in[i] = (const float*)d_in[i];
    a.out = (float*)d_out; a.ws = (unsigned char*)d_ws;
#if MK_N_LAUNCHES == 1
    a.ph_lo = 0; a.ph_hi = NPH;
    void* kargs[] = {&a};
    hipError_t e = hipLaunchCooperativeKernel((const void*)hymba_fwd, dim3(grid), dim3(NWAVES * 64), kargs, LDS_BYTES, stream);
    if (e != hipSuccess) fprintf(stderr, "kernel_launch: cooperative launch failed: %s (grid %d)\n", hipGetErrorString(e), grid);
#else
    for (int ph = 0; ph < NPH; ++ph) {
        a.ph_lo = ph; a.ph_hi = ph + 1;
        hipLaunchKernelGGL(hymba_fwd, dim3(grid), dim3(NWAVES * 64), LDS_BYTES, stream, a);
    }
#endif
}
```

```cpp
#include <hip/hip_runtime.h>
#include <hip/hip_cooperative_groups.h>
#include <cstdio>
#include <cstdint>
namespace cg = cooperative_groups;
#define MK_NAIVE_ATTN 0
#define MK_N_LAUNCHES 1
#define MK_DBL -1
namespace pg8 {
#define PG8_LAS __attribute__((address_space(3)))
typedef unsigned short bf16_t;
typedef short bf16x8 __attribute__((ext_vector_type(8)));
typedef float f32x4 __attribute__((ext_vector_type(4)));
typedef unsigned u32x4 __attribute__((ext_vector_type(4)));
constexpr int BM = 256, BK = 64, HALF = 128, HTB = HALF * BK * 2  , STAGE_BYTES = 8 * HTB, NXCD = 8, WGM = 8;

__host__ __device__ __forceinline__ int lds_byte(int r, int c) { const int st = (r >> 4) * 2 + (c >> 5), rr = r & 15, cc = c & 31, ob = rr * 64 + cc * 2; return st * 1024 + (ob ^ (((ob >> 9) & 1) << 5)); }
__host__ __device__ __forceinline__ void stage_rc(int b, int& R, int& C) { const int st = b / 1024, sb = b % 1024, swz = sb ^ (((sb >> 9) & 1) << 5); R = (st >> 1) * 16 + swz / 64; C = (st & 1) * 32 + (swz % 64) / 2; }
__host__ __device__ __forceinline__ int perm32(int rho) { const int n = rho >> 4, i = rho & 15; return 8 * (i >> 2) + 4 * n + (i & 3); }

struct Unit { int pm, pn; };
struct Gemm { const bf16_t* A; const bf16_t* Bt; int M, N, K; };

struct StaticOrder {
    int nM, nN, nwg, G, c;
    __host__ __device__ void init(int M, int N, int G_, int c_) { nM = M / BM; nN = N / BM; nwg = nM * nN; G = G_; c = c_; }
    __host__ __device__ bool next(int i, Unit& u) const {
        const long L = (long)i * G + c; if (L >= nwg) return false;
        int wgid = (int)L; { const int q = nwg / NXCD, r = nwg % NXCD, xcd = wgid % NXCD, off = wgid / NXCD; wgid = (xcd < r ? xcd * (q + 1) : r * (q + 1) + (xcd - r) * q) + off; }
        const int nig = WGM * nN, gid = wgid / nig, fm = gid * WGM, gsz = (nM - fm) < WGM ? (nM - fm) : WGM;
        u.pm = fm + ((wgid % nig) % gsz); u.pn = (wgid % nig) / gsz; return true;
    }
    __device__ __forceinline__ void a_ready(const Unit&) const {}
    __device__ __forceinline__ void done(const Unit&) const {}
};

__device__ __forceinline__ unsigned cvt_pk_bf16(float lo, float hi) { unsigned r; asm volatile("v_cvt_pk_bf16_f32 %0, %1, %2" : "=v"(r) : "v"(lo), "v"(hi)); return r; }
typedef unsigned u32x2 __attribute__((ext_vector_type(2)));
struct EpiBf16 {
    static constexpr bool PERM = true, AFTER_DRAIN = false;
    bf16_t* O; int ldc;
    __device__ __forceinline__ void operator()(const f32x4 (&acc)[2][2][4][2], const Unit& u, int wr, int wc, int fr, int fq) const {
        const int row0 = u.pm * BM + wr * 64 + fr; const int col0 = u.pn * BM + wc * 32 + 8 * fq;
#pragma unroll
        for (int ai = 0; ai < 2; ++ai)
#pragma unroll
            for (int m = 0; m < 4; ++m) { bf16_t* rowp = O + (size_t)(row0 + ai * HALF + m * 16) * ldc + col0;
#pragma unroll
                for (int bj = 0; bj < 2; ++bj) { const f32x4 v0 = acc[ai][bj][m][0], v1 = acc[ai][bj][m][1];
                    u32x4 w; w.x = cvt_pk_bf16(v0[0], v0[1]); w.y = cvt_pk_bf16(v0[2], v0[3]); w.z = cvt_pk_bf16(v1[0], v1[1]); w.w = cvt_pk_bf16(v1[2], v1[3]);
                    *(u32x4*)(rowp + bj * HALF) = w; } }
    }
};
struct EpiSqRelu {
    static constexpr bool PERM = true, AFTER_DRAIN = false;
    bf16_t* O; int ldc;
    __device__ __forceinline__ void operator()(const f32x4 (&acc)[2][2][4][2], const Unit& u, int wr, int wc, int fr, int fq) const {
        const int row0 = u.pm * BM + wr * 64 + fr; const int col0 = u.pn * BM + wc * 32 + 8 * fq;
#pragma unroll
        for (int ai = 0; ai < 2; ++ai)
#pragma unroll
            for (int m = 0; m < 4; ++m) { bf16_t* rowp = O + (size_t)(row0 + ai * HALF + m * 16) * ldc + col0;
#pragma unroll
                for (int bj = 0; bj < 2; ++bj) { f32x4 v0 = acc[ai][bj][m][0], v1 = acc[ai][bj][m][1];
#pragma unroll
                    for (int e = 0; e < 4; ++e) { const float a = fmaxf(v0[e], 0.f), b = fmaxf(v1[e], 0.f); v0[e] = a * a; v1[e] = b * b; }
                    u32x4 w; w.x = cvt_pk_bf16(v0[0], v0[1]); w.y = cvt_pk_bf16(v0[2], v0[3]); w.z = cvt_pk_bf16(v1[0], v1[1]); w.w = cvt_pk_bf16(v1[2], v1[3]);
                    *(u32x4*)(rowp + bj * HALF) = w; } }
    }
};
struct EpiResA {
    static constexpr bool PERM = true, AFTER_DRAIN = false;
    const float* base; bf16_t* ob; float* ss; int ldc;
    __device__ __forceinline__ void operator()(const f32x4 (&acc)[2][2][4][2], const Unit& u, int wr, int wc, int fr, int fq) const {
        const int row0 = u.pm * BM + wr * 64 + fr; const int col0 = u.pn * BM + wc * 32 + 8 * fq;
#pragma unroll
        for (int ai = 0; ai < 2; ++ai)
#pragma unroll
            for (int m = 0; m < 4; ++m) { const int r = row0 + ai * HALF + m * 16; const size_t off = (size_t)r * ldc + col0; float s = 0.f;
#pragma unroll
                for (int bj = 0; bj < 2; ++bj) { const f32x4 v0 = *(const f32x4*)(base + off + bj * HALF) + acc[ai][bj][m][0], v1 = *(const f32x4*)(base + off + bj * HALF + 4) + acc[ai][bj][m][1];
                    s += ((v0[0] * v0[0] + v0[1] * v0[1]) + (v0[2] * v0[2] + v0[3] * v0[3])) + ((v1[0] * v1[0] + v1[1] * v1[1]) + (v1[2] * v1[2] + v1[3] * v1[3]));
                    u32x4 w; w.x = cvt_pk_bf16(v0[0], v0[1]); w.y = cvt_pk_bf16(v0[2], v0[3]); w.z = cvt_pk_bf16(v1[0], v1[1]); w.w = cvt_pk_bf16(v1[2], v1[3]);
                    *(u32x4*)(ob + off + bj * HALF) = w; }
                s += __shfl_xor(s, 16); s += __shfl_xor(s, 32);
                if (fq == 0) ss[(size_t)r * 16 + u.pn * 4 + wc] = s; }
    }
};
struct EpiResB {
    static constexpr bool PERM = true, AFTER_DRAIN = false;
    const bf16_t* hb; float* out; float* ss; int ldc; const float* ss1;
    __device__ __forceinline__ void operator()(const f32x4 (&acc)[2][2][4][2], const Unit& u, int wr, int wc, int fr, int fq) const {
        const int row0 = u.pm * BM + wr * 64 + fr; const int col0 = u.pn * BM + wc * 32 + 8 * fq;
#pragma unroll
        for (int ai = 0; ai < 2; ++ai)
#pragma unroll
            for (int m = 0; m < 4; ++m) { const int r = row0 + ai * HALF + m * 16; const size_t off = (size_t)r * ldc + col0; float s = 0.f;
                const f32x4* sp = (const f32x4*)(ss1 + (size_t)r * 16); const f32x4 s0 = sp[0], s1 = sp[1], s2 = sp[2], s3 = sp[3];
                const float tot = ((s0[0] + s0[1]) + (s0[2] + s0[3])) + ((s1[0] + s1[1]) + (s1[2] + s1[3])) + ((s2[0] + s2[1]) + (s2[2] + s2[3])) + ((s3[0] + s3[1]) + (s3[2] + s3[3]));
                const float rs2 = 1.0f / (tot * (1.0f / 1024.0f) + 1e-6f);
#pragma unroll
                for (int bj = 0; bj < 2; ++bj) { const u32x4 rb = *(const u32x4*)(hb + off + bj * HALF);
                    f32x4 v0, v1; v0[0] = __uint_as_float(rb.x << 16); v0[1] = __uint_as_float(rb.x & 0xffff0000u); v0[2] = __uint_as_float(rb.y << 16); v0[3] = __uint_as_float(rb.y & 0xffff0000u);
                    v1[0] = __uint_as_float(rb.z << 16); v1[1] = __uint_as_float(rb.z & 0xffff0000u); v1[2] = __uint_as_float(rb.w << 16); v1[3] = __uint_as_float(rb.w & 0xffff0000u);
                    v0 += acc[ai][bj][m][0] * rs2; v1 += acc[ai][bj][m][1] * rs2;
                    s += ((v0[0] * v0[0] + v0[1] * v0[1]) + (v0[2] * v0[2] + v0[3] * v0[3])) + ((v1[0] * v1[0] + v1[1] * v1[1]) + (v1[2] * v1[2] + v1[3] * v1[3]));
                    *(f32x4*)(out + off + bj * HALF) = v0; *(f32x4*)(out + off + bj * HALF + 4) = v1; }
                s += __shfl_xor(s, 16); s += __shfl_xor(s, 32);
                if (fq == 0) ss[(size_t)r * 16 + u.pn * 4 + wc] = s; }
    }
};
template <class Epi, class Sched, bool ALIGN_EPI = false, bool SP2 = false>
__device__ __forceinline__ void gemm_phase(PG8_LAS unsigned char* lds, const Gemm g, const Sched& S, const Epi& E) {
    const int tid = threadIdx.x, wid = __builtin_amdgcn_readfirstlane(tid >> 6), lane = tid & 63, wr = wid >> 2, wc = wid & 3, fr = lane & 15, fq = lane >> 4;
    const int K = g.K, nt = K / BK;
    unsigned voffA[2], voffB[2];
#pragma unroll
    for (int i = 0; i < 2; ++i) { int R, C; stage_rc(tid * 16 + i * 8192, R, C); const int Rb = Epi::PERM ? ((R & ~31) + perm32(R & 31)) : R;
        voffA[i] = (unsigned)(R * K + C) * 2u; voffB[i] = (unsigned)(Rb * K + C) * 2u; }
    const size_t kstep = (size_t)(BK * 2);
    const size_t hstep = (size_t)HALF * K * 2;
    const size_t tstep = 2 * hstep;
    const unsigned ldsw = (unsigned)wid * 1024u;
    const int aoff = lds_byte(wr * 64 + fr, fq * 8), boff = lds_byte(wc * 32 + fr, fq * 8);
#define PG8_SA(b, h) (((b) * 2 + (h)) * HTB)
#define PG8_SB(b, h) ((4 + (b) * 2 + (h)) * HTB)
#define PG8_STAGE(bufoff, gbase, voff) do { _Pragma("unroll") for (int _i = 0; _i < 2; ++_i) \
        __builtin_amdgcn_global_load_lds((const unsigned*)((const char*)(gbase) + (voff)[_i]), (PG8_LAS unsigned*)(lds + (bufoff) + ldsw + _i * 8192), 16, 0, 0); } while (0)
#define PG8_LDA(dst, b, h) do { _Pragma("unroll") for (int m = 0; m < 4; ++m) _Pragma("unroll") for (int k = 0; k < 2; ++k) dst[m][k] = *(const PG8_LAS bf16x8*)(lds + PG8_SA(b, h) + aoff + m * 2048 + k * 1024); } while (0)
#define PG8_LDB(dst, b, h) do { _Pragma("unroll") for (int n = 0; n < 2; ++n) _Pragma("unroll") for (int k = 0; k < 2; ++k) dst[n][k] = *(const PG8_LAS bf16x8*)(lds + PG8_SB(b, h) + boff + n * 2048 + k * 1024); } while (0)
#define PG8_MMA(ai, bj, At, Bt) do { __builtin_amdgcn_s_setprio(1); _Pragma("unroll") for (int m = 0; m < 4; ++m) _Pragma("unroll") for (int n = 0; n < 2; ++n) _Pragma("unroll") for (int k = 0; k < 2; ++k) \
        acc[ai][bj][m][n] = __builtin_amdgcn_mfma_f32_16x16x32_bf16(Bt[n][k], At[m][k], acc[ai][bj][m][n], 0, 0, 0); __builtin_amdgcn_s_setprio(0); } while (0)
#define PG8_WAIT_V(n) asm volatile("s_waitcnt vmcnt(" #n ")" ::: "memory")
#define PG8_WAIT_L(n) asm volatile("s_waitcnt lgkmcnt(" #n ")" ::: "memory")
#define PG8_BAR __builtin_amdgcn_s_barrier()
#define PG8_SCHED __builtin_amdgcn_sched_barrier(0)
    Unit cur, nxt; int ui = 0;
    if (!S.next(0, cur)) return;
    f32x4 acc[2][2][4][2];
#pragma unroll
    for (int a = 0; a < 2; ++a)
#pragma unroll
        for (int b = 0; b < 2; ++b)
#pragma unroll
            for (int m = 0; m < 4; ++m)
#pragma unroll
                for (int n = 0; n < 2; ++n) acc[a][b][m][n] = (f32x4){0.f, 0.f, 0.f, 0.f};
    bf16x8 At[4][2], B0[2][2], B1[2][2];
    const char* cA = (const char*)g.A + (size_t)cur.pm * tstep; const char* cB = (const char*)g.Bt + (size_t)cur.pn * tstep;
    S.a_ready(cur);
    if constexpr (SP2) {
        PG8_STAGE(PG8_SB(0, 0), cB, voffB); PG8_STAGE(PG8_SB(0, 1), cB + hstep, voffB); PG8_STAGE(PG8_SA(0, 0), cA, voffA); PG8_STAGE(PG8_SA(0, 1), cA + hstep, voffA);
        if (wr == 1) PG8_BAR;
        PG8_WAIT_V(2); PG8_BAR;
        PG8_STAGE(PG8_SB(1, 0), cB + kstep, voffB); PG8_STAGE(PG8_SA(1, 0), cA + kstep, voffA); PG8_STAGE(PG8_SB(1, 1), cB + hstep + kstep, voffB);
        PG8_WAIT_V(6); PG8_BAR;
    } else {
        PG8_STAGE(PG8_SB(0, 0), cB, voffB); PG8_STAGE(PG8_SA(0, 0), cA, voffA); PG8_STAGE(PG8_SB(0, 1), cB + hstep, voffB); PG8_STAGE(PG8_SA(0, 1), cA + hstep, voffA);
        if (wr == 1) PG8_BAR;
        PG8_WAIT_V(4); PG8_BAR;
        PG8_STAGE(PG8_SB(1, 0), cB + kstep, voffB); PG8_STAGE(PG8_SA(1, 0), cA + kstep, voffA); PG8_STAGE(PG8_SB(1, 1), cB + hstep + kstep, voffB);
        PG8_WAIT_V(6); PG8_BAR;
    }
    for (;;) {
        const bool has_next = S.next(ui + 1, nxt);
        const char* nA = has_next ? (const char*)g.A + (size_t)nxt.pm * tstep : cA; const char* nB = has_next ? (const char*)g.Bt + (size_t)nxt.pn * tstep : cB;
        for (int t = 0; t < nt; t += 2) {
            const bool last = (t == nt - 2);
            const char* a1 = cA + (size_t)(t + 1) * kstep;
            const char* a2 = last ? nA : cA + (size_t)(t + 2) * kstep; const char* b2 = last ? nB : cB + (size_t)(t + 2) * kstep;
            const char* a3 = a2 + kstep; const char* b3 = b2 + kstep;
            if (last && has_next) S.a_ready(nxt);
            if constexpr (SP2) {
            PG8_LDB(B0, 0, 0); PG8_LDB(B1, 0, 1); PG8_SCHED; PG8_LDA(At, 0, 0); PG8_STAGE(PG8_SA(1, 1), a1 + hstep, voffA);
            PG8_WAIT_V(8); PG8_WAIT_L(0); PG8_BAR; PG8_MMA(0, 0, At, B0); PG8_MMA(0, 1, At, B1); PG8_BAR; PG8_SCHED;
            PG8_LDA(At, 0, 1); PG8_STAGE(PG8_SB(0, 0), b2, voffB); PG8_STAGE(PG8_SB(0, 1), b2 + hstep, voffB); PG8_STAGE(PG8_SA(0, 0), a2, voffA);
            PG8_WAIT_V(8); PG8_WAIT_L(0); PG8_BAR; PG8_MMA(1, 0, At, B0); PG8_MMA(1, 1, At, B1); PG8_BAR; PG8_SCHED;
            PG8_LDB(B0, 1, 0); PG8_LDB(B1, 1, 1); PG8_SCHED; PG8_LDA(At, 1, 0); PG8_STAGE(PG8_SA(0, 1), a2 + hstep, voffA);
            PG8_WAIT_V(8); PG8_WAIT_L(0); PG8_BAR; PG8_MMA(0, 0, At, B0); PG8_MMA(0, 1, At, B1); PG8_BAR; PG8_SCHED;
            PG8_LDA(At, 1, 1); PG8_STAGE(PG8_SB(1, 0), b3, voffB); PG8_STAGE(PG8_SB(1, 1), b3 + hstep, voffB); PG8_STAGE(PG8_SA(1, 0), a3, voffA);
            PG8_WAIT_V(8); PG8_WAIT_L(0); PG8_BAR; PG8_MMA(1, 0, At, B0); PG8_MMA(1, 1, At, B1); PG8_BAR; PG8_SCHED;
            } else {
            PG8_LDB(B0, 0, 0); PG8_SCHED; PG8_LDA(At, 0, 0); PG8_STAGE(PG8_SA(1, 1), a1 + hstep, voffA);
            PG8_WAIT_L(8); PG8_BAR; PG8_WAIT_L(0); PG8_MMA(0, 0, At, B0); PG8_BAR; PG8_SCHED;
            PG8_LDB(B1, 0, 1); PG8_STAGE(PG8_SB(0, 0), b2, voffB);
            PG8_BAR; PG8_WAIT_L(0); PG8_MMA(0, 1, At, B1); PG8_BAR;
            PG8_LDA(At, 0, 1); PG8_STAGE(PG8_SA(0, 0), a2, voffA);
            PG8_BAR; PG8_WAIT_L(0); PG8_MMA(1, 0, At, B0); PG8_BAR; PG8_SCHED;
            PG8_STAGE(PG8_SB(0, 1), b2 + hstep, voffB);
            PG8_WAIT_V(6); PG8_BAR; PG8_MMA(1, 1, At, B1); PG8_BAR;
            PG8_LDB(B0, 1, 0); PG8_SCHED; PG8_LDA(At, 1, 0); PG8_STAGE(PG8_SA(0, 1), a2 + hstep, voffA);
            PG8_WAIT_L(8); PG8_BAR; PG8_WAIT_L(0); PG8_MMA(0, 0, At, B0); PG8_BAR; PG8_SCHED;
            PG8_LDB(B1, 1, 1); PG8_STAGE(PG8_SB(1, 0), b3, voffB);
            PG8_BAR; PG8_WAIT_L(0); PG8_MMA(0, 1, At, B1); PG8_BAR;
            PG8_LDA(At, 1, 1); PG8_STAGE(PG8_SA(1, 0), a3, voffA);
            PG8_BAR; PG8_WAIT_L(0); PG8_MMA(1, 0, At, B0); PG8_BAR; PG8_SCHED;
            PG8_STAGE(PG8_SB(1, 1), b3 + hstep, voffB);
            PG8_WAIT_V(6); PG8_BAR; PG8_MMA(1, 1, At, B1); PG8_BAR;
            }
        }
        if constexpr (ALIGN_EPI) { if (wr == 0) PG8_BAR; }
        if constexpr (!Epi::AFTER_DRAIN) { E(acc, cur, wr, wc, fr, fq); S.done(cur); }
        if (!has_next) break;
#pragma unroll
        for (int a = 0; a < 2; ++a)
#pragma unroll
            for (int b = 0; b < 2; ++b)
#pragma unroll
                for (int m = 0; m < 4; ++m)
#pragma unroll
                    for (int n = 0; n < 2; ++n) acc[a][b][m][n] = (f32x4){0.f, 0.f, 0.f, 0.f};
        cur = nxt; cA = nA; cB = nB; ++ui;
        if constexpr (ALIGN_EPI) { if (wr == 1) PG8_BAR; }
    }
    PG8_WAIT_V(0);
    if constexpr (!ALIGN_EPI) { if (wr == 0) PG8_BAR; }
    PG8_BAR;
    if constexpr (Epi::AFTER_DRAIN) { E.fused(acc, cur, wr, wc, fr, fq, lds, wid, lane); S.done(cur); }
#undef PG8_SA
#undef PG8_SB
#undef PG8_STAGE
#undef PG8_LDA
#undef PG8_LDB
#undef PG8_MMA
#undef PG8_WAIT_V
#undef PG8_WAIT_L
#undef PG8_BAR
#undef PG8_SCHED
}
}
#define GAS __attribute__((address_space(1)))
#define LAS __attribute__((address_space(3)))
typedef unsigned short bf16;
typedef unsigned v4u __attribute__((ext_vector_type(4)));
typedef unsigned v2u __attribute__((ext_vector_type(2)));
typedef float f32x4 __attribute__((ext_vector_type(4)));
typedef float f32x16 __attribute__((ext_vector_type(16)));
typedef short bf16x8 __attribute__((ext_vector_type(8)));
#define LDS_WAIT() asm volatile("s_waitcnt lgkmcnt(0)" ::: "memory")

#ifndef MK_N_LAUNCHES
#define MK_N_LAUNCHES 1
#endif
#ifndef MK_NAIVE_ATTN
#define MK_NAIVE_ATTN 0
#endif
constexpr int NWAVES = 8, NPH = 8;
constexpr int BATCH = 4, SEQ = 8192, D = 1024, NH = 12, HD = 64, AW = 768, GWD = 256, NG = 4, INW = 2816, FF = 4096, M = BATCH * SEQ, CHUNK = 128;
constexpr float EPS = 1e-6f;
constexpr size_t MiB = 1u << 20;
constexpr size_t WS_WIN = 2 * MiB, WS_WOUT = 8 * MiB, WS_W1 = 10 * MiB, WS_W2 = 18 * MiB, WS_SS1 = 26 * MiB, WS_SS2 = 28 * MiB, WS_LSE = 30 * MiB, WS_GM = 36 * MiB,
                 WS_XN = 64 * MiB, WS_PROJ = 128 * MiB, WS_OP = 304 * MiB, WS_H1B = 128 * MiB, WS_HID = 192 * MiB, WS_END = 448 * MiB;
static_assert(WS_WIN + (size_t)INW * D * 2 <= WS_WOUT && WS_LSE + (size_t)3 * M * NH * 4 <= WS_GM && WS_GM + (size_t)M * GWD * 2 <= WS_XN && WS_PROJ + (size_t)M * INW * 2 <= WS_OP && WS_OP + (size_t)3 * M * AW * 2 <= WS_END && WS_HID + (size_t)M * FF * 2 <= WS_END, "ws map");
constexpr int ATT_LDS_END = 147456, LDS_BYTES = ATT_LDS_END + 256;
constexpr size_t WS_CTL = 0, CTL_ZERO_BYTES = 65536;

__device__ __forceinline__ float bflo(unsigned u) { return __uint_as_float(u << 16); }
__device__ __forceinline__ float bfhi(unsigned u) { return __uint_as_float(u & 0xffff0000u); }
typedef float pk_f32x2 __attribute__((ext_vector_type(2)));
typedef __bf16 pk_bf16x2 __attribute__((ext_vector_type(2)));
__device__ __forceinline__ unsigned pk2(float lo, float hi) { pk_f32x2 v = {lo, hi}; pk_bf16x2 b = __builtin_convertvector(v, pk_bf16x2); return __builtin_bit_cast(unsigned, b); }
__device__ __forceinline__ float wave_sum(float v) {
#pragma unroll
    for (int o = 1; o < 64; o <<= 1) v += __shfl_xor(v, o);
    return v;
}
__device__ __forceinline__ float gelu_t(float x) { const float y = 0.7978845608028654f * (x + 0.044715f * x * x * x); return x / (1.0f + __expf(-2.0f * y)); }

__device__ __forceinline__ void p0_transpose_item(const float* W, int K, int N, bf16* WT, const float* gk, int qcols, float qscale, LAS float* scr, int item, int lane) {
    const int nblk = N / 32, kb = item / nblk, nb = item % nblk, k0 = 64 * kb, n0 = 32 * nb;
#pragma unroll 8
    for (int i = 0; i < 32; ++i) { const int kk = 2 * i + (lane >> 5); const float g = gk ? gk[k0 + kk] : 1.0f; scr[kk * 33 + (lane & 31)] = W[(size_t)(k0 + kk) * N + n0 + (lane & 31)] * g; }
    LDS_WAIT();
    const int c = lane & 7;
#pragma unroll
    for (int j = 0; j < 4; ++j) { const int n = (lane >> 3) + 8 * j; const LAS float* s = scr + (8 * c) * 33 + n; const float sc = (n0 + n < qcols) ? qscale : 1.0f;
        v4u o; o.x = pk2(s[0 * 33] * sc, s[1 * 33] * sc); o.y = pk2(s[2 * 33] * sc, s[3 * 33] * sc); o.z = pk2(s[4 * 33] * sc, s[5 * 33] * sc); o.w = pk2(s[6 * 33] * sc, s[7 * 33] * sc);
        *(v4u*)(WT + (size_t)(n0 + n) * K + k0 + 8 * c) = o; }
    LDS_WAIT();
}
__device__ __forceinline__ void rms_rows2_to_bf16(const float* xa, const float* xb, bf16* oa, bf16* ob, int lane) {
    const f32x4* pa = (const f32x4*)xa + lane; const f32x4* pb = (const f32x4*)xb + lane;
    f32x4 va[4], vb[4]; float sa = 0.f, sb = 0.f;
#pragma unroll
    for (int j = 0; j < 4; ++j) { va[j] = pa[64 * j]; vb[j] = pb[64 * j]; }
#pragma unroll
    for (int j = 0; j < 4; ++j) { sa += (va[j].x * va[j].x + va[j].y * va[j].y) + (va[j].z * va[j].z + va[j].w * va[j].w); sb += (vb[j].x * vb[j].x + vb[j].y * vb[j].y) + (vb[j].z * vb[j].z + vb[j].w * vb[j].w); }
    const float ra = 1.0f / sqrtf(wave_sum(sa) * (1.0f / D) + EPS), rb = 1.0f / sqrtf(wave_sum(sb) * (1.0f / D) + EPS);
    v2u* qa = (v2u*)oa + lane; v2u* qb = (v2u*)ob + lane;
#pragma unroll
    for (int j = 0; j < 4; ++j) { v2u w; w.x = pk2(va[j].x * ra, va[j].y * ra); w.y = pk2(va[j].z * ra, va[j].w * ra); qa[64 * j] = w;
        v2u y; y.x = pk2(vb[j].x * rb, vb[j].y * rb); y.y = pk2(vb[j].z * rb, vb[j].w * rb); qb[64 * j] = y; }
}

typedef short gm_v4i16 __attribute__((ext_vector_type(4)));
__device__ __forceinline__ void gmlp_unit(LAS unsigned char* lds, const bf16* PROJ, const float* ln_g, const float* ln_b, const float* sgu_w, const float* sgu_b, bf16* GM, int unit, int tid) {
    const int g = unit & 3, n = (unit >> 2) & 63, b = unit >> 8;
    const size_t row0 = (size_t)b * SEQ + (size_t)n * CHUNK;
    const int wave = __builtin_amdgcn_readfirstlane(tid >> 6), lane = tid & 63, ql = lane & 31, h2 = lane >> 5, ti = wave >> 1, ci = wave & 1;
    const int tq = 32 * ti + ql;
    const float* wrow = sgu_w + ((size_t)g * CHUNK + tq) * CHUNK + 8 * h2;
    f32x4 wf[8][2];
#pragma unroll
    for (int ks = 0; ks < 8; ++ks) if (ks < 2 * (ti + 1)) { wf[ks][0] = *(const f32x4*)(wrow + 16 * ks); wf[ks][1] = *(const f32x4*)(wrow + 16 * ks + 4); }
    const bf16* up = PROJ + (row0 + tq) * INW + 2304 + g * 64 + 32 * ci + 4 * h2;
    v2u ur[4];
#pragma unroll
    for (int g4 = 0; g4 < 4; ++g4) ur[g4] = *(const v2u*)(up + 8 * g4);
    const float bs = sgu_b[g * CHUNK + tq];
    {
        const int t = tid >> 2, q = tid & 3;
        const bf16* zp = PROJ + (row0 + t) * INW + 2560 + g * 64 + 16 * q;
        const v4u r0 = *(const v4u*)zp, r1 = *(const v4u*)(zp + 8);
        float z[16];
        z[0] = bflo(r0.x); z[1] = bfhi(r0.x); z[2] = bflo(r0.y); z[3] = bfhi(r0.y); z[4] = bflo(r0.z); z[5] = bfhi(r0.z); z[6] = bflo(r0.w); z[7] = bfhi(r0.w);
        z[8] = bflo(r1.x); z[9] = bfhi(r1.x); z[10] = bflo(r1.y); z[11] = bfhi(r1.y); z[12] = bflo(r1.z); z[13] = bfhi(r1.z); z[14] = bflo(r1.w); z[15] = bfhi(r1.w);
        float s = 0.f;
#pragma unroll
        for (int e = 0; e < 16; ++e) { z[e] = gelu_t(z[e]); s += z[e]; }
        s += __shfl_xor(s, 1); s += __shfl_xor(s, 2);
        const float mean = s * (1.0f / 64.0f); float v = 0.f;
#pragma unroll
        for (int e = 0; e < 16; ++e) { z[e] -= mean; v += z[e] * z[e]; }
        v += __shfl_xor(v, 1); v += __shfl_xor(v, 2);
        const float rstd = 1.0f / sqrtf(v * (1.0f / 64.0f) + EPS);
        const float* lg = ln_g + g * 64 + 16 * q; const float* lb = ln_b + g * 64 + 16 * q;
#pragma unroll
        for (int e = 0; e < 16; ++e) z[e] = z[e] * rstd * lg[e] + lb[e];
        v4u w0, w1; w0.x = pk2(z[0], z[1]); w0.y = pk2(z[2], z[3]); w0.z = pk2(z[4], z[5]); w0.w = pk2(z[6], z[7]); w1.x = pk2(z[8], z[9]); w1.y = pk2(z[10], z[11]); w1.z = pk2(z[12], z[13]); w1.w = pk2(z[14], z[15]);
        *(LAS v4u*)(lds + t * 192 + q * 32) = w0; *(LAS v4u*)(lds + t * 192 + q * 32 + 16) = w1;
    }
    __syncthreads();
    f32x16 acc;
#pragma unroll
    for (int e = 0; e < 16; ++e) acc[e] = 0.f;
    const LAS unsigned char* zrd = lds + (8 * h2 + ((lane & 15) >> 2)) * 192 + (32 * ci + ((lane >> 4) & 1) * 16 + (lane & 3) * 4) * 2;
#pragma unroll
    for (int ks = 0; ks < 8; ++ks) if (ks < 2 * (ti + 1)) {
        float w[8];
#pragma unroll
        for (int e = 0; e < 4; ++e) { w[e] = wf[ks][0][e]; w[4 + e] = wf[ks][1][e]; }
#pragma unroll
        for (int e = 0; e < 8; ++e) w[e] = (16 * ks + 8 * h2 + e <= tq) ? w[e] : 0.f;
        v4u bw; bw.x = pk2(w[0], w[1]); bw.y = pk2(w[2], w[3]); bw.z = pk2(w[4], w[5]); bw.w = pk2(w[6], w[7]);
        const bf16x8 bfr = __builtin_bit_cast(bf16x8, bw);
        const gm_v4i16 a0 = __builtin_amdgcn_ds_read_tr16_b64_v4i16((LAS gm_v4i16*)(zrd + (16 * ks) * 192)), a1 = __builtin_amdgcn_ds_read_tr16_b64_v4i16((LAS gm_v4i16*)(zrd + (16 * ks + 4) * 192));
        const bf16x8 afr = {a0[0], a0[1], a0[2], a0[3], a1[0], a1[1], a1[2], a1[3]};
        acc = __builtin_amdgcn_mfma_f32_32x32x16_bf16(afr, bfr, acc, 0, 0, 0);
    }
    bf16* gp = GM + (row0 + tq) * GWD + g * 64 + 32 * ci + 4 * h2;
#pragma unroll
    for (int g4 = 0; g4 < 4; ++g4) {
        const float u0 = gelu_t(bflo(ur[g4].x)) * (acc[4 * g4] + bs), u1 = gelu_t(bfhi(ur[g4].x)) * (acc[4 * g4 + 1] + bs), u2 = gelu_t(bflo(ur[g4].y)) * (acc[4 * g4 + 2] + bs), u3 = gelu_t(bfhi(ur[g4].y)) * (acc[4 * g4 + 3] + bs);
        v2u o; o.x = pk2(u0, u1); o.y = pk2(u2, u3); *(v2u*)(gp + 8 * g4) = o;
    }
    __syncthreads();
}

__device__ __forceinline__ float alibi_slope(int h) { return (h < 8) ? exp2f(-(float)(h + 1)) : exp2f(-0.5f - (float)(h - 8)); }

#if MK_NAIVE_ATTN
__device__ __forceinline__ void attn_naive(const bf16* PROJ, bf16* OP, float* LSE, int gtid, int nthreads) {
#pragma unroll 1
    for (int it = gtid; it < M * NH * 3; it += nthreads) {
        const int h = it % NH, row = (it / NH) % M, p = it / (NH * M), dil = 1 << (2 * p), t = row % SEQ;
        const float slope = alibi_slope(h);
        const bf16* qp = PROJ + (size_t)row * INW + h * 64;
        float q[64], o[64];
#pragma unroll
        for (int c = 0; c < 8; ++c) { const v4u r = *(const v4u*)(qp + 8 * c); q[8*c] = bflo(r.x); q[8*c+1] = bfhi(r.x); q[8*c+2] = bflo(r.y); q[8*c+3] = bfhi(r.y); q[8*c+4] = bflo(r.z); q[8*c+5] = bfhi(r.z); q[8*c+6] = bflo(r.w); q[8*c+7] = bfhi(r.w); }
#pragma unroll
        for (int e = 0; e < 64; ++e) o[e] = 0.f;
        float m = -1e30f, l = 0.f;
#pragma unroll 1
        for (int j = 0; j <= 128; ++j) {
            const int tk = t - dil * j; if (tk < 0) break;
            const bf16* kp = qp + 768 - (size_t)(dil * j) * INW; const bf16* vp = kp + 768;
            float dot = 0.f;
#pragma unroll
            for (int c = 0; c < 8; ++c) { const v4u r = *(const v4u*)(kp + 8 * c);
                dot += q[8*c] * bflo(r.x) + q[8*c+1] * bfhi(r.x) + q[8*c+2] * bflo(r.y) + q[8*c+3] * bfhi(r.y) + q[8*c+4] * bflo(r.z) + q[8*c+5] * bfhi(r.z) + q[8*c+6] * bflo(r.w) + q[8*c+7] * bfhi(r.w); }
            const float s = dot - slope * (float)(dil * j);
            const float mn = fmaxf(m, s), sc = __expf(m - mn), pe = __expf(s - mn);
            l = l * sc + pe; m = mn;
#pragma unroll
            for (int c = 0; c < 8; ++c) { const v4u r = *(const v4u*)(vp + 8 * c);
                o[8*c] = o[8*c] * sc + pe * bflo(r.x); o[8*c+1] = o[8*c+1] * sc + pe * bfhi(r.x); o[8*c+2] = o[8*c+2] * sc + pe * bflo(r.y); o[8*c+3] = o[8*c+3] * sc + pe * bfhi(r.y);
                o[8*c+4] = o[8*c+4] * sc + pe * bflo(r.z); o[8*c+5] = o[8*c+5] * sc + pe * bfhi(r.z); o[8*c+6] = o[8*c+6] * sc + pe * bflo(r.w); o[8*c+7] = o[8*c+7] * sc + pe * bfhi(r.w); }
        }
        const float il = 1.0f / l;
        bf16* op = OP + ((size_t)p * M + row) * AW + h * 64;
#pragma unroll
        for (int c = 0; c < 8; ++c) { v4u w; w.x = pk2(o[8*c] * il, o[8*c+1] * il); w.y = pk2(o[8*c+2] * il, o[8*c+3] * il); w.z = pk2(o[8*c+4] * il, o[8*c+5] * il); w.w = pk2(o[8*c+6] * il, o[8*c+7] * il); *(v4u*)(op + 8 * c) = w; }
        LSE[((size_t)p * M + row) * NH + h] = m + __logf(l);
    }
}
#endif

struct MixRow { v2u w[4]; };
__device__ __forceinline__ MixRow mixnorm_load(const bf16* OP, const float* LSE, const bf16* GM, int row, int lane) {
    float a[3][4]; float ssa = 0.f;
    v2u ro[3][3]; float ls[3][3];
#pragma unroll
    for (int j = 0; j < 3; ++j) { const int c = 256 * j + 4 * lane, head = c >> 6;
#pragma unroll
        for (int p = 0; p < 3; ++p) { ls[j][p] = LSE[((size_t)p * M + row) * NH + head]; ro[j][p] = *(const v2u*)(OP + ((size_t)p * M + row) * AW + c); } }
    const v2u gr = *(const v2u*)(GM + (size_t)row * GWD + 4 * lane);
#pragma unroll
    for (int j = 0; j < 3; ++j) {
        const float mx = fmaxf(ls[j][0], fmaxf(ls[j][1], ls[j][2]));
        float w[3]; float wsum = 0.f;
#pragma unroll
        for (int p = 0; p < 3; ++p) { w[p] = __expf(ls[j][p] - mx); wsum += w[p]; }
        const float iw = 1.0f / wsum;
#pragma unroll
        for (int e = 0; e < 4; ++e) a[j][e] = 0.f;
#pragma unroll
        for (int p = 0; p < 3; ++p) { const v2u r = ro[j][p]; const float wp = w[p] * iw;
            a[j][0] += wp * bflo(r.x); a[j][1] += wp * bfhi(r.x); a[j][2] += wp * bflo(r.y); a[j][3] += wp * bfhi(r.y); }
#pragma unroll
        for (int e = 0; e < 4; ++e) ssa += a[j][e] * a[j][e];
    }
    float gv[4]; gv[0] = bflo(gr.x); gv[1] = bfhi(gr.x); gv[2] = bflo(gr.y); gv[3] = bfhi(gr.y);
    float ssg = (gv[0] * gv[0] + gv[1] * gv[1]) + (gv[2] * gv[2] + gv[3] * gv[3]);
    const float ra = 1.0f / sqrtf(wave_sum(ssa) * (1.0f / AW) + EPS), rg = 1.0f / sqrtf(wave_sum(ssg) * (1.0f / GWD) + EPS);
    MixRow r;
#pragma unroll
    for (int j = 0; j < 3; ++j) { r.w[j].x = pk2(a[j][0] * ra, a[j][1] * ra); r.w[j].y = pk2(a[j][2] * ra, a[j][3] * ra); }
    r.w[3].x = pk2(gv[0] * rg, gv[1] * rg); r.w[3].y = pk2(gv[2] * rg, gv[3] * rg);
    return r;
}
__device__ __forceinline__ void mixnorm_store(const MixRow& r, bf16* MIXED, int row, int lane) {
    bf16* mp = MIXED + (size_t)row * D;
#pragma unroll
    for (int j = 0; j < 3; ++j) *(v2u*)(mp + 256 * j + 4 * lane) = r.w[j];
    *(v2u*)(mp + AW + 4 * lane) = r.w[3];
}
#if !MK_NAIVE_ATTN
typedef short v4i16_t __attribute__((ext_vector_type(4)));
typedef float f32x2_t __attribute__((ext_vector_type(2)));
typedef __bf16 bf16x2_t __attribute__((ext_vector_type(2)));
__device__ __forceinline__ unsigned cvtpk_s(float lo, float hi) { f32x2_t v = {lo, hi}; bf16x2_t b = __builtin_convertvector(v, bf16x2_t); return __builtin_bit_cast(unsigned, b); }
__device__ __forceinline__ v4i16_t vtr(const LAS unsigned char* p) { return __builtin_amdgcn_ds_read_tr16_b64_v4i16((LAS v4i16_t*)p); }
__device__ __forceinline__ float xhalf_max(float v) { auto rr = __builtin_amdgcn_permlane32_swap(__float_as_uint(v), __float_as_uint(v), false, false); return fmaxf(__uint_as_float(rr[0]), __uint_as_float(rr[1])); }
__device__ __forceinline__ float xhalf_sum(float v) { auto rr = __builtin_amdgcn_permlane32_swap(__float_as_uint(v), __float_as_uint(v), false, false); return __uint_as_float(rr[0]) + __uint_as_float(rr[1]); }
constexpr int ATT_KS = 144, ATT_VS = 192, ATT_KROWS = 384, ATT_VOFF = ATT_KROWS * ATT_KS, ATT_OOFF = ATT_VOFF + ATT_KROWS * ATT_VS, ATT_OS = 72;
static_assert(ATT_OOFF + NWAVES * 32 * ATT_OS <= ATT_LDS_END, "attention LDS map");
constexpr int ATT_NU = BATCH * NH * 96;

struct AttUnit { int p, h, dil, i0w; size_t rowb; };
__device__ __forceinline__ AttUnit att_decode(int u) {
    AttUnit a; const int bh = u / 96, rem = u - bh * 96, b = bh / NH; a.h = bh - b * NH; a.p = rem >> 5; const int sub = rem & 31, dsh = 2 * a.p; a.dil = 1 << dsh;
    const int nblk = 32 >> dsh, r = sub / nblk, blk = sub - r * nblk; a.i0w = 256 * blk; a.rowb = (size_t)b * SEQ + r; return a;
}

__device__ __forceinline__ void attn_phase(LAS unsigned char* lds, const bf16* PROJ, bf16* OP, float* LSE, int vcu, int G, int wave, int lane, int tid) {
    constexpr float LOG2E = 1.4426950408889634f, LN2 = 0.6931471805599453f;
    const int ql = lane & 31, h2 = lane >> 5;
    LAS unsigned char* KL = lds; LAS unsigned char* VL = lds + ATT_VOFF; LAS unsigned char* OL = lds + ATT_OOFF + wave * (32 * ATT_OS);
    const LAS unsigned char* krd = KL + (32 * wave + ql) * ATT_KS + 16 * h2;
    const LAS unsigned char* vrd = VL + (32 * wave + 4 * h2 + ((lane & 15) >> 2)) * ATT_VS + (((lane >> 4) & 1) * 16 + (lane & 3) * 4) * 2;
    v4u kreg[6], vreg[6]; bf16x8 qn[4];
#define ATT_LOAD(u_) do { const AttUnit a_ = att_decode(u_); const bf16* base_ = PROJ + a_.h * 64; \
        _Pragma("unroll") for (int j = 0; j < 6; ++j) { const int c_ = tid + 512 * j; int di_ = a_.i0w - 128 + (c_ >> 3); di_ = di_ < 0 ? 0 : di_; \
            const bf16* kp_ = base_ + AW + (a_.rowb + (size_t)di_ * a_.dil) * INW + (c_ & 7) * 8; kreg[j] = *(const v4u*)kp_; vreg[j] = *(const v4u*)(kp_ + AW); } \
        const bf16* qp_ = base_ + (a_.rowb + (size_t)(a_.i0w + 32 * wave + ql) * a_.dil) * INW + 8 * h2; \
        _Pragma("unroll") for (int s = 0; s < 4; ++s) qn[s] = *(const bf16x8*)(qp_ + 16 * s); } while (0)
    int u = vcu;
    if (u < ATT_NU) ATT_LOAD(u);
#pragma unroll 1
    for (; u < ATT_NU; u += G) {
        asm volatile("" ::: "memory"); __builtin_amdgcn_s_barrier(); asm volatile("" ::: "memory");
#pragma unroll
        for (int j = 0; j < 6; ++j) { const int c = tid + 512 * j; *(LAS v4u*)(KL + (c >> 3) * ATT_KS + (c & 7) * 16) = kreg[j]; *(LAS v4u*)(VL + (c >> 3) * ATT_VS + (c & 7) * 16) = vreg[j]; }
        bf16x8 qf[4];
#pragma unroll
        for (int s = 0; s < 4; ++s) qf[s] = qn[s];
        asm volatile("s_waitcnt lgkmcnt(0)" ::: "memory"); __builtin_amdgcn_s_barrier(); asm volatile("" ::: "memory");
        const AttUnit au = att_decode(u);
        if (u + G < ATT_NU) ATT_LOAD(u + G);
        const int i0 = au.i0w + 32 * wave, dil = au.dil;
        const float c2 = alibi_slope(au.h) * (float)dil * LOG2E;
        f32x16 o0, o1, bias;
#pragma unroll
        for (int e = 0; e < 16; ++e) { o0[e] = 0.f; o1[e] = 0.f; bias[e] = c2 * (float)((e & 3) + 8 * (e >> 2) + 4 * h2 - ql); }
        float m = -1e30f, l = 0.f;
#pragma unroll
        for (int kk = 0; kk < 5; ++kk) {
            const int kt = 4 - kk;
            const int k0 = i0 - 128 + 32 * kt;
            if (k0 >= 0) {
                f32x16 sa = bias;
#pragma unroll
                for (int s = 0; s < 4; ++s) { const bf16x8 kc = *(const LAS bf16x8*)(krd + (32 * kt) * ATT_KS + 32 * s); sa = __builtin_amdgcn_mfma_f32_32x32x16_bf16(kc, qf[s], sa, 0, 0, 0); }
                float mx = -INFINITY;
#pragma unroll
                for (int e = 0; e < 16; ++e) { const int kr = (e & 3) + 8 * (e >> 2);
                    if (kt == 0) sa[e] = (kr + 4 * h2 >= ql) ? sa[e] : -INFINITY;
                    if (kt == 4) sa[e] = (kr + 4 * h2 <= ql) ? sa[e] : -INFINITY;
                    mx = fmaxf(mx, sa[e]); }
                mx = xhalf_max(mx);
                const float delta = c2 * (float)(128 - 32 * kt);
                if (kt == 4) m = mx;
                else {
                    const float mxt = mx - delta; const bool need = mxt > m + 8.0f;
                    if (__builtin_amdgcn_ballot_w64(need) != 0ull) {
                        const float mn = need ? mxt : m, alpha = __builtin_amdgcn_exp2f(m - mn); m = mn; l *= alpha;
#pragma unroll
                        for (int e = 0; e < 16; ++e) { o0[e] *= alpha; o1[e] *= alpha; }
                    }
                }
                const float msub = m + delta;
                float ls = 0.f;
#pragma unroll
                for (int e = 0; e < 16; ++e) { sa[e] = __builtin_amdgcn_exp2f(sa[e] - msub); ls += sa[e]; }
                l += ls;
#pragma unroll
                for (int s2 = 0; s2 < 2; ++s2) {
                    v4u pw; pw.x = cvtpk_s(sa[8 * s2], sa[8 * s2 + 1]); pw.y = cvtpk_s(sa[8 * s2 + 2], sa[8 * s2 + 3]); pw.z = cvtpk_s(sa[8 * s2 + 4], sa[8 * s2 + 5]); pw.w = cvtpk_s(sa[8 * s2 + 6], sa[8 * s2 + 7]);
                    const bf16x8 pb = __builtin_bit_cast(bf16x8, pw);
                    const LAS unsigned char* vb = vrd + (32 * kt + 16 * s2) * ATT_VS;
                    { const v4i16_t a = vtr(vb), c = vtr(vb + 8 * ATT_VS);
                      const bf16x8 vf = {a[0], a[1], a[2], a[3], c[0], c[1], c[2], c[3]};
                      o0 = __builtin_amdgcn_mfma_f32_32x32x16_bf16(vf, pb, o0, 0, 0, 0); }
                    { const v4i16_t a = vtr(vb + 64), c = vtr(vb + 8 * ATT_VS + 64);
                      const bf16x8 vf = {a[0], a[1], a[2], a[3], c[0], c[1], c[2], c[3]};
                      o1 = __builtin_amdgcn_mfma_f32_32x32x16_bf16(vf, pb, o1, 0, 0, 0); }
                }
            }
        }
        const float lt = xhalf_sum(l), il = 1.0f / lt;
        if (h2 == 0) LSE[((size_t)au.p * M + au.rowb + (size_t)(i0 + ql) * dil) * NH + au.h] = (m + __log2f(lt)) * LN2;
        bf16* og = OP + ((size_t)au.p * M + au.rowb + (size_t)(i0 + (lane >> 1)) * dil) * AW + au.h * 64 + 16 * (lane & 1);
        LAS unsigned char* ow = OL + ql * ATT_OS + 8 * h2;
        const LAS unsigned char* orr = OL + (lane >> 1) * ATT_OS + 32 * (lane & 1);
#pragma unroll
        for (int dt = 0; dt < 2; ++dt) {
#pragma unroll
            for (int g4 = 0; g4 < 4; ++g4) { v2u w;
                if (dt == 0) { w.x = cvtpk_s(o0[4 * g4] * il, o0[4 * g4 + 1] * il); w.y = cvtpk_s(o0[4 * g4 + 2] * il, o0[4 * g4 + 3] * il); }
                else { w.x = cvtpk_s(o1[4 * g4] * il, o1[4 * g4 + 1] * il); w.y = cvtpk_s(o1[4 * g4 + 2] * il, o1[4 * g4 + 3] * il); }
                *(LAS v2u*)(ow + 16 * g4) = w; }
            const v2u r0 = *(const LAS v2u*)(orr), r1 = *(const LAS v2u*)(orr + 8), r2 = *(const LAS v2u*)(orr + 16), r3 = *(const LAS v2u*)(orr + 24);
            v4u s0; s0.x = r0.x; s0.y = r0.y; s0.z = r1.x; s0.w = r1.y; v4u s1; s1.x = r2.x; s1.y = r2.y; s1.z = r3.x; s1.w = r3.y;
            *(v4u*)(og + 32 * dt) = s0; *(v4u*)(og + 32 * dt + 8) = s1;
        }
    }
#undef ATT_LOAD
    asm volatile("" ::: "memory"); __builtin_amdgcn_s_barrier(); asm volatile("" ::: "memory");
}
#endif
#define XB_TMO      128
#define XB_XCNT(j)  (256  + 64 * (j))
#define XB_XSUB(j)  (1280 + 64 * (j))
#define XB_XGEN(j)  (2304 + 64 * (j))
#define XB_TOP      3328
#define XB_TOPGEN   3392
#define XCD_BAR_WORDS 3456
#define XB_SPIN_CAP (1u << 18)

__device__ __forceinline__ unsigned xb_ld(unsigned* p)              { return __hip_atomic_load(p, __ATOMIC_RELAXED, __HIP_MEMORY_SCOPE_AGENT); }
__device__ __forceinline__ unsigned xb_add(unsigned* p, unsigned v) { return __hip_atomic_fetch_add(p, v, __ATOMIC_RELAXED, __HIP_MEMORY_SCOPE_AGENT); }
__device__ __forceinline__ unsigned xb_xcc_id() { return (unsigned)__builtin_amdgcn_s_getreg((3 << 11) | 20) & 0xFu; }
#define XB_SPIN(cond, bar) do { unsigned _sp = 0; while (cond) { __builtin_amdgcn_s_sleep(1); \
    if ((++_sp & 255u) == 0u) { if (xb_ld(&(bar)[XB_TMO])) break; if (_sp > XB_SPIN_CAP) { atomicAdd(&(bar)[XB_TMO], 1u); break; } } } } while (0)

struct XcdBarrier {
    unsigned* bar; unsigned x;
    volatile LAS unsigned* st;
};

__device__ __forceinline__ XcdBarrier xcd_barrier_post(unsigned* bar, volatile LAS unsigned* st) {
    XcdBarrier b; b.bar = bar; b.x = xb_xcc_id(); b.st = st;
    if (threadIdx.x == 0) (void)xb_add(&bar[XB_XCNT(b.x)], 1u);
    return b;
}
__device__ __forceinline__ void xcd_barrier_complete(unsigned* bar, unsigned x, unsigned& nloc, unsigned& nx) {
    const unsigned G = gridDim.x * gridDim.y * gridDim.z;
    unsigned sum, cnt, mine, sp = 0u;
    for (;;) {
        sum = 0u; cnt = 0u; mine = 0u;
#pragma unroll
        for (unsigned j = 0; j < 16; ++j) { const unsigned c = xb_ld(&bar[XB_XCNT(j)]); sum += c; cnt += (c > 0u) ? 1u : 0u; mine = (j == x) ? c : mine; }
        if (sum == G) break;
        __builtin_amdgcn_s_sleep(1);
        if ((++sp & 255u) == 0u) { if (xb_ld(&bar[XB_TMO])) break; if (sp > XB_SPIN_CAP) { atomicAdd(&bar[XB_TMO], 1u); break; } }
    }
    nloc = mine > 0u ? mine : 1u; nx = cnt > 0u ? cnt : 1u;
}

__device__ __forceinline__ void xcd_barrier(const XcdBarrier& b) {
    asm volatile("s_waitcnt vmcnt(0)" ::: "memory");
    __syncthreads();
    if (threadIdx.x == 0) {
        unsigned* bar = b.bar;
        __builtin_amdgcn_s_waitcnt(0);
        unsigned nloc = b.st[0], nx = b.st[1];
        if (nloc == 0u) { xcd_barrier_complete(bar, b.x, nloc, nx); b.st[0] = nloc; b.st[1] = nx; }
        const unsigned old = xb_add(&bar[XB_XSUB(b.x)], 1u);
        const unsigned gen = old / nloc;
        if (old + 1u == (gen + 1u) * nloc) {
            __builtin_amdgcn_fence(__ATOMIC_RELEASE, "agent");
            asm volatile("s_waitcnt vmcnt(0)" ::: "memory");
            const unsigned og = xb_add(&bar[XB_TOP], 1u);
            const unsigned tg = og / nx;
            if (og + 1u == (tg + 1u) * nx) xb_add(&bar[XB_TOPGEN], 1u);
            else XB_SPIN(xb_ld(&bar[XB_TOPGEN]) == tg, bar);
            __builtin_amdgcn_fence(__ATOMIC_ACQUIRE, "agent");
            xb_add(&bar[XB_XGEN(b.x)], 1u);
            asm volatile("s_waitcnt vmcnt(0)" ::: "memory");
        } else {
            XB_SPIN(xb_ld(&bar[XB_XGEN(b.x)]) == gen, bar);
            __builtin_amdgcn_fence(__ATOMIC_ACQUIRE, "agent");
            asm volatile("s_waitcnt vmcnt(0)" ::: "memory");
        }
    }
    __syncthreads();
}

struct Args { const float* in[14]; float* out; unsigned char* ws; int ph_lo, ph_hi; };
__global__ void __launch_bounds__(NWAVES * 64, 2) hymba_fwd(Args args) {
    extern __shared__ __attribute__((aligned(16))) unsigned char lds_raw[];
    LAS unsigned char* lds = (LAS unsigned char*)lds_raw;
    cg::grid_group grid = cg::this_grid();
    const int tid = threadIdx.x, lane = tid & 63, wave = __builtin_amdgcn_readfirstlane(tid >> 6);
    const int G = gridDim.x, bx = blockIdx.x;
    const int vcu = (G % 8 == 0) ? (bx % 8) * (G / 8) + bx / 8 : bx;
    const int gw = vcu * NWAVES + wave, NGW = G * NWAVES;
    unsigned char* ws = args.ws;
    const float* x = args.in[0]; const float* norm1_g = args.in[1]; const float* w_in = args.in[2]; const float* sgu_ln_g = args.in[3]; const float* sgu_ln_b = args.in[4];
    const float* sgu_w = args.in[5]; const float* sgu_b = args.in[6]; const float* attn_out_g = args.in[7]; const float* gmlp_out_g = args.in[8]; const float* w_out = args.in[9];
    const float* norm2_g = args.in[10]; const float* w_ff1 = args.in[11]; const float* w_ff2 = args.in[12]; const float* final_g = args.in[13];
    float* out = args.out;
    bf16* WIN = (bf16*)(ws + WS_WIN); bf16* WOUT = (bf16*)(ws + WS_WOUT); bf16* W1 = (bf16*)(ws + WS_W1); bf16* W2 = (bf16*)(ws + WS_W2);
    float* SS1 = (float*)(ws + WS_SS1); float* SS2 = (float*)(ws + WS_SS2); float* LSE = (float*)(ws + WS_LSE);
    bf16* GM = (bf16*)(ws + WS_GM); bf16* XN = (bf16*)(ws + WS_XN); bf16* PROJ = (bf16*)(ws + WS_PROJ); bf16* OP = (bf16*)(ws + WS_OP);
    bf16* H1B = (bf16*)(ws + WS_H1B); bf16* HID = (bf16*)(ws + WS_HID);
    const int lo = args.ph_lo, hi = args.ph_hi;
    volatile LAS unsigned* MISC = (volatile LAS unsigned*)(lds + ATT_LDS_END);
    if (tid < 16) MISC[tid] = 0u;
    __syncthreads();
    XcdBarrier bar = xcd_barrier_post((unsigned*)(ws + WS_CTL), MISC + 8);
    if (lo < 0) grid.sync();
#define IN(k) (lo <= (k) && (k) < hi)
#define SEAM(k) do { if (IN(k) && IN((k) + 1)) xcd_barrier(bar); } while (0)
#define REPS(k) for (int rep_ = 0; rep_ < ((MK_DBL == (k)) ? 2 : 1); ++rep_)
#define REPSYNC() do { if (rep_) xcd_barrier(bar); } while (0)

#if MK_DBL == 30
    for (int i_ = 0; i_ < 8; ++i_) xcd_barrier(bar);
#endif
    if (IN(0)) REPS(0) { REPSYNC();
        LAS float* scr = (LAS float*)(lds + wave * 16384);
        constexpr int I_IN = (D / 64) * (INW / 32), I_O = (D / 64) * (D / 32), I_1 = (D / 64) * (FF / 32), I_2 = (FF / 64) * (D / 32);
        constexpr int NITEMS = I_IN + I_O + I_1 + I_2;
#pragma unroll 1
        for (int it = gw; it < NITEMS; it += NGW) {
            int r = it;
            if (r < I_IN) { p0_transpose_item(w_in, D, INW, WIN, norm1_g, AW, MK_NAIVE_ATTN ? 0.125f : 0.125f * 1.4426950408889634f, scr, r, lane); continue; } r -= I_IN;
            if (r < I_O) { p0_transpose_item(w_out, D, D, WOUT, (r / (D / 32)) < (AW / 64) ? attn_out_g : gmlp_out_g - AW, 0, 1.0f, scr, r, lane); continue; } r -= I_O;
            if (r < I_1) { p0_transpose_item(w_ff1, D, FF, W1, norm2_g, 0, 1.0f, scr, r, lane); continue; } r -= I_1;
            p0_transpose_item(w_ff2, FF, D, W2, nullptr, 0, 1.0f, scr, r, lane);
        }
#pragma unroll 1
        for (int m = gw; m < M; m += 2 * NGW) rms_rows2_to_bf16(x + (size_t)m * D, x + (size_t)(m + NGW) * D, XN + (size_t)m * D, XN + (size_t)(m + NGW) * D, lane);
    }
    SEAM(0);
    if (IN(1)) REPS(1) { REPSYNC();
        pg8::Gemm g{XN, WIN, M, INW, D}; pg8::StaticOrder S; S.init(M, INW, G, bx);
        pg8::EpiBf16 E{PROJ, INW};
        pg8::gemm_phase<pg8::EpiBf16, pg8::StaticOrder, true, true>(lds, g, S, E);
    }
    SEAM(1);
    if (IN(2)) REPS(2) { REPSYNC();
        for (int rg_ = 0; rg_ < (MK_DBL == 20 ? 2 : 1); ++rg_)
#pragma unroll 1
        for (int u = vcu; u < BATCH * (SEQ / CHUNK) * NG; u += G) gmlp_unit(lds, PROJ, sgu_ln_g, sgu_ln_b, sgu_w, sgu_b, GM, u, tid);
#if MK_NAIVE_ATTN
        attn_naive(PROJ, OP, LSE, bx * (NWAVES * 64) + tid, G * NWAVES * 64);
#else
        for (int ra_ = 0; ra_ < (MK_DBL == 21 ? 2 : 1); ++ra_) attn_phase(lds, PROJ, OP, LSE, vcu, G, wave, lane, tid);
#endif
    }
    SEAM(2);
    if (IN(3)) REPS(3) { REPSYNC();
#pragma unroll 1
        for (int m = gw; m < M; m += 2 * NGW) { MixRow r0 = mixnorm_load(OP, LSE, GM, m, lane), r1 = mixnorm_load(OP, LSE, GM, m + NGW, lane); mixnorm_store(r0, XN, m, lane); mixnorm_store(r1, XN, m + NGW, lane); }
    }
    SEAM(3);
    if (IN(4)) REPS(4) { REPSYNC();
        pg8::Gemm g{XN, WOUT, M, D, D}; pg8::StaticOrder S; S.init(M, D, G, bx);
        pg8::EpiResA E{x, H1B, SS1, D};
        pg8::gemm_phase<pg8::EpiResA, pg8::StaticOrder, true, true>(lds, g, S, E);
    }
    SEAM(4);
    if (IN(5)) REPS(5) { REPSYNC();
        pg8::Gemm g{H1B, W1, M, FF, D}; pg8::StaticOrder S; S.init(M, FF, G, bx);
        pg8::EpiSqRelu E{HID, FF};
        pg8::gemm_phase<pg8::EpiSqRelu, pg8::StaticOrder, true, true>(lds, g, S, E);
    }
    SEAM(5);
    if (IN(6)) REPS(6) { REPSYNC();
        pg8::Gemm g{HID, W2, M, D, FF}; pg8::StaticOrder S; S.init(M, D, G, bx);
        pg8::EpiResB E{H1B, out, SS2, D, SS1};
        pg8::gemm_phase<pg8::EpiResB, pg8::StaticOrder, true, true>(lds, g, S, E);
    }
    SEAM(6);
    if (IN(7)) REPS(7) { REPSYNC();
#pragma unroll 1
        for (int m = gw; m < M; m += 2 * NGW) {
            f32x4* orow0 = (f32x4*)(out + (size_t)m * D) + lane; f32x4* orow1 = (f32x4*)(out + (size_t)(m + NGW) * D) + lane;
            f32x4* wrow0 = (MK_DBL == 7 && rep_ == 0) ? (f32x4*)((float*)(ws + WS_XN) + (size_t)m * D) + lane : orow0;
            f32x4* wrow1 = (MK_DBL == 7 && rep_ == 0) ? (f32x4*)((float*)(ws + WS_XN) + (size_t)(m + NGW) * D) + lane : orow1;
            float s0 = SS2[(size_t)m * 16 + (lane & 15)], s1 = SS2[(size_t)(m + NGW) * 16 + (lane & 15)];
            f32x4 v0[4], v1[4], gq[4];
#pragma unroll
            for (int j = 0; j < 4; ++j) { v0[j] = orow0[64 * j]; v1[j] = orow1[64 * j]; gq[j] = *((const f32x4*)final_g + lane + 64 * j); }
            s0 += __shfl_xor(s0, 1); s0 += __shfl_xor(s0, 2); s0 += __shfl_xor(s0, 4); s0 += __shfl_xor(s0, 8);
            s1 += __shfl_xor(s1, 1); s1 += __shfl_xor(s1, 2); s1 += __shfl_xor(s1, 4); s1 += __shfl_xor(s1, 8);
            const float rstd0 = 1.0f / sqrtf(s0 * (1.0f / D) + EPS), rstd1 = 1.0f / sqrtf(s1 * (1.0f / D) + EPS);
#pragma unroll
            for (int j = 0; j < 4; ++j) { wrow0[64 * j] = v0[j] * rstd0 * gq[j]; wrow1[64 * j] = v1[j] * rstd1 * gq[j]; }
        }
    }
#undef IN
#undef SEAM
}

extern "C" void kernel_launch(void* const* d_in, const int* in_sizes, int n_in, void* d_out, int out_size, void* d_ws, size_t ws_size, hipStream_t stream) {
    static int grid = 0;
    if (grid == 0) {
        if (n_in != 14 || in_sizes[0] != M * D || out_size != M * D || ws_size < WS_END) { fprintf(stderr, "kernel_launch: unexpected shapes (n_in %d, in0 %d, out %d, ws %zu); nothing launched\n", n_in, n_in > 0 ? in_sizes[0] : -1, out_size, ws_size); grid = -1; return; }
        int dev = 0, cus = 0, per_cu = 0;
        if (hipGetDevice(&dev) != hipSuccess || hipDeviceGetAttribute(&cus, hipDeviceAttributeMultiprocessorCount, dev) != hipSuccess) { grid = -1; return; }
        if (hipFuncSetAttribute((const void*)hymba_fwd, hipFuncAttributeMaxDynamicSharedMemorySize, LDS_BYTES) != hipSuccess) { fprintf(stderr, "kernel_launch: hipFuncSetAttribute failed\n"); grid = -1; return; }
        if (hipOccupancyMaxActiveBlocksPerMultiprocessor(&per_cu, (const void*)hymba_fwd, NWAVES * 64, LDS_BYTES) != hipSuccess || per_cu < 1) { fprintf(stderr, "kernel_launch: occupancy query says %d blocks per CU\n", per_cu); per_cu = 1; }
        (void)hipGetLastError();
        grid = cus;
    }
    if (grid < 0) return;
    if (hipMemsetAsync((char*)d_ws + WS_CTL, 0, CTL_ZERO_BYTES, stream) != hipSuccess) { fprintf(stderr, "kernel_launch: memset of the barrier words failed\n"); return; }
    Args a{};
    for (int i = 0; i < 14; ++i) a.in[i] = (const float*)d_in[i];
    a.out = (float*)d_out; a.ws = (unsigned char*)d_ws;
#if MK_N_LAUNCHES == 1
    a.ph_lo = 0; a.ph_hi = NPH;
    void* kargs[] = {&a};
    hipError_t e = hipLaunchCooperativeKernel((const void*)hymba_fwd, dim3(grid), dim3(NWAVES * 64), kargs, LDS_BYTES, stream);
    if (e != hipSuccess) fprintf(stderr, "kernel_launch: cooperative launch failed: %s (grid %d)\n", hipGetErrorString(e), grid);
#else
    for (int ph = 0; ph < NPH; ++ph) {
        a.ph_lo = ph; a.ph_hi = ph + 1;
        hipLaunchKernelGGL(hymba_fwd, dim3(grid), dim3(NWAVES * 64), LDS_BYTES, stream, a);
    }
#endif
}
```
